# Optimizing an MI355X kernel written in HIP

```python
import jax, jax.numpy as jnp
from jax import lax
import numpy as np

D_MODEL = 1024
BATCH = 4
SEQ = 8192
DEPTH = 1

PLE_DIM = 256
SB_HEADS = 8
SB_HEAD_DIM = 64
SB_WIDTH = SB_HEADS * SB_HEAD_DIM
SB_BLOCK = 128
ML_HEADS = 4
ML_HEAD_DIM = 128
ML_WIDTH = ML_HEADS * ML_HEAD_DIM
ML_CHUNK = 128
CONV_WIDTH = 4
PEER_HEADS = 8
PEER_KEYS = 128
PEER_EXPERTS = PEER_KEYS * PEER_KEYS
PEER_QDIM = 256
PEER_HALF = PEER_QDIM // 2
PEER_TOPK = 16
PEER_BLOCK = 128
ALPHA = (2.0 * DEPTH) ** 0.25
BETA = (8.0 * DEPTH) ** -0.25
LN_EPS = 1e-5
IN_SIZES = (SB_WIDTH, SB_WIDTH, SB_WIDTH, ML_WIDTH, ML_WIDTH, ML_WIDTH, ML_WIDTH, ML_HEADS, ML_HEADS, D_MODEL, D_MODEL)
IN_WIDTH = sum(IN_SIZES)

kernel_name = 'hybrid_stickbreak_mlstm_peer_deepnorm'


def layer_norm(x, g, b):
    xf = x.astype(jnp.float32)
    mu = jnp.mean(xf, axis=-1, keepdims=True)
    var = jnp.mean(jnp.square(xf - mu), axis=-1, keepdims=True)
    return ((xf - mu) * lax.rsqrt(var + LN_EPS) * g + b).astype(x.dtype)


def split_heads(t, n_heads):
    b, s, _ = t.shape
    return t.reshape(b, s, n_heads, -1).transpose(0, 2, 1, 3)


def merge_heads(t):
    b, h, s, d = t.shape
    return t.transpose(0, 2, 1, 3).reshape(b, s, h * d)


def causal_conv(x, w, b):
    k_w = w.shape[0]
    s = x.shape[1]
    xp = jnp.pad(x, ((0, 0), (k_w - 1, 0), (0, 0)))
    y = b
    for j in range(k_w):
        y = y + w[j] * xp[:, k_w - 1 - j:k_w - 1 - j + s]
    return y


def stick_breaking_attention(q, k, v):
    s_len, dh = q.shape[2], q.shape[3]
    scale = dh ** -0.5
    outs = []
    for blk in range(s_len // SB_BLOCK):
        t0 = blk * SB_BLOCK
        kl = t0 + SB_BLOCK
        z = jnp.einsum('bhtd,bhsd->bhts', q[:, :, t0:kl], k[:, :, :kl]).astype(jnp.float32) * scale
        t_idx = t0 + jnp.arange(SB_BLOCK)[:, None]
        s_idx = jnp.arange(kl)[None, :]
        causal = s_idx < t_idx
        log_beta = jax.nn.log_sigmoid(z)
        log_one_minus = jnp.where(causal, jax.nn.log_sigmoid(-z), 0.0)
        tail = lax.cumsum(log_one_minus, axis=3, reverse=True) - log_one_minus
        w = jnp.where(causal, jnp.exp(log_beta + tail), 0.0)
        outs.append(jnp.einsum('bhts,bhsd->bhtd', w.astype(v.dtype), v[:, :, :kl]))
    return jnp.concatenate(outs, axis=2)


def mlstm_chunkwise(q, k, v, log_i, log_f):
    b_, h_, s_len, d = q.shape
    L = ML_CHUNK
    nc = s_len // L
    f32 = jnp.float32
    q = q.astype(f32).reshape(b_, h_, nc, L, d)
    k = (k.astype(f32) * d ** -0.5).reshape(b_, h_, nc, L, d)
    v = v.astype(f32).reshape(b_, h_, nc, L, d)
    li = log_i.reshape(b_, h_, nc, L)
    bcum = jnp.cumsum(log_f.reshape(b_, h_, nc, L), axis=-1)
    b_last = bcum[..., -1]
    w_end = b_last[..., None] - bcum + li
    m_loc = jnp.max(w_end, axis=-1)
    e_end = jnp.exp(w_end - m_loc[..., None])
    c_loc = jnp.einsum('bhcsd,bhcse->bhcde', e_end[..., None] * v, k)
    n_loc = jnp.einsum('bhcs,bhcse->bhce', e_end, k)

    def step(carry, inp):
        c_st, n_st, m_st = carry
        cl, nl, ml, bl = inp
        m_new = jnp.maximum(bl + m_st, ml)
        a = jnp.exp(bl + m_st - m_new)
        g = jnp.exp(ml - m_new)
        c_new = a[..., None, None] * c_st + g[..., None, None] * cl
        n_new = a[..., None] * n_st + g[..., None] * nl
        return (c_new, n_new, m_new), (c_st, n_st, m_st)

    init = (jnp.zeros((b_, h_, d, d), f32), jnp.zeros((b_, h_, d), f32), jnp.zeros((b_, h_), f32))
    xs = (jnp.moveaxis(c_loc, 2, 0), jnp.moveaxis(n_loc, 2, 0), jnp.moveaxis(m_loc, 2, 0), jnp.moveaxis(b_last, 2, 0))
    _, (c_prev, n_prev, m_prev) = lax.scan(step, init, xs)
    c_prev = jnp.moveaxis(c_prev, 0, 2)
    n_prev = jnp.moveaxis(n_prev, 0, 2)
    m_prev = jnp.moveaxis(m_prev, 0, 2)
    d_log = bcum[..., :, None] - bcum[..., None, :] + li[..., None, :]
    tri = jnp.tril(jnp.ones((L, L), dtype=bool))
    d_log = jnp.where(tri, d_log, -jnp.inf)
    inter_log = bcum + m_prev[..., None]
    m_t = jnp.maximum(inter_log, jnp.max(d_log, axis=-1))
    a_t = jnp.exp(inter_log - m_t)
    s_w = jnp.einsum('bhctd,bhcsd->bhcts', q, k) * jnp.exp(d_log - m_t[..., None])
    num = a_t[..., None] * jnp.einsum('bhcde,bhcte->bhctd', c_prev, q) + jnp.einsum('bhcts,bhcsd->bhctd', s_w, v)
    den = a_t * jnp.einsum('bhce,bhcte->bhct', n_prev, q) + jnp.sum(s_w, axis=-1)
    h = num / jnp.maximum(jnp.abs(den), jnp.exp(-m_t))[..., None]
    return h.reshape(b_, h_, s_len, d)


def token_mixer(h, w_in, b_igate, b_fgate, conv_w, conv_b, w_branch_sb, w_branch_ml, w_out):
    proj = h @ w_in
    offs = []
    acc = 0
    for sz in IN_SIZES[:-1]:
        acc += sz
        offs.append(acc)
    sb_q, sb_k, sb_v, ml_q, ml_k, ml_v, ml_o, ml_i, ml_f, gate_sb, gate_ml = jnp.split(proj, offs, axis=-1)
    o_sb = merge_heads(stick_breaking_attention(split_heads(sb_q, SB_HEADS), split_heads(sb_k, SB_HEADS), split_heads(sb_v, SB_HEADS)))
    qk = jax.nn.silu(causal_conv(jnp.concatenate([ml_q, ml_k], axis=-1), conv_w, conv_b))
    ml_q, ml_k = jnp.split(qk, 2, axis=-1)
    log_i = (ml_i + b_igate).astype(jnp.float32).transpose(0, 2, 1)
    log_f = jax.nn.log_sigmoid((ml_f + b_fgate).astype(jnp.float32)).transpose(0, 2, 1)
    h_ml = mlstm_chunkwise(split_heads(ml_q, ML_HEADS), split_heads(ml_k, ML_HEADS), split_heads(ml_v, ML_HEADS), log_i, log_f)
    o_ml = jax.nn.sigmoid(ml_o) * merge_heads(h_ml).astype(h.dtype)
    y = jax.nn.sigmoid(gate_sb) * (o_sb @ w_branch_sb) + jax.nn.sigmoid(gate_ml) * (o_ml @ w_branch_ml)
    return y @ w_out


def peer_ffn(h, wq, k1, k2, u_tab, v_tab):
    b_, s_len, d = h.shape
    q = (h @ wq).astype(jnp.float32).reshape(b_, s_len, PEER_HEADS, 2, PEER_HALF)
    s1 = jnp.einsum('bshd,nd->bshn', q[..., 0, :], k1.astype(jnp.float32))
    s2 = jnp.einsum('bshd,nd->bshn', q[..., 1, :], k2.astype(jnp.float32))
    v1, i1 = lax.top_k(s1, PEER_TOPK)
    v2, i2 = lax.top_k(s2, PEER_TOPK)
    cand = (v1[..., :, None] + v2[..., None, :]).reshape(b_, s_len, PEER_HEADS, PEER_TOPK * PEER_TOPK)
    cidx = (i1[..., :, None] * PEER_KEYS + i2[..., None, :]).reshape(b_, s_len, PEER_HEADS, PEER_TOPK * PEER_TOPK)
    top_s, pos = lax.top_k(cand, PEER_TOPK)
    idx = jnp.take_along_axis(cidx, pos, axis=-1)
    gates = jax.nn.softmax(top_s, axis=-1).astype(h.dtype)
    nb = s_len // PEER_BLOCK

    def blockify(t):
        return jnp.moveaxis(t.reshape((b_, nb, PEER_BLOCK) + t.shape[2:]), 1, 0)

    def expert_block(args):
        hb, ib, gb = args
        ue = jnp.take(u_tab, ib, axis=0)
        act = jax.nn.gelu(jnp.einsum('btd,bthkd->bthk', hb, ue), approximate=False)
        ve = jnp.take(v_tab, ib, axis=0)
        return jnp.einsum('bthk,bthkd->btd', gb * act, ve)

    out = lax.map(expert_block, (blockify(h), blockify(idx), blockify(gates)))
    return jnp.moveaxis(out, 0, 1).reshape(b_, s_len, d)


def setup_inputs(seed: int = 0) -> dict:
    key = jax.random.key(seed)
    ks = jax.random.split(key, 24)
    f32 = jnp.float32
    nrm = lambda k, shape, s: jax.random.normal(k, shape, f32) * s
    dn = DEPTH
    b_f = jnp.broadcast_to(jnp.linspace(3.0, 6.0, ML_HEADS, dtype=f32), (dn, ML_HEADS)) + nrm(ks[5], (dn, ML_HEADS), 0.01)
    return {
        'x': nrm(ks[0], (BATCH, SEQ, D_MODEL), 1.0),
        'p': nrm(ks[1], (DEPTH, BATCH, SEQ, PLE_DIM), 1.0),
        'ln0_g': 1.0 + nrm(ks[2], (D_MODEL,), 0.01),
        'ln0_b': nrm(ks[3], (D_MODEL,), 0.01),
        'w_in': nrm(ks[4], (dn, D_MODEL, IN_WIDTH), D_MODEL ** -0.5),
        'b_igate': nrm(ks[6], (dn, ML_HEADS), 0.1),
        'b_fgate': b_f,
        'conv_w': nrm(ks[7], (dn, CONV_WIDTH, 2 * ML_WIDTH), CONV_WIDTH ** -0.5),
        'conv_b': nrm(ks[8], (dn, 2 * ML_WIDTH), 0.01),
        'w_branch_sb': nrm(ks[9], (dn, SB_WIDTH, D_MODEL), BETA * SB_WIDTH ** -0.5),
        'w_branch_ml': nrm(ks[10], (dn, ML_WIDTH, D_MODEL), BETA * ML_WIDTH ** -0.5),
        'w_out': nrm(ks[11], (dn, D_MODEL, D_MODEL), BETA * D_MODEL ** -0.5),
        'ln1_g': 1.0 + nrm(ks[12], (dn, D_MODEL), 0.01),
        'ln1_b': nrm(ks[13], (dn, D_MODEL), 0.01),
        'peer_wq': nrm(ks[14], (dn, D_MODEL, PEER_HEADS * PEER_QDIM), D_MODEL ** -0.5),
        'peer_k1': nrm(ks[15], (dn, PEER_KEYS, PEER_HALF), PEER_HALF ** -0.5),
        'peer_k2': nrm(ks[16], (dn, PEER_KEYS, PEER_HALF), PEER_HALF ** -0.5),
        'peer_u': nrm(ks[17], (dn, PEER_EXPERTS, D_MODEL), D_MODEL ** -0.5),
        'peer_v': nrm(ks[18], (dn, PEER_EXPERTS, D_MODEL), BETA * PEER_HEADS ** -0.5),
        'w_ple_gate': nrm(ks[19], (dn, D_MODEL, D_MODEL), D_MODEL ** -0.5),
        'w_ple': nrm(ks[20], (dn, PLE_DIM, D_MODEL), PLE_DIM ** -0.5),
        'ln2_g': 1.0 + nrm(ks[21], (dn, D_MODEL), 0.01),
        'ln2_b': nrm(ks[22], (dn, D_MODEL), 0.01),
    }


def reference(x, p, ln0_g, ln0_b, w_in, b_igate, b_fgate, conv_w, conv_b, w_branch_sb, w_branch_ml, w_out, ln1_g, ln1_b, peer_wq, peer_k1, peer_k2, peer_u, peer_v, w_ple_gate, w_ple, ln2_g, ln2_b):
    h = layer_norm(x, ln0_g, ln0_b)
    for i in range(DEPTH):
        mix = token_mixer(h, w_in[i], b_igate[i], b_fgate[i], conv_w[i], conv_b[i], w_branch_sb[i], w_branch_ml[i], w_out[i])
        h = layer_norm(ALPHA * h + mix, ln1_g[i], ln1_b[i])
        ffn = peer_ffn(h, peer_wq[i], peer_k1[i], peer_k2[i], peer_u[i], peer_v[i])
        ple = jax.nn.sigmoid(h @ w_ple_gate[i]) * (p[i] @ w_ple[i])
        h = layer_norm(ALPHA * h + ffn + ple, ln2_g[i], ln2_b[i])
    return h
```

```cpp
#include <hip/hip_runtime.h>
#include <cstdio>
#include <cstdint>
#include <cmath>
namespace pg8 {
#define PG8_LAS __attribute__((address_space(3)))
typedef unsigned short bf16_t;
typedef short bf16x8 __attribute__((ext_vector_type(8)));
typedef float f32x4 __attribute__((ext_vector_type(4)));
typedef unsigned u32x4 __attribute__((ext_vector_type(4)));
constexpr int BM = 256, BK = 64, HALF = 128, HTB = HALF * BK * 2  , STAGE_BYTES = 8 * HTB, NXCD = 8, WGM = 8;

__host__ __device__ __forceinline__ int lds_byte(int r, int c) { const int st = (r >> 4) * 2 + (c >> 5), rr = r & 15, cc = c & 31, ob = rr * 64 + cc * 2; return st * 1024 + (ob ^ (((ob >> 9) & 1) << 5)); }
__host__ __device__ __forceinline__ void stage_rc(int b, int& R, int& C) { const int st = b / 1024, sb = b % 1024, swz = sb ^ (((sb >> 9) & 1) << 5); R = (st >> 1) * 16 + swz / 64; C = (st & 1) * 32 + (swz % 64) / 2; }
__host__ __device__ __forceinline__ int perm32(int rho) { const int n = rho >> 4, i = rho & 15; return 8 * (i >> 2) + 4 * n + (i & 3); }

struct Unit { int pm, pn; };
struct Gemm { const bf16_t* A; const bf16_t* Bt; int M, N, K; };

struct StaticOrder {
    int nM, nN, nwg, G, c;
    __host__ __device__ void init(int M, int N, int G_, int c_) { nM = M / BM; nN = N / BM; nwg = nM * nN; G = G_; c = c_; }
    __host__ __device__ bool next(int i, Unit& u) const {
        const long L = (long)i * G + c; if (L >= nwg) return false;
        int wgid = (int)L; { const int q = nwg / NXCD, r = nwg % NXCD, xcd = wgid % NXCD, off = wgid / NXCD; wgid = (xcd < r ? xcd * (q + 1) : r * (q + 1) + (xcd - r) * q) + off; }
        const int nig = WGM * nN, gid = wgid / nig, fm = gid * WGM, gsz = (nM - fm) < WGM ? (nM - fm) : WGM;
        u.pm = fm + ((wgid % nig) % gsz); u.pn = (wgid % nig) / gsz; return true;
    }
    __device__ __forceinline__ void a_ready(const Unit&) const {}
    __device__ __forceinline__ void done(const Unit&) const {}
};

__device__ __forceinline__ unsigned cvt_pk_bf16(float lo, float hi) { unsigned r; asm volatile("v_cvt_pk_bf16_f32 %0, %1, %2" : "=v"(r) : "v"(lo), "v"(hi)); return r; }
typedef float f32x2 __attribute__((ext_vector_type(2)));
__device__ __forceinline__ f32x2 gelu_pk(f32x2 v) {
    const f32x2 av = __builtin_elementwise_abs(v), d = av * 0.2316418882f + 1.0f;
    f32x2 t; t.x = __builtin_amdgcn_rcpf(d.x); t.y = __builtin_amdgcn_rcpf(d.y);
    f32x2 q = t * 0.5307027145f + (-0.7265760135f); q = q * t + 0.7107068705f; q = q * t + (-0.142248368f); q = q * t + 0.127414796f; q = q * t;
    const f32x2 s = (v * v) * (-0.72134752044f);
    f32x2 e; e.x = __builtin_amdgcn_exp2f(s.x); e.y = __builtin_amdgcn_exp2f(s.y);
    const f32x2 m = v * (q * e), r = v - m;
    f32x2 o; o.x = v.x < 0.f ? m.x : r.x; o.y = v.y < 0.f ? m.y : r.y; return o;
}

template <int ACT  > struct EpiBf16 {
    static constexpr bool PERM = true, AFTER_DRAIN = false; static_assert(ACT == 0 || ACT == 1, "EpiBf16: ACT is 0 (none) or 1 (gelu_pk)");
    bf16_t* O; int ldc; const float* bias; int split_cols; size_t split_stride; float scale0;
    __device__ __forceinline__ void operator()(const f32x4 (&acc)[2][2][4][2], const Unit& u, int wr, int wc, int fr, int fq) const {
        const int row0 = u.pm * BM + wr * 64 + fr; int colt = u.pn * BM; bf16_t* base = O;
        float sc = 1.f; if (split_cols) { const int t = colt / split_cols; base += (size_t)t * split_stride; colt -= t * split_cols; if (t == 0) sc = scale0; }
        const int col0 = colt + wc * 32 + 8 * fq, bcol0 = u.pn * BM + wc * 32 + 8 * fq;
        f32x4 bv[2][2];
#pragma unroll
        for (int bj = 0; bj < 2; ++bj)
#pragma unroll
            for (int n = 0; n < 2; ++n) bv[bj][n] = bias ? *(const f32x4*)(bias + bcol0 + bj * HALF + 4 * n) : (f32x4){0.f, 0.f, 0.f, 0.f};
#pragma unroll
        for (int ai = 0; ai < 2; ++ai)
#pragma unroll
            for (int m = 0; m < 4; ++m) { bf16_t* rowp = base + (size_t)(row0 + ai * HALF + m * 16) * ldc + col0;
#pragma unroll
                for (int bj = 0; bj < 2; ++bj) { f32x4 v0 = acc[ai][bj][m][0] + bv[bj][0], v1 = acc[ai][bj][m][1] + bv[bj][1];
                    if (ACT == 1) { f32x2 a = gelu_pk((f32x2){v0[0], v0[1]}), b = gelu_pk((f32x2){v0[2], v0[3]}), c = gelu_pk((f32x2){v1[0], v1[1]}), d = gelu_pk((f32x2){v1[2], v1[3]});
                        v0 = (f32x4){a.x, a.y, b.x, b.y}; v1 = (f32x4){c.x, c.y, d.x, d.y}; }
                    v0 = v0 * sc; v1 = v1 * sc; u32x4 w; w.x = cvt_pk_bf16(v0[0], v0[1]); w.y = cvt_pk_bf16(v0[2], v0[3]); w.z = cvt_pk_bf16(v1[0], v1[1]); w.w = cvt_pk_bf16(v1[2], v1[3]);
                    *(u32x4*)(rowp + bj * HALF) = w; } }
    }
};

struct PanelStats {
    unsigned* xbuf;
    unsigned* cnt;
    unsigned* tmo;
    int ntn; float eps;
    unsigned code;
    __device__ __forceinline__ bool run(const f32x4 (&v)[2][2][4][2], const Unit& u, int wr, int wc, int fr, int fq, PG8_LAS unsigned char* lds, int wid, int lane) const {
        typedef float f32x2v __attribute__((ext_vector_type(2)));
        PG8_LAS f32x2v* P = (PG8_LAS f32x2v*)lds;
        PG8_LAS f32x2v* S = (PG8_LAS f32x2v*)(lds + 8192);
        PG8_LAS unsigned* flag = (PG8_LAS unsigned*)(lds + 8192 + 2048);
#pragma unroll
        for (int ai = 0; ai < 2; ++ai)
#pragma unroll
            for (int m = 0; m < 4; ++m) {
                float s = 0.f;
#pragma unroll
                for (int bj = 0; bj < 2; ++bj)
#pragma unroll
                    for (int n = 0; n < 2; ++n) { const f32x4 x = v[ai][bj][m][n]; s += (x[0] + x[1]) + (x[2] + x[3]); }
                s += __shfl_xor(s, 16); s += __shfl_xor(s, 32);
                const float mw = s * (1.0f / 64.0f); float q = 0.f;
#pragma unroll
                for (int bj = 0; bj < 2; ++bj)
#pragma unroll
                    for (int n = 0; n < 2; ++n) { const f32x4 d = v[ai][bj][m][n] - mw; q += (d[0] * d[0] + d[1] * d[1]) + (d[2] * d[2] + d[3] * d[3]); }
                q += __shfl_xor(q, 16); q += __shfl_xor(q, 32);
                if (fq == 0) P[(ai * HALF + wr * 64 + m * 16 + fr) * 4 + wc] = (f32x2v){mw, q};
            }
        asm volatile("s_waitcnt lgkmcnt(0)" ::: "memory"); __builtin_amdgcn_s_barrier(); asm volatile("" ::: "memory");
#if defined(BROKEN_EXCHANGE_NO_WAIT)
#warning BROKEN CONTROL BUILD: the row-statistics exchange does not wait; results are wrong by design
        if (blockIdx.x >= 64) { const long long t0_ = clock64(); while (clock64() - t0_ < 60000) __builtin_amdgcn_s_sleep(8); }
#endif
        const int row = wid * 32 + (lane & 31);
        if (lane < 32) {
            const f32x2v a = P[row * 4 + 0], b = P[row * 4 + 1], c = P[row * 4 + 2], d = P[row * 4 + 3];
            const float mt = (a.x + b.x + c.x + d.x) * 0.25f;
            const float da = a.x - mt, db = b.x - mt, dc = c.x - mt, dd = d.x - mt;
            const float m2 = (a.y + b.y) + (c.y + d.y) + 64.0f * ((da * da + db * db) + (dc * dc + dd * dd));
            unsigned long long* slot = (unsigned long long*)xbuf + ((size_t)(u.pm * BM + row) * 4 + u.pn);
            __hip_atomic_store(slot, ((unsigned long long)__float_as_uint(m2) << 32) | __float_as_uint(mt), __ATOMIC_RELAXED, __HIP_MEMORY_SCOPE_AGENT);
        }
        asm volatile("s_waitcnt vmcnt(0)" ::: "memory");
        if (lane == 0) __hip_atomic_fetch_add(cnt + 64 * u.pm, 1u, __ATOMIC_RELAXED, __HIP_MEMORY_SCOPE_AGENT);
        if (wid == 0) {
            bool dead = false; const unsigned long long t0 = __builtin_amdgcn_s_memrealtime(); const unsigned want = 8u * (unsigned)ntn;
            for (;;) {
#if defined(BROKEN_EXCHANGE_NO_WAIT)
                break;
#endif
                if ((unsigned)__builtin_amdgcn_readfirstlane(__hip_atomic_load(cnt + 64 * u.pm, __ATOMIC_RELAXED, __HIP_MEMORY_SCOPE_AGENT)) >= want) break;
                if (__builtin_amdgcn_s_memrealtime() - t0 > 2000000ull) {
                    if (lane == 0) { unsigned expect = 0u; __hip_atomic_compare_exchange_strong(tmo + 1, &expect, code | (unsigned)(u.pm & 0xff), __ATOMIC_RELAXED, __ATOMIC_RELAXED, __HIP_MEMORY_SCOPE_AGENT);
                                     __hip_atomic_store(tmo, 1u, __ATOMIC_RELAXED, __HIP_MEMORY_SCOPE_AGENT); }
                    dead = true; break; }
                __builtin_amdgcn_s_sleep(2);
            }
            __builtin_amdgcn_fence(__ATOMIC_ACQUIRE, "agent");
            if (lane == 0) flag[0] = dead ? 1u : 0u;
        }
        asm volatile("s_waitcnt vmcnt(0) lgkmcnt(0)" ::: "memory"); __builtin_amdgcn_s_barrier(); asm volatile("" ::: "memory");
        const bool bad = flag[0] != 0u;
        if (lane < 32) {
            const unsigned long long* slot = (const unsigned long long*)xbuf + (size_t)(u.pm * BM + row) * 4; float mt[4], m2[4]; float ms = 0.f;
#pragma unroll
            for (int t = 0; t < 4; ++t) { if (t < ntn) { const unsigned long long w = __hip_atomic_load(slot + t, __ATOMIC_RELAXED, __HIP_MEMORY_SCOPE_AGENT); mt[t] = __uint_as_float((unsigned)w); m2[t] = __uint_as_float((unsigned)(w >> 32)); } else { mt[t] = 0.f; m2[t] = 0.f; } ms += mt[t]; }
            const float mean = ms / (float)ntn; float q = 0.f;
#pragma unroll
            for (int t = 0; t < 4; ++t) if (t < ntn) { const float dm = mt[t] - mean; q += m2[t] + 256.0f * dm * dm; }
            S[row] = (f32x2v){mean, 1.0f / sqrtf(q / (256.0f * (float)ntn) + eps)};
        }
        asm volatile("s_waitcnt lgkmcnt(0)" ::: "memory"); __builtin_amdgcn_s_barrier(); asm volatile("" ::: "memory");
        return bad;
    }
};
struct EpiLnRes {
    static constexpr bool PERM = false, AFTER_DRAIN = true;
    const float* base; float* out; int ldc; const float* bias; PanelStats st; unsigned poison;
    __device__ __forceinline__ void fused(f32x4 (&acc)[2][2][4][2], const Unit& u, int wr, int wc, int fr, int fq, PG8_LAS unsigned char* lds, int wid, int lane) const {
        typedef float f32x2v __attribute__((ext_vector_type(2)));
        const PG8_LAS f32x2v* S = (const PG8_LAS f32x2v*)(lds + 8192);
        const int col0 = u.pn * BM + wc * 32 + 4 * fq;
#pragma unroll
        for (int bj = 0; bj < 2; ++bj)
#pragma unroll
            for (int n = 0; n < 2; ++n) { const f32x4 bv = bias ? *(const f32x4*)(bias + col0 + bj * HALF + n * 16) : (f32x4){0.f, 0.f, 0.f, 0.f};
#pragma unroll
                for (int ai = 0; ai < 2; ++ai)
#pragma unroll
                    for (int m = 0; m < 4; ++m) acc[ai][bj][m][n] += bv; }
        f32x4 pre[4][2][2];
#pragma unroll
        for (int m = 0; m < 4; ++m) { const size_t off = (size_t)(u.pm * BM + wr * 64 + m * 16 + fr) * ldc + col0;
#pragma unroll
            for (int bj = 0; bj < 2; ++bj)
#pragma unroll
                for (int n = 0; n < 2; ++n) pre[m][bj][n] = *(const f32x4*)(base + off + bj * HALF + n * 16); }
        const bool bad = st.run(acc, u, wr, wc, fr, fq, lds, wid, lane) || poison != 0u;
        const float qnan = __builtin_nanf("");
#pragma unroll
        for (int ai = 0; ai < 2; ++ai)
#pragma unroll
            for (int m = 0; m < 4; ++m) { const int r = ai * HALF + wr * 64 + m * 16 + fr; const f32x2v sr = S[r]; const size_t off = (size_t)(u.pm * BM + r) * ldc + col0;
#pragma unroll
                for (int bj = 0; bj < 2; ++bj)
#pragma unroll
                    for (int n = 0; n < 2; ++n) { const f32x4 bs = ai == 0 ? pre[m][bj][n] : *(const f32x4*)(base + off + bj * HALF + n * 16); f32x4 o = bs + (acc[ai][bj][m][n] - sr.x) * sr.y;
                        if (bad) o = (f32x4){qnan, qnan, qnan, qnan}; *(f32x4*)(out + off + bj * HALF + n * 16) = o; }
                if (m & 1) asm volatile("" ::: "memory"); }
    }
};
struct EpiLnResLn {
    static constexpr bool PERM = false, AFTER_DRAIN = true;
    const float* base; float* out; bf16_t* xn; int ldc; const float* bias; PanelStats st1, st2; unsigned poison;
    __device__ __forceinline__ void fused(f32x4 (&acc)[2][2][4][2], const Unit& u, int wr, int wc, int fr, int fq, PG8_LAS unsigned char* lds, int wid, int lane) const {
        typedef float f32x2v __attribute__((ext_vector_type(2))); typedef unsigned u32x2v __attribute__((ext_vector_type(2)));
        const PG8_LAS f32x2v* S = (const PG8_LAS f32x2v*)(lds + 8192);
        const int col0 = u.pn * BM + wc * 32 + 4 * fq;
#pragma unroll
        for (int bj = 0; bj < 2; ++bj)
#pragma unroll
            for (int n = 0; n < 2; ++n) { const f32x4 bv = bias ? *(const f32x4*)(bias + col0 + bj * HALF + n * 16) : (f32x4){0.f, 0.f, 0.f, 0.f};
#pragma unroll
                for (int ai = 0; ai < 2; ++ai)
#pragma unroll
                    for (int m = 0; m < 4; ++m) acc[ai][bj][m][n] += bv; }
        bool bad = st1.run(acc, u, wr, wc, fr, fq, lds, wid, lane) || poison != 0u;
        const float qnan = __builtin_nanf("");
#pragma unroll
        for (int ai = 0; ai < 2; ++ai)
#pragma unroll
            for (int m = 0; m < 4; ++m) { const int r = ai * HALF + wr * 64 + m * 16 + fr; const f32x2v sr = S[r]; const size_t off = (size_t)(u.pm * BM + r) * ldc + col0;
#pragma unroll
                for (int bj = 0; bj < 2; ++bj)
#pragma unroll
                    for (int n = 0; n < 2; ++n) { const f32x4 bs = *(const f32x4*)(base + off + bj * HALF + n * 16); acc[ai][bj][m][n] = bs + (acc[ai][bj][m][n] - sr.x) * sr.y; }
                asm volatile("" : "+v"(acc[ai][0][m][0]), "+v"(acc[ai][0][m][1]), "+v"(acc[ai][1][m][0]), "+v"(acc[ai][1][m][1]));
                if (m & 1) asm volatile("" ::: "memory"); }
        const bool bad1 = bad;
        bad = st2.run(acc, u, wr, wc, fr, fq, lds, wid, lane) || bad;
#pragma unroll
        for (int ai = 0; ai < 2; ++ai)
#pragma unroll
            for (int m = 0; m < 4; ++m) { const int r = ai * HALF + wr * 64 + m * 16 + fr; const f32x2v sr = S[r]; const size_t off = (size_t)(u.pm * BM + r) * ldc + col0;
#pragma unroll
                for (int bj = 0; bj < 2; ++bj)
#pragma unroll
                    for (int n = 0; n < 2; ++n) { const f32x4 x1 = acc[ai][bj][m][n]; *(f32x4*)(out + off + bj * HALF + n * 16) = bad1 ? (f32x4){qnan, qnan, qnan, qnan} : x1;
                        const f32x4 o = (x1 - sr.x) * sr.y; u32x2v w; w.x = cvt_pk_bf16(o[0], o[1]); w.y = cvt_pk_bf16(o[2], o[3]);
                        if (bad) { w.x = 0x7fc07fc0u; w.y = 0x7fc07fc0u; } *(u32x2v*)(xn + off + bj * HALF + n * 16) = w; }
                asm volatile("" ::: "memory"); }
    }
};

template <class Epi, class Sched, bool ALIGN_EPI = false, bool SP2 = false>
__device__ __forceinline__ void gemm_phase(PG8_LAS unsigned char* lds, const Gemm g, const Sched& S, const Epi& E) {
    const int tid = threadIdx.x, wid = __builtin_amdgcn_readfirstlane(tid >> 6), lane = tid & 63, wr = wid >> 2, wc = wid & 3, fr = lane & 15, fq = lane >> 4;
    const int K = g.K, nt = K / BK;
    unsigned voffA[2], voffB[2];
#pragma unroll
    for (int i = 0; i < 2; ++i) { int R, C; stage_rc(tid * 16 + i * 8192, R, C); const int Rb = Epi::PERM ? ((R & ~31) + perm32(R & 31)) : R;
        voffA[i] = (unsigned)(R * K + C) * 2u; voffB[i] = (unsigned)(Rb * K + C) * 2u; }
    const size_t kstep = (size_t)(BK * 2);
    const size_t hstep = (size_t)HALF * K * 2;
    const size_t tstep = 2 * hstep;
    const unsigned ldsw = (unsigned)wid * 1024u;
    const int aoff = lds_byte(wr * 64 + fr, fq * 8), boff = lds_byte(wc * 32 + fr, fq * 8);
#define PG8_SA(b, h) (((b) * 2 + (h)) * HTB)
#define PG8_SB(b, h) ((4 + (b) * 2 + (h)) * HTB)
#define PG8_STAGE(bufoff, gbase, voff) do { _Pragma("unroll") for (int _i = 0; _i < 2; ++_i) \
        __builtin_amdgcn_global_load_lds((const unsigned*)((const char*)(gbase) + (voff)[_i]), (PG8_LAS unsigned*)(lds + (bufoff) + ldsw + _i * 8192), 16, 0, 0); } while (0)
#define PG8_LDA(dst, b, h) do { _Pragma("unroll") for (int m = 0; m < 4; ++m) _Pragma("unroll") for (int k = 0; k < 2; ++k) dst[m][k] = *(const PG8_LAS bf16x8*)(lds + PG8_SA(b, h) + aoff + m * 2048 + k * 1024); } while (0)
#define PG8_LDB(dst, b, h) do { _Pragma("unroll") for (int n = 0; n < 2; ++n) _Pragma("unroll") for (int k = 0; k < 2; ++k) dst[n][k] = *(const PG8_LAS bf16x8*)(lds + PG8_SB(b, h) + boff + n * 2048 + k * 1024); } while (0)
#define PG8_MMA(ai, bj, At, Bt) do { __builtin_amdgcn_s_setprio(1); _Pragma("unroll") for (int m = 0; m < 4; ++m) _Pragma("unroll") for (int n = 0; n < 2; ++n) _Pragma("unroll") for (int k = 0; k < 2; ++k) \
        acc[ai][bj][m][n] = __builtin_amdgcn_mfma_f32_16x16x32_bf16(Bt[n][k], At[m][k], acc[ai][bj][m][n], 0, 0, 0); __builtin_amdgcn_s_setprio(0); } while (0)
#define PG8_WAIT_V(n) asm volatile("s_waitcnt vmcnt(" #n ")" ::: "memory")
#define PG8_WAIT_L(n) asm volatile("s_waitcnt lgkmcnt(" #n ")" ::: "memory")
#define PG8_BAR __builtin_amdgcn_s_barrier()
#define PG8_SCHED __builtin_amdgcn_sched_barrier(0)
    Unit cur, nxt; int ui = 0;
    if (!S.next(0, cur)) return;
    f32x4 acc[2][2][4][2];
#pragma unroll
    for (int a = 0; a < 2; ++a)
#pragma unroll
        for (int b = 0; b < 2; ++b)
#pragma unroll
            for (int m = 0; m < 4; ++m)
#pragma unroll
                for (int n = 0; n < 2; ++n) acc[a][b][m][n] = (f32x4){0.f, 0.f, 0.f, 0.f};
    bf16x8 At[4][2], B0[2][2], B1[2][2];
    const char* cA = (const char*)g.A + (size_t)cur.pm * tstep; const char* cB = (const char*)g.Bt + (size_t)cur.pn * tstep;
    S.a_ready(cur);
    if constexpr (SP2) {
        PG8_STAGE(PG8_SB(0, 0), cB, voffB); PG8_STAGE(PG8_SB(0, 1), cB + hstep, voffB); PG8_STAGE(PG8_SA(0, 0), cA, voffA); PG8_STAGE(PG8_SA(0, 1), cA + hstep, voffA);
        if (wr == 1) PG8_BAR;
        PG8_WAIT_V(2); PG8_BAR;
        PG8_STAGE(PG8_SB(1, 0), cB + kstep, voffB); PG8_STAGE(PG8_SA(1, 0), cA + kstep, voffA); PG8_STAGE(PG8_SB(1, 1), cB + hstep + kstep, voffB);
        PG8_WAIT_V(6); PG8_BAR;
    } else {
        PG8_STAGE(PG8_SB(0, 0), cB, voffB); PG8_STAGE(PG8_SA(0, 0), cA, voffA); PG8_STAGE(PG8_SB(0, 1), cB + hstep, voffB); PG8_STAGE(PG8_SA(0, 1), cA + hstep, voffA);
        if (wr == 1) PG8_BAR;
        PG8_WAIT_V(4); PG8_BAR;
        PG8_STAGE(PG8_SB(1, 0), cB + kstep, voffB); PG8_STAGE(PG8_SA(1, 0), cA + kstep, voffA); PG8_STAGE(PG8_SB(1, 1), cB + hstep + kstep, voffB);
        PG8_WAIT_V(6); PG8_BAR;
    }
    for (;;) {
        const bool has_next = S.next(ui + 1, nxt);
        const char* nA = has_next ? (const char*)g.A + (size_t)nxt.pm * tstep : cA; const char* nB = has_next ? (const char*)g.Bt + (size_t)nxt.pn * tstep : cB;
        for (int t = 0; t < nt; t += 2) {
            const bool last = (t == nt - 2);
            const char* a1 = cA + (size_t)(t + 1) * kstep;
            const char* a2 = last ? nA : cA + (size_t)(t + 2) * kstep; const char* b2 = last ? nB : cB + (size_t)(t + 2) * kstep;
            const char* a3 = a2 + kstep; const char* b3 = b2 + kstep;
            if (last && has_next) S.a_ready(nxt);
            if constexpr (SP2) {
            PG8_LDB(B0, 0, 0); PG8_LDB(B1, 0, 1); PG8_SCHED; PG8_LDA(At, 0, 0); PG8_STAGE(PG8_SA(1, 1), a1 + hstep, voffA);
            PG8_WAIT_V(8); PG8_WAIT_L(0); PG8_BAR; PG8_MMA(0, 0, At, B0); PG8_MMA(0, 1, At, B1); PG8_BAR; PG8_SCHED;
            PG8_LDA(At, 0, 1); PG8_STAGE(PG8_SB(0, 0), b2, voffB); PG8_STAGE(PG8_SB(0, 1), b2 + hstep, voffB); PG8_STAGE(PG8_SA(0, 0), a2, voffA);
            PG8_WAIT_V(8); PG8_WAIT_L(0); PG8_BAR; PG8_MMA(1, 0, At, B0); PG8_MMA(1, 1, At, B1); PG8_BAR; PG8_SCHED;
            PG8_LDB(B0, 1, 0); PG8_LDB(B1, 1, 1); PG8_SCHED; PG8_LDA(At, 1, 0); PG8_STAGE(PG8_SA(0, 1), a2 + hstep, voffA);
            PG8_WAIT_V(8); PG8_WAIT_L(0); PG8_BAR; PG8_MMA(0, 0, At, B0); PG8_MMA(0, 1, At, B1); PG8_BAR; PG8_SCHED;
            PG8_LDA(At, 1, 1); PG8_STAGE(PG8_SB(1, 0), b3, voffB); PG8_STAGE(PG8_SB(1, 1), b3 + hstep, voffB); PG8_STAGE(PG8_SA(1, 0), a3, voffA);
            PG8_WAIT_V(8); PG8_WAIT_L(0); PG8_BAR; PG8_MMA(1, 0, At, B0); PG8_MMA(1, 1, At, B1); PG8_BAR; PG8_SCHED;
            } else {
            PG8_LDB(B0, 0, 0); PG8_SCHED; PG8_LDA(At, 0, 0); PG8_STAGE(PG8_SA(1, 1), a1 + hstep, voffA);
            PG8_WAIT_L(8); PG8_BAR; PG8_WAIT_L(0); PG8_MMA(0, 0, At, B0); PG8_BAR; PG8_SCHED;
            PG8_LDB(B1, 0, 1); PG8_STAGE(PG8_SB(0, 0), b2, voffB);
            PG8_BAR; PG8_WAIT_L(0); PG8_MMA(0, 1, At, B1); PG8_BAR;
            PG8_LDA(At, 0, 1); PG8_STAGE(PG8_SA(0, 0), a2, voffA);
            PG8_BAR; PG8_WAIT_L(0); PG8_MMA(1, 0, At, B0); PG8_BAR; PG8_SCHED;
            PG8_STAGE(PG8_SB(0, 1), b2 + hstep, voffB);
            PG8_WAIT_V(6); PG8_BAR; PG8_MMA(1, 1, At, B1); PG8_BAR;
            PG8_LDB(B0, 1, 0); PG8_SCHED; PG8_LDA(At, 1, 0); PG8_STAGE(PG8_SA(0, 1), a2 + hstep, voffA);
            PG8_WAIT_L(8); PG8_BAR; PG8_WAIT_L(0); PG8_MMA(0, 0, At, B0); PG8_BAR; PG8_SCHED;
            PG8_LDB(B1, 1, 1); PG8_STAGE(PG8_SB(1, 0), b3, voffB);
            PG8_BAR; PG8_WAIT_L(0); PG8_MMA(0, 1, At, B1); PG8_BAR;
            PG8_LDA(At, 1, 1); PG8_STAGE(PG8_SA(1, 0), a3, voffA);
            PG8_BAR; PG8_WAIT_L(0); PG8_MMA(1, 0, At, B0); PG8_BAR; PG8_SCHED;
            PG8_STAGE(PG8_SB(1, 1), b3 + hstep, voffB);
            PG8_WAIT_V(6); PG8_BAR; PG8_MMA(1, 1, At, B1); PG8_BAR;
            }
        }
        if constexpr (ALIGN_EPI) { if (wr == 0) PG8_BAR; }
        if constexpr (!Epi::AFTER_DRAIN) { E(acc, cur, wr, wc, fr, fq); S.done(cur); }
        if (!has_next) break;
#pragma unroll
        for (int a = 0; a < 2; ++a)
#pragma unroll
            for (int b = 0; b < 2; ++b)
#pragma unroll
                for (int m = 0; m < 4; ++m)
#pragma unroll
                    for (int n = 0; n < 2; ++n) acc[a][b][m][n] = (f32x4){0.f, 0.f, 0.f, 0.f};
        cur = nxt; cA = nA; cB = nB; ++ui;
        if constexpr (ALIGN_EPI) { if (wr == 1) PG8_BAR; }
    }
    PG8_WAIT_V(0);
    if constexpr (!ALIGN_EPI) { if (wr == 0) PG8_BAR; }
    PG8_BAR;
    if constexpr (Epi::AFTER_DRAIN) { E.fused(acc, cur, wr, wc, fr, fq, lds, wid, lane); S.done(cur); }
#undef PG8_SA
#undef PG8_SB
#undef PG8_STAGE
#undef PG8_LDA
#undef PG8_LDB
#undef PG8_MMA
#undef PG8_WAIT_V
#undef PG8_WAIT_L
#undef PG8_BAR
#undef PG8_SCHED
}
}
#ifndef PG8_SP2
#define PG8_SP2 true
#endif
#ifndef PG8_ALIGN
#define PG8_ALIGN true
#endif
constexpr int NWAVES = 8;
#ifndef MK_N_LAUNCHES
#define MK_N_LAUNCHES 11
#endif
#ifndef SB_EARLY_EXIT
#define SB_EARLY_EXIT 1
#endif
constexpr int N_PHASES = 11;
constexpr int N_LAUNCHES = MK_N_LAUNCHES;

constexpr int BATCH = 4, SEQ = 8192, DM = 1024, M = BATCH * SEQ;
constexpr int INW = 5640, NPROJ = 5632, GATE_COL = 3584;
constexpr int NCHUNK = SEQ / 128;
constexpr int N_MLU = BATCH * 4 * NCHUNK;
constexpr float ALPHA = 1.18920711500272107f;
constexpr float LN_EPS = 1e-5f;
constexpr float LOG2E = 1.4426950408889634f;
constexpr float C2 = 0.125f * LOG2E;
constexpr float SB_EXIT_THR = -160.0f;

constexpr size_t MiB = 1u << 20;
constexpr size_t WS_CTL = 0, CTL_ZERO_BYTES = 1 * MiB;
constexpr size_t WS_WIN_T = 1 * MiB;
constexpr size_t WS_WSB_T = 12 * MiB;
constexpr size_t WS_WML_T = 13 * MiB;
constexpr size_t WS_WOUT_T = 14 * MiB;
constexpr size_t WS_WQG_T = 16 * MiB;
constexpr size_t WS_WPLE_T = 22 * MiB;
constexpr size_t WS_STATS = 23 * MiB;
constexpr size_t WS_GI = 24 * MiB;
constexpr size_t WS_GF = 25 * MiB;
constexpr size_t WS_MLN = 26 * MiB;
constexpr size_t WS_MLS = 27 * MiB;
constexpr size_t WS_XN = 32 * MiB;
constexpr size_t WS_OSB = 32 * MiB;
constexpr size_t WS_C = 64 * MiB;
constexpr size_t WS_UT = 32 * MiB;
constexpr size_t WS_VT = 64 * MiB;
constexpr size_t WS_PROJ = 96 * MiB;
constexpr size_t SLAB = (size_t)M * 512;
constexpr size_t WS_Y = 96 * MiB;
constexpr size_t WS_PLE = 160 * MiB;
constexpr size_t WS_H1B = 224 * MiB;
constexpr size_t WS_PRE1 = 320 * MiB;
constexpr size_t WS_Q = 320 * MiB;
constexpr size_t WS_IDX = 96 * MiB;
constexpr size_t WS_GATE = 112 * MiB;
constexpr size_t WS_OML = 448 * MiB;
constexpr size_t WS_PB = 480 * MiB;
constexpr size_t WS_END = 496 * MiB;
constexpr int CW_TMO = 0, CW_CODE = 1;
constexpr int CW_BAR = 4096;

constexpr int RING_OFF = 0, RING_BYTES = 131072;
constexpr int LDSCTL_OFF = RING_BYTES, MISC_OFF = LDSCTL_OFF + 320;
constexpr int LDS_BYTES = 147456;
#define GAS __attribute__((address_space(1)))
#define LAS __attribute__((address_space(3)))
typedef unsigned short bf16;
typedef unsigned v4u __attribute__((ext_vector_type(4)));
typedef float f32x4 __attribute__((ext_vector_type(4)));
typedef short bf16x8 __attribute__((ext_vector_type(8)));
typedef GAS unsigned gu32;
typedef GAS unsigned long long gu64;
#define RLX_AGENT __ATOMIC_RELAXED, __HIP_MEMORY_SCOPE_AGENT
#define LDS_WAIT() asm volatile("s_waitcnt lgkmcnt(0)" ::: "memory")
#define VM_WAIT() asm volatile("s_waitcnt vmcnt(0)" ::: "memory")
__device__ __forceinline__ unsigned long long rt() { return __builtin_amdgcn_s_memrealtime(); }
__device__ __forceinline__ unsigned f2bf(float f) { unsigned u = __builtin_bit_cast(unsigned, f); return (u + 0x7fffu + ((u >> 16) & 1u)) >> 16; }
__device__ __forceinline__ unsigned pk2(float lo, float hi) { return f2bf(lo) | (f2bf(hi) << 16); }

#define XB_TMO      128
#define XB_XCNT(j)  (256  + 64 * (j))
#define XB_XSUB(j)  (1280 + 64 * (j))
#define XB_XGEN(j)  (2304 + 64 * (j))
#define XB_TOP      3328
#define XB_TOPGEN   3392
#define XCD_BAR_WORDS 3456
#define XB_SPIN_CAP (1u << 18)

__device__ __forceinline__ unsigned xb_ld(unsigned* p)              { return __hip_atomic_load(p, __ATOMIC_RELAXED, __HIP_MEMORY_SCOPE_AGENT); }
__device__ __forceinline__ unsigned xb_add(unsigned* p, unsigned v) { return __hip_atomic_fetch_add(p, v, __ATOMIC_RELAXED, __HIP_MEMORY_SCOPE_AGENT); }
__device__ __forceinline__ unsigned xb_xcc_id() { return (unsigned)__builtin_amdgcn_s_getreg((3 << 11) | 20) & 0xFu; }
#define XB_SPIN(cond, bar) do { unsigned _sp = 0; while (cond) { __builtin_amdgcn_s_sleep(1); \
    if ((++_sp & 255u) == 0u) { if (xb_ld(&(bar)[XB_TMO])) break; if (_sp > XB_SPIN_CAP) { atomicAdd(&(bar)[XB_TMO], 1u); break; } } } } while (0)

struct XcdBarrier {
    unsigned* bar; unsigned x;
    volatile LAS unsigned* st;
};

__device__ __forceinline__ XcdBarrier xcd_barrier_post(unsigned* bar, volatile LAS unsigned* st) {
    XcdBarrier b; b.bar = bar; b.x = xb_xcc_id(); b.st = st;
    if (threadIdx.x == 0) (void)xb_add(&bar[XB_XCNT(b.x)], 1u);
    return b;
}
__device__ __forceinline__ void xcd_barrier_complete(unsigned* bar, unsigned x, unsigned& nloc, unsigned& nx) {
    const unsigned G = gridDim.x * gridDim.y * gridDim.z;
    unsigned sum, cnt, mine, sp = 0u;
    for (;;) {
        sum = 0u; cnt = 0u; mine = 0u;
#pragma unroll
        for (unsigned j = 0; j < 16; ++j) { const unsigned c = xb_ld(&bar[XB_XCNT(j)]); sum += c; cnt += (c > 0u) ? 1u : 0u; mine = (j == x) ? c : mine; }
        if (sum == G) break;
        __builtin_amdgcn_s_sleep(1);
        if ((++sp & 255u) == 0u) { if (xb_ld(&bar[XB_TMO])) break; if (sp > XB_SPIN_CAP) { atomicAdd(&bar[XB_TMO], 1u); break; } }
    }
    nloc = mine > 0u ? mine : 1u; nx = cnt > 0u ? cnt : 1u;
}

__device__ __forceinline__ void xcd_barrier(const XcdBarrier& b) {
    asm volatile("s_waitcnt vmcnt(0)" ::: "memory");
    __syncthreads();
    if (threadIdx.x == 0) {
        unsigned* bar = b.bar;
        __builtin_amdgcn_s_waitcnt(0);
        unsigned nloc = b.st[0], nx = b.st[1];
        if (nloc == 0u) { xcd_barrier_complete(bar, b.x, nloc, nx); b.st[0] = nloc; b.st[1] = nx; }
        const unsigned old = xb_add(&bar[XB_XSUB(b.x)], 1u);
        const unsigned gen = old / nloc;
        if (old + 1u == (gen + 1u) * nloc) {
            __builtin_amdgcn_fence(__ATOMIC_RELEASE, "agent");
            asm volatile("s_waitcnt vmcnt(0)" ::: "memory");
            const unsigned og = xb_add(&bar[XB_TOP], 1u);
            const unsigned tg = og / nx;
            if (og + 1u == (tg + 1u) * nx) xb_add(&bar[XB_TOPGEN], 1u);
            else XB_SPIN(xb_ld(&bar[XB_TOPGEN]) == tg, bar);
            __builtin_amdgcn_fence(__ATOMIC_ACQUIRE, "agent");
            xb_add(&bar[XB_XGEN(b.x)], 1u);
            asm volatile("s_waitcnt vmcnt(0)" ::: "memory");
        } else {
            XB_SPIN(xb_ld(&bar[XB_XGEN(b.x)]) == gen, bar);
            __builtin_amdgcn_fence(__ATOMIC_ACQUIRE, "agent");
            asm volatile("s_waitcnt vmcnt(0)" ::: "memory");
        }
    }
    __syncthreads();
}
typedef float f32x16 __attribute__((ext_vector_type(16)));
typedef float f32x2 __attribute__((ext_vector_type(2)));
typedef unsigned u32x2 __attribute__((ext_vector_type(2)));
typedef __bf16 bf16x2_t __attribute__((ext_vector_type(2)));

struct Frame {
    LAS unsigned char* lds;
    volatile LAS unsigned* MISC;
    gu32* ctl;
    int tid, lane, wave;
    int vcu, G;
    const float* const* in;
    float* out;
    unsigned char* ws;
};
#define WSP(T, off) ((T*)(F.ws + (off)))

__device__ __forceinline__ float wave_sum(float v) {
#pragma unroll
    for (int o = 1; o < 64; o <<= 1) v += __shfl_xor(v, o);
    return v;
}
__device__ __forceinline__ float wave_max(float v) {
#pragma unroll
    for (int o = 1; o < 64; o <<= 1) v = fmaxf(v, __shfl_xor(v, o));
    return v;
}
__device__ __forceinline__ float bf_lo(unsigned u) { return __uint_as_float(u << 16); }
__device__ __forceinline__ float bf_hi(unsigned u) { return __uint_as_float(u & 0xffff0000u); }
__device__ __forceinline__ unsigned cvtpk(float lo, float hi) { f32x2 v = {lo, hi}; bf16x2_t b = __builtin_convertvector(v, bf16x2_t); return __builtin_bit_cast(unsigned, b); }
__device__ __forceinline__ float sigmoidf_fast(float x) { return __builtin_amdgcn_rcpf(1.0f + __builtin_amdgcn_exp2f(-x * LOG2E)); }
__device__ __forceinline__ float siluf_fast(float x) { return x * sigmoidf_fast(x); }
__device__ __forceinline__ int crow(int r, int hi) { return (r & 3) + 8 * (r >> 2) + 4 * hi; }
__device__ __forceinline__ float dot2_bf16(unsigned w, unsigned x, float acc) { return __builtin_amdgcn_fdot2_f32_bf16(__builtin_bit_cast(bf16x2_t, w), __builtin_bit_cast(bf16x2_t, x), acc, false); }
#define MFMA32(a, b, c) __builtin_amdgcn_mfma_f32_32x32x16_bf16((a), (b), (c), 0, 0, 0)

namespace pg8 {
template <bool ADD> struct EpiGate {
    static constexpr bool PERM = true, AFTER_DRAIN = false;
    bf16_t* Y; const bf16_t* G;
    __device__ __forceinline__ void operator()(const f32x4 (&acc)[2][2][4][2], const Unit& u, int wr, int wc, int fr, int fq) const {
        const int row0 = u.pm * BM + wr * 64 + fr, col0 = u.pn * BM + wc * 32 + 8 * fq;
#pragma unroll
        for (int ai = 0; ai < 2; ++ai)
#pragma unroll
            for (int m = 0; m < 4; ++m) { const size_t row = (size_t)(row0 + ai * HALF + m * 16);
#pragma unroll
                for (int bj = 0; bj < 2; ++bj) { const int col = col0 + bj * HALF;
                    const u32x4 g = *(const u32x4*)(G + (size_t)(col >> 9) * SLAB + row * 512 + (col & 511));
                    const f32x4 v0 = acc[ai][bj][m][0], v1 = acc[ai][bj][m][1];
                    float y[8];
                    y[0] = sigmoidf_fast(bf_lo(g.x)) * v0[0]; y[1] = sigmoidf_fast(bf_hi(g.x)) * v0[1]; y[2] = sigmoidf_fast(bf_lo(g.y)) * v0[2]; y[3] = sigmoidf_fast(bf_hi(g.y)) * v0[3];
                    y[4] = sigmoidf_fast(bf_lo(g.z)) * v1[0]; y[5] = sigmoidf_fast(bf_hi(g.z)) * v1[1]; y[6] = sigmoidf_fast(bf_lo(g.w)) * v1[2]; y[7] = sigmoidf_fast(bf_hi(g.w)) * v1[3];
                    u32x4* yp = (u32x4*)(Y + row * 1024 + col);
                    if (ADD) { const u32x4 o = *yp; y[0] += bf_lo(o.x); y[1] += bf_hi(o.x); y[2] += bf_lo(o.y); y[3] += bf_hi(o.y); y[4] += bf_lo(o.z); y[5] += bf_hi(o.z); y[6] += bf_lo(o.w); y[7] += bf_hi(o.w); }
                    u32x4 w; w.x = cvtpk(y[0], y[1]); w.y = cvtpk(y[2], y[3]); w.z = cvtpk(y[4], y[5]); w.w = cvtpk(y[6], y[7]);
                    *yp = w; } }
    }
};
struct EpiPre1 {
    static constexpr bool PERM = false, AFTER_DRAIN = false;
    float* P; const float* x; const float* stats; const float* g0; const float* b0;
    __device__ __forceinline__ void operator()(const f32x4 (&acc)[2][2][4][2], const Unit& u, int wr, int wc, int fr, int fq) const {
        const int row0 = u.pm * BM + wr * 64 + fr, col0 = u.pn * BM + wc * 32 + 4 * fq;
        f32x4 gv[2][2], bv[2][2];
#pragma unroll
        for (int bj = 0; bj < 2; ++bj)
#pragma unroll
            for (int n = 0; n < 2; ++n) { gv[bj][n] = *(const f32x4*)(g0 + col0 + bj * HALF + n * 16); bv[bj][n] = *(const f32x4*)(b0 + col0 + bj * HALF + n * 16); }
#pragma unroll
        for (int ai = 0; ai < 2; ++ai)
#pragma unroll
            for (int m = 0; m < 4; ++m) { const size_t row = (size_t)(row0 + ai * HALF + m * 16); const f32x2 st = *(const f32x2*)(stats + row * 2);
#pragma unroll
                for (int bj = 0; bj < 2; ++bj)
#pragma unroll
                    for (int n = 0; n < 2; ++n) { const size_t off = row * 1024 + col0 + bj * HALF + n * 16; const f32x4 xv = *(const f32x4*)(x + off);
                        const f32x4 h0 = (xv - st.x) * st.y * gv[bj][n] + bv[bj][n];
                        *(f32x4*)(P + off) = h0 * ALPHA + acc[ai][bj][m][n]; } }
    }
};
struct EpiQG {
    static constexpr bool PERM = true, AFTER_DRAIN = false;
    bf16_t* Q; bf16_t* PLE;
    __device__ __forceinline__ void operator()(const f32x4 (&acc)[2][2][4][2], const Unit& u, int wr, int wc, int fr, int fq) const {
        const int row0 = u.pm * BM + wr * 64 + fr, colt = u.pn * BM, col0 = colt + wc * 32 + 8 * fq;
        const bool isq = colt < 2048;
#pragma unroll
        for (int ai = 0; ai < 2; ++ai)
#pragma unroll
            for (int m = 0; m < 4; ++m) { const size_t row = (size_t)(row0 + ai * HALF + m * 16);
#pragma unroll
                for (int bj = 0; bj < 2; ++bj) { const int col = col0 + bj * HALF; const f32x4 v0 = acc[ai][bj][m][0], v1 = acc[ai][bj][m][1];
                    if (isq) { u32x4 w; w.x = cvtpk(v0[0], v0[1]); w.y = cvtpk(v0[2], v0[3]); w.z = cvtpk(v1[0], v1[1]); w.w = cvtpk(v1[2], v1[3]);
                        *(u32x4*)(Q + row * 2048 + col) = w; }
                    else { u32x4* pp = (u32x4*)(PLE + row * 1024 + (col - 2048)); const u32x4 o = *pp; u32x4 w;
                        w.x = cvtpk(sigmoidf_fast(v0[0]) * bf_lo(o.x), sigmoidf_fast(v0[1]) * bf_hi(o.x)); w.y = cvtpk(sigmoidf_fast(v0[2]) * bf_lo(o.y), sigmoidf_fast(v0[3]) * bf_hi(o.y));
                        w.z = cvtpk(sigmoidf_fast(v1[0]) * bf_lo(o.z), sigmoidf_fast(v1[1]) * bf_hi(o.z)); w.w = cvtpk(sigmoidf_fast(v1[2]) * bf_lo(o.w), sigmoidf_fast(v1[3]) * bf_hi(o.w));
                        *pp = w; } } }
    }
};
}

__device__ __forceinline__ void p0_transpose_item(const float* W, int ldw, int K, int nblk, int shift_from, int shift, bf16* WT, int row_off, LAS float* scr, int item, int lane) {
    const int kb = item / nblk, nb = item % nblk, k0 = 64 * kb, n0 = 32 * nb, sn0 = n0 + (n0 >= shift_from ? shift : 0);
#pragma unroll 8
    for (int i = 0; i < 32; ++i) { const int kk = 2 * i + (lane >> 5); scr[kk * 33 + (lane & 31)] = W[(size_t)(k0 + kk) * ldw + sn0 + (lane & 31)]; }
    LDS_WAIT(); asm volatile("" ::: "memory");
    const int c = lane & 7;
#pragma unroll
    for (int j = 0; j < 4; ++j) { const int n = (lane >> 3) + 8 * j; const LAS float* s = scr + (8 * c) * 33 + n;
        v4u o; o.x = pk2(s[0 * 33], s[1 * 33]); o.y = pk2(s[2 * 33], s[3 * 33]); o.z = pk2(s[4 * 33], s[5 * 33]); o.w = pk2(s[6 * 33], s[7 * 33]);
        *(GAS v4u*)(WT + (size_t)(row_off + n0 + n) * K + k0 + 8 * c) = o; }
    LDS_WAIT(); asm volatile("" ::: "memory");
}
__device__ __forceinline__ float log_sigmoidf(float x) { return -(fmaxf(-x, 0.f) + log1pf(expf(-fabsf(x)))); }

__device__ __forceinline__ void p0_prologue(Frame& F) {
    const int gw = F.vcu * NWAVES + F.wave, NGW = F.G * NWAVES, lane = F.lane;
    {
        LAS float* scr = (LAS float*)(F.lds + RING_OFF + F.wave * 16384);
        constexpr int I_IN = 16 * (NPROJ / 32), I_SB = 8 * 32, I_ML = 8 * 32, I_OUT = 16 * 32, I_WQ = 16 * 64, I_WG = 16 * 32, I_PLE = 4 * 32;
        constexpr int NITEMS = I_IN + I_SB + I_ML + I_OUT + I_WQ + I_WG + I_PLE;
        for (int it = gw; it < NITEMS; it += NGW) {
            int r = it;
            if (r < I_IN) { p0_transpose_item(F.in[4], INW, 1024, NPROJ / 32, GATE_COL, 8, WSP(bf16, WS_WIN_T), 0, scr, r, lane); continue; } r -= I_IN;
            if (r < I_SB) { p0_transpose_item(F.in[9], 1024, 512, 32, 1 << 30, 0, WSP(bf16, WS_WSB_T), 0, scr, r, lane); continue; } r -= I_SB;
            if (r < I_ML) { p0_transpose_item(F.in[10], 1024, 512, 32, 1 << 30, 0, WSP(bf16, WS_WML_T), 0, scr, r, lane); continue; } r -= I_ML;
            if (r < I_OUT) { p0_transpose_item(F.in[11], 1024, 1024, 32, 1 << 30, 0, WSP(bf16, WS_WOUT_T), 0, scr, r, lane); continue; } r -= I_OUT;
            if (r < I_WQ) { p0_transpose_item(F.in[14], 2048, 1024, 64, 1 << 30, 0, WSP(bf16, WS_WQG_T), 0, scr, r, lane); continue; } r -= I_WQ;
            if (r < I_WG) { p0_transpose_item(F.in[19], 1024, 1024, 32, 1 << 30, 0, WSP(bf16, WS_WQG_T), 2048, scr, r, lane); continue; } r -= I_WG;
            p0_transpose_item(F.in[20], 1024, 256, 32, 1 << 30, 0, WSP(bf16, WS_WPLE_T), 0, scr, r, lane);
        }
    }
    {
        const float* p = F.in[1]; bf16* PB = WSP(bf16, WS_PB);
        const size_t nchunk = (size_t)M * 256 / 8, stride = (size_t)F.G * NWAVES * 64;
        for (size_t i = (size_t)F.vcu * NWAVES * 64 + F.tid; i < nchunk; i += stride) {
            const f32x4 a = *(const GAS f32x4*)(p + i * 8), b = *(const GAS f32x4*)(p + i * 8 + 4);
            v4u o; o.x = pk2(a.x, a.y); o.y = pk2(a.z, a.w); o.z = pk2(b.x, b.y); o.w = pk2(b.z, b.w);
            *(GAS v4u*)(PB + i * 8) = o; }
    }
    __syncthreads();
    LAS float* WGt = (LAS float*)(F.lds + RING_OFF);
    for (int i = F.tid; i < 8192; i += NWAVES * 64) { const int k = i >> 3, c = i & 7; WGt[c * 1024 + k] = F.in[4][(size_t)k * INW + GATE_COL + c]; }
    __syncthreads();
    const float* x = F.in[0]; const float* g0 = F.in[2]; const float* b0 = F.in[3];
    f32x4 gv[4], bv[4];
#pragma unroll
    for (int j = 0; j < 4; ++j) { gv[j] = *(const f32x4*)(g0 + 256 * j + 4 * lane); bv[j] = *(const f32x4*)(b0 + 256 * j + 4 * lane); }
    bf16* XN = WSP(bf16, WS_XN); float* stats = WSP(float, WS_STATS); float* GI = WSP(float, WS_GI); float* GF = WSP(float, WS_GF);
    const float big = F.in[5][lane & 3], bfg = F.in[6][lane & 3];
    for (int m = gw; m < M; m += NGW) {
        const GAS f32x4* xr = (const GAS f32x4*)(x + (size_t)m * DM) + lane;
        f32x4 v[4]; float s = 0.f;
#pragma unroll
        for (int j = 0; j < 4; ++j) { v[j] = xr[64 * j]; s += (v[j].x + v[j].y) + (v[j].z + v[j].w); }
        const float mean = wave_sum(s) * (1.f / DM); float s2 = 0.f;
#pragma unroll
        for (int j = 0; j < 4; ++j) { v[j] = v[j] - mean; s2 += (v[j].x * v[j].x + v[j].y * v[j].y) + (v[j].z * v[j].z + v[j].w * v[j].w); }
        const float rstd = 1.f / sqrtf(wave_sum(s2) * (1.f / DM) + LN_EPS);
        GAS unsigned long long* o8 = (GAS unsigned long long*)(XN + (size_t)m * DM) + lane;
        float part[8];
#pragma unroll
        for (int c = 0; c < 8; ++c) part[c] = 0.f;
#pragma unroll
        for (int j = 0; j < 4; ++j) { const f32x4 y = v[j] * rstd * gv[j] + bv[j];
            o8[64 * j] = (unsigned long long)pk2(y.x, y.y) | ((unsigned long long)pk2(y.z, y.w) << 32);
#pragma unroll
            for (int c = 0; c < 8; ++c) { const f32x4 w = *(const LAS f32x4*)(WGt + c * 1024 + 256 * j + 4 * lane); part[c] += (y.x * w.x + y.y * w.y) + (y.z * w.z + y.w * w.w); } }
#pragma unroll
        for (int c = 0; c < 8; ++c) part[c] = wave_sum(part[c]);
        if (lane == 0) { stats[(size_t)m * 2] = mean; stats[(size_t)m * 2 + 1] = rstd; }
        float sel = part[0];
#pragma unroll
        for (int c = 1; c < 8; ++c) sel = (lane == c) ? part[c] : sel;
        if (lane < 4) GI[(size_t)m * 4 + lane] = sel + big;
        else if (lane < 8) GF[(size_t)m * 4 + (lane - 4)] = log_sigmoidf(sel + bfg);
    }
}
template <bool MASK>
__device__ __forceinline__ void sb_block(const f32x16& x, float& R, int kbase, int qg, int hi, unsigned (&pw)[8]) {
    float l[16], lb[16];
#pragma unroll
    for (int r = 0; r < 16; ++r) {
        const float xv = x[r];
        const float e = __builtin_amdgcn_exp2f(-fabsf(xv));
        const float sp = fmaxf(xv, 0.f) + __builtin_amdgcn_logf(1.0f + e);
        lb[r] = xv - sp;
        l[r] = -sp;
        if (MASK) { const bool c = (kbase + crow(r, hi)) < qg; l[r] = c ? l[r] : 0.f; lb[r] = c ? lb[r] : -INFINITY; }
    }
    float ex[16], T[4];
#pragma unroll
    for (int g = 0; g < 4; ++g) { ex[4 * g + 3] = 0.f; ex[4 * g + 2] = l[4 * g + 3]; ex[4 * g + 1] = ex[4 * g + 2] + l[4 * g + 2]; ex[4 * g] = ex[4 * g + 1] + l[4 * g + 1]; T[g] = ex[4 * g] + l[4 * g]; }
    float S[4], up[4];
#pragma unroll
    for (int g = 0; g < 4; ++g) { auto rr = __builtin_amdgcn_permlane32_swap(__float_as_uint(T[g]), __float_as_uint(T[g]), false, false);
        const float lo_v = __uint_as_float(rr[0]), up_v = __uint_as_float(rr[1]); S[g] = lo_v + up_v; up[g] = up_v; }
    float base[4];
    base[3] = R; base[2] = base[3] + S[3]; base[1] = base[2] + S[2]; base[0] = base[1] + S[1];
    R = base[0] + S[0];
    float w[16];
#pragma unroll
    for (int g = 0; g < 4; ++g) { const float off = base[g] + (hi == 0 ? up[g] : 0.f);
#pragma unroll
        for (int i = 0; i < 4; ++i) w[4 * g + i] = __builtin_amdgcn_exp2f(lb[4 * g + i] + (off + ex[4 * g + i])); }
#pragma unroll
    for (int i = 0; i < 8; ++i) pw[i] = cvtpk(w[2 * i], w[2 * i + 1]);
}

constexpr int AT_KS = 0, AT_KSB = 64 * 144, AT_VT = 2 * AT_KSB, AT_VTB = 64 * 136, AT_FL = AT_VT + 2 * AT_VTB;
__device__ __forceinline__ void attn_unit(Frame& F, int bh, int qb) {
    const int tid = F.tid, lane = F.lane, wave = F.wave, r32 = lane & 31, hi = lane >> 5;
    const int b = bh >> 3, h = bh & 7;
    const size_t rowbase = (size_t)b * SEQ;
    const int q0 = qb * 256, qw = q0 + wave * 32;
    const bf16* PROJ = WSP(bf16, WS_PROJ);
    const bf16* Qs = PROJ + (rowbase + qw) * 512 + h * 64;
    const bf16* Ks = PROJ + SLAB + rowbase * 512 + h * 64;
    const bf16* Vs = PROJ + 2 * SLAB + rowbase * 512 + h * 64;
    bf16x8 qr[4];
#pragma unroll
    for (int ks = 0; ks < 4; ++ks) qr[ks] = *(const bf16x8*)(Qs + (size_t)r32 * 512 + ks * 16 + hi * 8);
    LAS unsigned char* L = F.lds + RING_OFF;
    LAS unsigned* FL = (LAS unsigned*)(L + AT_FL);
    const int skey = tid >> 3, sch = tid & 7;
    f32x16 o0, o1;
#pragma unroll
    for (int r = 0; r < 16; ++r) { o0[r] = 0.f; o1[r] = 0.f; }
    float R = 0.f; bool wdone = false;
    const int NT = (q0 + 256) >> 6;
    v4u kreg, vreg;
#define AT_LOAD(kt) do { const size_t ro_ = (size_t)((kt) * 64 + skey) * 512 + sch * 8; kreg = *(const v4u*)(Ks + ro_); vreg = *(const v4u*)(Vs + ro_); } while (0)
#define AT_WRITE(buf) do { *(LAS v4u*)(L + AT_KS + (buf) * AT_KSB + skey * 144 + sch * 16) = kreg; \
        LAS unsigned short* vt_ = (LAS unsigned short*)(L + AT_VT + (buf) * AT_VTB) + (sch * 8) * 68 + skey; \
        vt_[0 * 68] = (unsigned short)(vreg.x & 0xffffu); vt_[1 * 68] = (unsigned short)(vreg.x >> 16); vt_[2 * 68] = (unsigned short)(vreg.y & 0xffffu); vt_[3 * 68] = (unsigned short)(vreg.y >> 16); \
        vt_[4 * 68] = (unsigned short)(vreg.z & 0xffffu); vt_[5 * 68] = (unsigned short)(vreg.z >> 16); vt_[6 * 68] = (unsigned short)(vreg.w & 0xffffu); vt_[7 * 68] = (unsigned short)(vreg.w >> 16); } while (0)
    AT_LOAD(NT - 1); AT_WRITE(0);
    __syncthreads();
    int cur = 0, par = 0;
    for (int kt = NT - 1; kt >= 0; --kt) {
        if (kt > 0) AT_LOAD(kt - 1);
        if (!wdone && 64 * kt < qw + 31) {
            const bool full = (64 * kt + 63 < qw);
#pragma unroll
            for (int kbi = 0; kbi < 2; ++kbi) { const int kb = 1 - kbi; const int kbase = 64 * kt + 32 * kb;
                if (kbase < qw + 31) {
                    f32x16 x;
#pragma unroll
                    for (int r = 0; r < 16; ++r) x[r] = 0.f;
#pragma unroll
                    for (int ks = 0; ks < 4; ++ks) { const bf16x8 a = *(const LAS bf16x8*)(L + AT_KS + cur * AT_KSB + (32 * kb + r32) * 144 + (16 * ks + 8 * hi) * 2); x = MFMA32(a, qr[ks], x); }
                    unsigned pw[8];
                    if (full) sb_block<false>(x, R, kbase, qw + r32, hi, pw); else sb_block<true>(x, R, kbase, qw + r32, hi, pw);
#pragma unroll
                    for (int s2 = 0; s2 < 2; ++s2) { v4u av; av.x = pw[4 * s2]; av.y = pw[4 * s2 + 1]; av.z = pw[4 * s2 + 2]; av.w = pw[4 * s2 + 3]; const bf16x8 a = __builtin_bit_cast(bf16x8, av);
#pragma unroll
                        for (int dt = 0; dt < 2; ++dt) { const LAS unsigned char* vp = L + AT_VT + cur * AT_VTB + (32 * dt + r32) * 136 + (32 * kb + 16 * s2 + 4 * hi) * 2;
                            const u32x2 b0 = *(const LAS u32x2*)vp, b1 = *(const LAS u32x2*)(vp + 16);
                            v4u bv; bv.x = b0.x; bv.y = b0.y; bv.z = b1.x; bv.w = b1.y; const bf16x8 bb = __builtin_bit_cast(bf16x8, bv);
                            if (dt == 0) o0 = MFMA32(a, bb, o0); else o1 = MFMA32(a, bb, o1); } }
                }
            }
#if SB_EARLY_EXIT
            wdone = __all(R < SB_EXIT_THR);
#endif
        }
        if (lane == 0) FL[par * 8 + wave] = wdone ? 1u : 0u;
        if (kt > 0) AT_WRITE(cur ^ 1);
        __syncthreads();
        unsigned alld = 1u;
#pragma unroll
        for (int w = 0; w < 8; ++w) alld &= FL[par * 8 + w];
        cur ^= 1; par ^= 1;
        if (alld) break;
    }
#undef AT_LOAD
#undef AT_WRITE
    bf16* Ow = WSP(bf16, WS_OSB) + (rowbase + qw) * 512 + h * 64 + r32;
#pragma unroll
    for (int r = 0; r < 16; ++r) { const int q = crow(r, hi); Ow[(size_t)q * 512] = (bf16)f2bf(o0[r]); Ow[(size_t)q * 512 + 32] = (bf16)f2bf(o1[r]); }
    __syncthreads();
}

template <bool TRANS>
__device__ __forceinline__ void ml_stage_conv(Frame& F, const bf16* raw, int t0, const float* cw, const float* cb, float scale, LAS bf16* dst) {
    const int cg = F.tid & 15, rr = F.tid >> 4;
    float w[4][8], bb[8];
#pragma unroll
    for (int j = 0; j < 4; ++j) { const f32x4 a = *(const f32x4*)(cw + j * 1024 + cg * 8), c = *(const f32x4*)(cw + j * 1024 + cg * 8 + 4);
        w[j][0] = a.x; w[j][1] = a.y; w[j][2] = a.z; w[j][3] = a.w; w[j][4] = c.x; w[j][5] = c.y; w[j][6] = c.z; w[j][7] = c.w; }
    { const f32x4 a = *(const f32x4*)(cb + cg * 8), c = *(const f32x4*)(cb + cg * 8 + 4); bb[0] = a.x; bb[1] = a.y; bb[2] = a.z; bb[3] = a.w; bb[4] = c.x; bb[5] = c.y; bb[6] = c.z; bb[7] = c.w; }
#pragma unroll
    for (int p = 0; p < 4; ++p) { const int s = p * 32 + rr;
        float y[8];
#pragma unroll
        for (int i = 0; i < 8; ++i) y[i] = bb[i];
#pragma unroll
        for (int j = 0; j < 4; ++j) { const int t = t0 + s - j;
            v4u rv = {0u, 0u, 0u, 0u};
            if (t >= 0) rv = *(const v4u*)(raw + (size_t)t * 512 + cg * 8);
            y[0] += w[j][0] * bf_lo(rv.x); y[1] += w[j][1] * bf_hi(rv.x); y[2] += w[j][2] * bf_lo(rv.y); y[3] += w[j][3] * bf_hi(rv.y);
            y[4] += w[j][4] * bf_lo(rv.z); y[5] += w[j][5] * bf_hi(rv.z); y[6] += w[j][6] * bf_lo(rv.w); y[7] += w[j][7] * bf_hi(rv.w); }
#pragma unroll
        for (int i = 0; i < 8; ++i) y[i] = siluf_fast(y[i]) * scale;
        if (!TRANS) { v4u o; o.x = cvtpk(y[0], y[1]); o.y = cvtpk(y[2], y[3]); o.z = cvtpk(y[4], y[5]); o.w = cvtpk(y[6], y[7]); *(LAS v4u*)(dst + s * 136 + cg * 8) = o; }
        else {
#pragma unroll
            for (int i = 0; i < 8; ++i) dst[(cg * 8 + i) * 136 + s] = (bf16)f2bf(y[i]); }
    }
}
__device__ __forceinline__ void scan_add128(float a0, float a1, int lane, float& o0, float& o1) {
    float v = a0 + a1;
#pragma unroll
    for (int d = 1; d < 64; d <<= 1) { const float t = __shfl_up(v, d); if (lane >= d) v += t; }
    const float exv = v - (a0 + a1); o0 = exv + a0; o1 = exv + a0 + a1;
}
__device__ __forceinline__ void scan_max128(float a0, float a1, int lane, float& o0, float& o1) {
    float v = fmaxf(a0, a1);
#pragma unroll
    for (int d = 1; d < 64; d <<= 1) { const float t = __shfl_up(v, d); if (lane >= d) v = fmaxf(v, t); }
    float pv = __shfl_up(v, 1); if (lane == 0) pv = -INFINITY;
    o0 = fmaxf(pv, a0); o1 = fmaxf(o0, a1);
}

constexpr int ML_T0 = 0, ML_T1 = 34816, ML_T2 = 69632, ML_SM = 104448;
__device__ __forceinline__ void mla_unit(Frame& F, int u) {
    const int tid = F.tid, lane = F.lane, wave = F.wave, r32 = lane & 31, hi = lane >> 5;
    const int bhd = u >> 6, ch = u & 63, b = bhd >> 2, hd = bhd & 3;
    const size_t rowbase = (size_t)b * SEQ; const int t0 = ch * 128;
    LAS unsigned char* L = F.lds + RING_OFF;
    LAS bf16* KT = (LAS bf16*)(L + ML_T0); LAS bf16* VT = (LAS bf16*)(L + ML_T1);
    LAS float* BC = (LAS float*)(L + ML_SM); LAS float* EE = BC + 128; LAS float* SC = BC + 256;
    const bf16* PROJ = WSP(bf16, WS_PROJ);
    const float* GI = WSP(float, WS_GI); const float* GF = WSP(float, WS_GF);
    if (wave == 0) {
        const size_t r0 = rowbase + t0 + 2 * lane;
        const float f0 = GF[r0 * 4 + hd], f1 = GF[(r0 + 1) * 4 + hd], i0 = GI[r0 * 4 + hd], i1 = GI[(r0 + 1) * 4 + hd];
        float c0, c1; scan_add128(f0, f1, lane, c0, c1);
        const float blast = __shfl(c1, 63);
        const float w0 = blast - c0 + i0, w1 = blast - c1 + i1;
        const float mloc = wave_max(fmaxf(w0, w1));
        EE[2 * lane] = __expf(w0 - mloc); EE[2 * lane + 1] = __expf(w1 - mloc);
        if (lane == 0) { float* S = WSP(float, WS_MLS); S[u] = mloc; S[1024 + u] = blast; }
    }
    ml_stage_conv<true>(F, PROJ + 4 * SLAB + rowbase * 512 + hd * 128, t0, F.in[7] + 512 + hd * 128, F.in[8] + 512 + hd * 128, 0.08838834764831845f, KT);
    __syncthreads();
    {
        const bf16* Vs = PROJ + 5 * SLAB + (rowbase + t0) * 512 + hd * 128;
        const int cg = tid & 15, rr = tid >> 4;
#pragma unroll
        for (int p = 0; p < 4; ++p) { const int s = p * 32 + rr; const float e = EE[s]; const v4u rv = *(const v4u*)(Vs + (size_t)s * 512 + cg * 8);
            LAS bf16* d = VT + (cg * 8) * 136 + s;
            d[0 * 136] = (bf16)f2bf(e * bf_lo(rv.x)); d[1 * 136] = (bf16)f2bf(e * bf_hi(rv.x)); d[2 * 136] = (bf16)f2bf(e * bf_lo(rv.y)); d[3 * 136] = (bf16)f2bf(e * bf_hi(rv.y));
            d[4 * 136] = (bf16)f2bf(e * bf_lo(rv.z)); d[5 * 136] = (bf16)f2bf(e * bf_hi(rv.z)); d[6 * 136] = (bf16)f2bf(e * bf_lo(rv.w)); d[7 * 136] = (bf16)f2bf(e * bf_hi(rv.w)); }
    }
    if (tid < 128) {
        float n = 0.f; const LAS bf16* kr = KT + tid * 136;
#pragma unroll 4
        for (int s8 = 0; s8 < 16; ++s8) { const v4u kv = *(const LAS v4u*)(kr + s8 * 8); const LAS float* ep = EE + s8 * 8;
            n += ep[0] * bf_lo(kv.x) + ep[1] * bf_hi(kv.x) + ep[2] * bf_lo(kv.y) + ep[3] * bf_hi(kv.y) + ep[4] * bf_lo(kv.z) + ep[5] * bf_hi(kv.z) + ep[6] * bf_lo(kv.w) + ep[7] * bf_hi(kv.w); }
        WSP(float, WS_MLN)[(size_t)u * 128 + tid] = n;
    }
    __syncthreads();
    {
        const int dvt = wave >> 1, eh = wave & 1;
        f32x16 c0, c1;
#pragma unroll
        for (int r = 0; r < 16; ++r) { c0[r] = 0.f; c1[r] = 0.f; }
#pragma unroll
        for (int ks = 0; ks < 8; ++ks) { const bf16x8 a = *(const LAS bf16x8*)(VT + (32 * dvt + r32) * 136 + 16 * ks + 8 * hi);
            const bf16x8 b0 = *(const LAS bf16x8*)(KT + (64 * eh + r32) * 136 + 16 * ks + 8 * hi), b1 = *(const LAS bf16x8*)(KT + (64 * eh + 32 + r32) * 136 + 16 * ks + 8 * hi);
            c0 = MFMA32(a, b0, c0); c1 = MFMA32(a, b1, c1); }
        bf16* Cg = WSP(bf16, WS_C) + (size_t)u * 16384 + 64 * eh + r32;
#pragma unroll
        for (int r = 0; r < 16; ++r) { const int dv = 32 * dvt + crow(r, hi); Cg[(size_t)dv * 128] = (bf16)f2bf(c0[r]); Cg[(size_t)dv * 128 + 32] = (bf16)f2bf(c1[r]); }
    }
    __syncthreads();
}

__device__ __forceinline__ void ml_scan_item(Frame& F, int item) {
    const int tid = F.tid; const int bhd = item >> 4, part = item & 15;
    LAS float* SM = (LAS float*)(F.lds + RING_OFF);
    float* S = WSP(float, WS_MLS);
    if (tid < 64) SM[tid] = S[bhd * 64 + tid]; else if (tid < 128) SM[tid] = S[1024 + bhd * 64 + (tid - 64)];
    unsigned* Cw = WSP(unsigned, WS_C) + (size_t)bhd * 64 * 8192 + (size_t)(part * 8 + (tid >> 6)) * 64 + (tid & 63);
    unsigned cl[64];
#pragma unroll
    for (int j = 0; j < 64; ++j) cl[j] = Cw[(size_t)j * 8192];
    const bool do_n = (part == 0 && tid < 128);
    float* Nw = WSP(float, WS_MLN) + (size_t)bhd * 64 * 128 + (tid & 127);
    float nlv[64];
#pragma unroll
    for (int j = 0; j < 64; ++j) nlv[j] = do_n ? Nw[(size_t)j * 128] : 0.f;
    __syncthreads();
    float c0 = 0.f, c1 = 0.f, m = 0.f, n = 0.f;
#pragma unroll
    for (int j = 0; j < 64; ++j) {
        const float ml = SM[j], bl = SM[64 + j];
        Cw[(size_t)j * 8192] = cvtpk(c0, c1);
        const float nl = nlv[j]; if (do_n) Nw[(size_t)j * 128] = n;
        if (part == 0 && tid == 0) S[2048 + bhd * 64 + j] = m;
        const float mn = fmaxf(bl + m, ml), a = __expf(bl + m - mn), g = __expf(ml - mn);
        c0 = a * c0 + g * bf_lo(cl[j]); c1 = a * c1 + g * bf_hi(cl[j]); n = a * n + g * nl; m = mn;
    }
    __syncthreads();
}

__device__ __forceinline__ void mlc_unit(Frame& F, int u) {
    const int tid = F.tid, lane = F.lane, wave = F.wave, r32 = lane & 31, hi = lane >> 5;
    const int bhd = u >> 6, ch = u & 63, b = bhd >> 2, hd = bhd & 3;
    const size_t rowbase = (size_t)b * SEQ; const int t0 = ch * 128;
    LAS unsigned char* L = F.lds + RING_OFF;
    LAS bf16* QS = (LAS bf16*)(L + ML_T0); LAS bf16* KS = (LAS bf16*)(L + ML_T1); LAS bf16* VT = (LAS bf16*)(L + ML_T2);
    LAS float* AA = (LAS float*)(L + ML_SM); LAS float* MM = AA + 128; LAS float* AT = AA + 256; LAS float* EM = AA + 384; LAS float* NP = AA + 512; LAS float* NQ = AA + 640; LAS float* INV = AA + 768;
    const bf16* PROJ = WSP(bf16, WS_PROJ);
    const float* GI = WSP(float, WS_GI); const float* GF = WSP(float, WS_GF);
    const float mprev = WSP(float, WS_MLS)[2048 + u];
    if (wave == 0) {
        const size_t r0 = rowbase + t0 + 2 * lane;
        const float f0 = GF[r0 * 4 + hd], f1 = GF[(r0 + 1) * 4 + hd], i0 = GI[r0 * 4 + hd], i1 = GI[(r0 + 1) * 4 + hd];
        float c0, c1; scan_add128(f0, f1, lane, c0, c1);
        const float a0 = i0 - c0, a1 = i1 - c1;
        float p0, p1; scan_max128(a0, a1, lane, p0, p1);
        const float m0 = fmaxf(mprev, p0), m1 = fmaxf(mprev, p1);
        AA[2 * lane] = a0; AA[2 * lane + 1] = a1; MM[2 * lane] = m0; MM[2 * lane + 1] = m1;
        AT[2 * lane] = __expf(mprev - m0); AT[2 * lane + 1] = __expf(mprev - m1);
        EM[2 * lane] = __expf(-(c0 + m0)); EM[2 * lane + 1] = __expf(-(c1 + m1));
    } else if (wave == 1) {
        const float* Np = WSP(float, WS_MLN) + (size_t)u * 128; NP[2 * lane] = Np[2 * lane]; NP[2 * lane + 1] = Np[2 * lane + 1];
    }
    ml_stage_conv<false>(F, PROJ + 3 * SLAB + rowbase * 512 + hd * 128, t0, F.in[7] + hd * 128, F.in[8] + hd * 128, 1.0f, QS);
    ml_stage_conv<false>(F, PROJ + 4 * SLAB + rowbase * 512 + hd * 128, t0, F.in[7] + 512 + hd * 128, F.in[8] + 512 + hd * 128, 0.08838834764831845f, KS);
    {
        const bf16* Vs = PROJ + 5 * SLAB + (rowbase + t0) * 512 + hd * 128;
        const int cg = tid & 15, rr = tid >> 4;
#pragma unroll
        for (int p = 0; p < 4; ++p) { const int s = p * 32 + rr; const v4u rv = *(const v4u*)(Vs + (size_t)s * 512 + cg * 8);
            LAS bf16* d = VT + (cg * 8) * 136 + s;
            d[0 * 136] = (bf16)(rv.x & 0xffffu); d[1 * 136] = (bf16)(rv.x >> 16); d[2 * 136] = (bf16)(rv.y & 0xffffu); d[3 * 136] = (bf16)(rv.y >> 16);
            d[4 * 136] = (bf16)(rv.z & 0xffffu); d[5 * 136] = (bf16)(rv.z >> 16); d[6 * 136] = (bf16)(rv.w & 0xffffu); d[7 * 136] = (bf16)(rv.w >> 16); }
    }
    __syncthreads();
    if (tid < 128) {
        float n = 0.f; const LAS bf16* qrow = QS + tid * 136;
#pragma unroll 4
        for (int e8 = 0; e8 < 16; ++e8) { const v4u qv = *(const LAS v4u*)(qrow + e8 * 8); const LAS float* np = NP + e8 * 8;
            n += np[0] * bf_lo(qv.x) + np[1] * bf_hi(qv.x) + np[2] * bf_lo(qv.y) + np[3] * bf_hi(qv.y) + np[4] * bf_lo(qv.z) + np[5] * bf_hi(qv.z) + np[6] * bf_lo(qv.w) + np[7] * bf_hi(qv.w); }
        NQ[tid] = n;
    }
    const int tt = wave >> 1, dh = wave & 1;
    f32x16 acc0, acc1;
#pragma unroll
    for (int r = 0; r < 16; ++r) { acc0[r] = 0.f; acc1[r] = 0.f; }
    {
        const bf16* Cg = WSP(bf16, WS_C) + (size_t)u * 16384;
#pragma unroll
        for (int ks = 0; ks < 8; ++ks) { const bf16x8 a = *(const LAS bf16x8*)(QS + (32 * tt + r32) * 136 + 16 * ks + 8 * hi);
            const bf16x8 b0 = *(const bf16x8*)(Cg + (size_t)(64 * dh + r32) * 128 + 16 * ks + 8 * hi), b1 = *(const bf16x8*)(Cg + (size_t)(64 * dh + 32 + r32) * 128 + 16 * ks + 8 * hi);
            acc0 = MFMA32(a, b0, acc0); acc1 = MFMA32(a, b1, acc1); }
#pragma unroll
        for (int r = 0; r < 16; ++r) { const float at = AT[32 * tt + crow(r, hi)]; acc0[r] *= at; acc1[r] *= at; }
    }
    float den = 0.f;
    const int tg = 32 * tt + r32; const float mmt = MM[tg];
    for (int st = 0; st <= tt; ++st) {
        f32x16 sT;
#pragma unroll
        for (int r = 0; r < 16; ++r) sT[r] = 0.f;
#pragma unroll
        for (int ks = 0; ks < 8; ++ks) { const bf16x8 a = *(const LAS bf16x8*)(KS + (32 * st + r32) * 136 + 16 * ks + 8 * hi); const bf16x8 bq = *(const LAS bf16x8*)(QS + (32 * tt + r32) * 136 + 16 * ks + 8 * hi);
            sT = MFMA32(a, bq, sT); }
        float p[16];
#pragma unroll
        for (int r = 0; r < 16; ++r) { const int s = 32 * st + crow(r, hi); const float wgt = (s <= tg) ? __expf(AA[s] - mmt) : 0.f; p[r] = sT[r] * wgt; den += p[r]; }
#pragma unroll
        for (int s2 = 0; s2 < 2; ++s2) { v4u av; av.x = cvtpk(p[8 * s2], p[8 * s2 + 1]); av.y = cvtpk(p[8 * s2 + 2], p[8 * s2 + 3]); av.z = cvtpk(p[8 * s2 + 4], p[8 * s2 + 5]); av.w = cvtpk(p[8 * s2 + 6], p[8 * s2 + 7]);
            const bf16x8 a = __builtin_bit_cast(bf16x8, av);
#pragma unroll
            for (int d = 0; d < 2; ++d) { const LAS bf16* vp = VT + (64 * dh + 32 * d + r32) * 136 + 32 * st + 16 * s2 + 4 * hi;
                const u32x2 b0 = *(const LAS u32x2*)vp, b1 = *(const LAS u32x2*)(vp + 8);
                v4u bv; bv.x = b0.x; bv.y = b0.y; bv.z = b1.x; bv.w = b1.y; const bf16x8 bb = __builtin_bit_cast(bf16x8, bv);
                if (d == 0) acc0 = MFMA32(a, bb, acc0); else acc1 = MFMA32(a, bb, acc1); } }
    }
    { auto rr = __builtin_amdgcn_permlane32_swap(__float_as_uint(den), __float_as_uint(den), false, false); den = __uint_as_float(rr[0]) + __uint_as_float(rr[1]); }
    __syncthreads();
    if (dh == 0 && hi == 0) { const float dn = AT[tg] * NQ[tg] + den; INV[tg] = 1.0f / fmaxf(fabsf(dn), EM[tg]); }
    __syncthreads();
    {
        const bf16* Og = PROJ + 6 * SLAB + (rowbase + t0) * 512 + hd * 128 + 64 * dh + r32;
        bf16* Out = WSP(bf16, WS_OML) + (rowbase + t0) * 512 + hd * 128 + 64 * dh + r32;
#pragma unroll
        for (int r = 0; r < 16; ++r) { const int t = 32 * tt + crow(r, hi); const float iv = INV[t];
            const float g0 = sigmoidf_fast(bf_lo((unsigned)Og[(size_t)t * 512])), g1 = sigmoidf_fast(bf_lo((unsigned)Og[(size_t)t * 512 + 32]));
            Out[(size_t)t * 512] = (bf16)f2bf(acc0[r] * iv * g0); Out[(size_t)t * 512 + 32] = (bf16)f2bf(acc1[r] * iv * g1); }
    }
    __syncthreads();
}
__device__ __forceinline__ void p7_ln1_tables(Frame& F) {
    const int gw = F.vcu * NWAVES + F.wave, NGW = F.G * NWAVES, lane = F.lane;
    const float* g1 = F.in[12]; const float* b1 = F.in[13];
    f32x4 gv[4], bv[4];
#pragma unroll
    for (int j = 0; j < 4; ++j) { gv[j] = *(const f32x4*)(g1 + 256 * j + 4 * lane); bv[j] = *(const f32x4*)(b1 + 256 * j + 4 * lane); }
    const float* PRE = WSP(float, WS_PRE1); bf16* H1B = WSP(bf16, WS_H1B);
    for (int m = gw; m < M; m += NGW) {
        const GAS f32x4* xr = (const GAS f32x4*)(PRE + (size_t)m * DM) + lane;
        f32x4 v[4]; float s = 0.f;
#pragma unroll
        for (int j = 0; j < 4; ++j) { v[j] = xr[64 * j]; s += (v[j].x + v[j].y) + (v[j].z + v[j].w); }
        const float mean = wave_sum(s) * (1.f / DM); float s2 = 0.f;
#pragma unroll
        for (int j = 0; j < 4; ++j) { v[j] = v[j] - mean; s2 += (v[j].x * v[j].x + v[j].y * v[j].y) + (v[j].z * v[j].z + v[j].w * v[j].w); }
        const float rstd = 1.f / sqrtf(wave_sum(s2) * (1.f / DM) + LN_EPS);
        GAS unsigned long long* o8 = (GAS unsigned long long*)(H1B + (size_t)m * DM) + lane;
#pragma unroll
        for (int j = 0; j < 4; ++j) { const f32x4 y = v[j] * rstd * gv[j] + bv[j]; o8[64 * j] = (unsigned long long)pk2(y.x, y.y) | ((unsigned long long)pk2(y.z, y.w) << 32); }
    }
    const size_t nchunk = (size_t)16384 * 1024 / 8, stride = (size_t)F.G * NWAVES * 64;
#pragma unroll 1
    for (int tb = 0; tb < 2; ++tb) { const float* src = F.in[17 + tb]; bf16* dst = WSP(bf16, tb == 0 ? WS_UT : WS_VT);
        for (size_t i = (size_t)F.vcu * NWAVES * 64 + F.tid; i < nchunk; i += stride) {
            const f32x4 a = *(const GAS f32x4*)(src + i * 8), b = *(const GAS f32x4*)(src + i * 8 + 4);
            v4u o; o.x = pk2(a.x, a.y); o.y = pk2(a.z, a.w); o.z = pk2(b.x, b.y); o.w = pk2(b.z, b.w);
            *(GAS v4u*)(dst + i * 8) = o; } }
}

constexpr int RT_K1 = 0, RT_K2 = 34816, RT_VL = 69632, RT_FL = 102400;
__device__ __forceinline__ float max3f(float a, float b, float c) { return fmaxf(fmaxf(a, b), c); }
__device__ __forceinline__ void p9_route(Frame& F) {
    const int tid = F.tid, lane = F.lane, wave = F.wave, r32 = lane & 31, hi = lane >> 5;
    LAS unsigned char* L = F.lds + RING_OFF;
    for (int i = tid; i < 2 * 128 * 32; i += NWAVES * 64) { const int which = i >> 12, row = (i >> 5) & 127, c4 = (i & 31) * 4;
        const f32x4 a = *(const f32x4*)(F.in[15 + which] + row * 128 + c4);
        u32x2 o; o.x = pk2(a.x, a.y); o.y = pk2(a.z, a.w);
        *(LAS u32x2*)(L + (which ? RT_K2 : RT_K1) + row * 272 + c4 * 2) = o; }
    __syncthreads();
    const bf16* Q = WSP(bf16, WS_Q); int* IDX = WSP(int, WS_IDX); float* GATE = WSP(float, WS_GATE);
    LAS float* VL = (LAS float*)(L + RT_VL) + (wave * 32 + r32) * 32;
    LAS float* FLs = (LAS float*)(L + RT_FL) + (wave * 32 + r32) * 16;
    const int gw = F.vcu * NWAVES + wave, NGW = F.G * NWAVES;
    for (int unit = gw; unit < (M / 32) * 8; unit += NGW) {
        const int tg = unit >> 3, hd = unit & 7; const size_t tok = (size_t)tg * 32 + r32;
        const bf16* qp = Q + tok * 2048 + hd * 256;
#pragma unroll 1
        for (int half = 0; half < 2; ++half) {
            f32x16 s0, s1, s2, s3;
#pragma unroll
            for (int r = 0; r < 16; ++r) { s0[r] = 0.f; s1[r] = 0.f; s2[r] = 0.f; s3[r] = 0.f; }
            const LAS unsigned char* KB = L + (half ? RT_K2 : RT_K1);
#pragma unroll
            for (int ks = 0; ks < 8; ++ks) { const bf16x8 bq = *(const bf16x8*)(qp + half * 128 + ks * 16 + hi * 8);
                const LAS unsigned char* ka = KB + r32 * 272 + (16 * ks + 8 * hi) * 2;
                s0 = MFMA32(*(const LAS bf16x8*)(ka), bq, s0); s1 = MFMA32(*(const LAS bf16x8*)(ka + 32 * 272), bq, s1);
                s2 = MFMA32(*(const LAS bf16x8*)(ka + 64 * 272), bq, s2); s3 = MFMA32(*(const LAS bf16x8*)(ka + 96 * 272), bq, s3); }
#pragma unroll
            for (int r = 0; r < 16; ++r) { const unsigned key = (unsigned)crow(r, hi);
                s0[r] = __uint_as_float((__float_as_uint(s0[r]) & ~127u) | key); s1[r] = __uint_as_float((__float_as_uint(s1[r]) & ~127u) | (key + 32u));
                s2[r] = __uint_as_float((__float_as_uint(s2[r]) & ~127u) | (key + 64u)); s3[r] = __uint_as_float((__float_as_uint(s3[r]) & ~127u) | (key + 96u)); }
#pragma unroll 1
            for (int it = 0; it < 16; ++it) {
                float m = max3f(s0[0], s1[0], s2[0]); m = fmaxf(m, s3[0]);
#pragma unroll
                for (int r = 1; r < 16; ++r) { m = max3f(m, s0[r], s1[r]); m = max3f(m, s2[r], s3[r]); }
                auto rr = __builtin_amdgcn_permlane32_swap(__float_as_uint(m), __float_as_uint(m), false, false);
                const float gm = fmaxf(__uint_as_float(rr[0]), __uint_as_float(rr[1]));
#pragma unroll
                for (int r = 0; r < 16; ++r) { s0[r] = (s0[r] == gm) ? -INFINITY : s0[r]; s1[r] = (s1[r] == gm) ? -INFINITY : s1[r]; s2[r] = (s2[r] == gm) ? -INFINITY : s2[r]; s3[r] = (s3[r] == gm) ? -INFINITY : s3[r]; }
                if (hi == 0) VL[half * 16 + it] = gm;
            }
        }
        float l1[16], l2[16];
#pragma unroll
        for (int i = 0; i < 16; ++i) { l1[i] = __uint_as_float(__float_as_uint(VL[i]) & ~127u); l2[i] = __uint_as_float(__float_as_uint(VL[16 + i]) & ~127u); }
        float cand[50];
        {
            int n = 0;
#pragma unroll
            for (int i = 0; i < 16; ++i)
#pragma unroll
                for (int j = 0; j < 16; ++j) if ((i + 1) * (j + 1) <= 16) { cand[n] = __uint_as_float((__float_as_uint(l1[i] + l2[j]) & ~255u) | (unsigned)(i * 16 + j)); ++n; }
        }
#pragma unroll 1
        for (int it = 0; it < 16; ++it) {
            float m = cand[0];
#pragma unroll
            for (int c = 1; c < 50; ++c) m = fmaxf(m, cand[c]);
#pragma unroll
            for (int c = 0; c < 50; ++c) cand[c] = (cand[c] == m) ? -INFINITY : cand[c];
            if (hi == 0) FLs[it] = m;
        }
        const float top = __uint_as_float(__float_as_uint(FLs[0]) & ~255u);
        float esum = 0.f, ev[8]; int ex[8];
#pragma unroll
        for (int k = 0; k < 16; ++k) { const unsigned bits = __float_as_uint(FLs[k]); const float e = __expf(__uint_as_float(bits & ~255u) - top); esum += e;
            if ((k >> 3) == hi) { ev[k & 7] = e; const int ci = (bits >> 4) & 15, cj = bits & 15;
                ex[k & 7] = (int)((__float_as_uint(VL[ci]) & 127u) * 128u + (__float_as_uint(VL[16 + cj]) & 127u)); } }
        const float inv = 1.0f / esum;
        int* ip = IDX + tok * 128 + hd * 16 + hi * 8; float* gp = GATE + tok * 128 + hd * 16 + hi * 8;
        *(int4*)ip = make_int4(ex[0], ex[1], ex[2], ex[3]); *(int4*)(ip + 4) = make_int4(ex[4], ex[5], ex[6], ex[7]);
        *(f32x4*)gp = (f32x4){ev[0] * inv, ev[1] * inv, ev[2] * inv, ev[3] * inv}; *(f32x4*)(gp + 4) = (f32x4){ev[4] * inv, ev[5] * inv, ev[6] * inv, ev[7] * inv};
    }
    __syncthreads();
}

__device__ __forceinline__ float gelu_erf(float x) { return 0.5f * x * (1.0f + erff(x * 0.70710678118654752f)); }
#define AXPY8(ACC, O, V4, C) do { ACC[O + 0] += (C) * bf_lo((V4).x); ACC[O + 1] += (C) * bf_hi((V4).x); ACC[O + 2] += (C) * bf_lo((V4).y); ACC[O + 3] += (C) * bf_hi((V4).y); \
        ACC[O + 4] += (C) * bf_lo((V4).z); ACC[O + 5] += (C) * bf_hi((V4).z); ACC[O + 6] += (C) * bf_lo((V4).w); ACC[O + 7] += (C) * bf_hi((V4).w); } while (0)
__device__ __forceinline__ float dot8(const v4u& a, const v4u& b, float acc) { acc = dot2_bf16(a.x, b.x, acc); acc = dot2_bf16(a.y, b.y, acc); acc = dot2_bf16(a.z, b.z, acc); return dot2_bf16(a.w, b.w, acc); }
__device__ __forceinline__ void p10_experts(Frame& F) {
    const int lane = F.lane; const int gw = F.vcu * NWAVES + F.wave, NGW = F.G * NWAVES;
    const bf16* H1B = WSP(bf16, WS_H1B); const bf16* PLE = WSP(bf16, WS_PLE); const int* IDX = WSP(int, WS_IDX); const float* GATE = WSP(float, WS_GATE);
    const v4u* UT = WSP(v4u, WS_UT); const v4u* VTb = WSP(v4u, WS_VT);
    const float* g2 = F.in[21]; const float* b2 = F.in[22];
    const bool up32 = (lane & 32) != 0, up16 = (lane & 16) != 0;
    for (int tok = gw; tok < M; tok += NGW) {
        const v4u hA = *((const v4u*)(H1B + (size_t)tok * 1024) + lane), hB = *((const v4u*)(H1B + (size_t)tok * 1024) + 64 + lane);
        const int idx0 = IDX[(size_t)tok * 128 + lane], idx1 = IDX[(size_t)tok * 128 + 64 + lane];
        const float gt0 = GATE[(size_t)tok * 128 + lane], gt1 = GATE[(size_t)tok * 128 + 64 + lane];
        float acc[16];
#pragma unroll
        for (int i = 0; i < 16; ++i) acc[i] = 0.f;
        v4u UA[4][2], VA[4][2], UB[4][2], VB[4][2];
#define P10_ISSUE(U, V, c) do { const int iv_ = ((c) < 16) ? idx0 : idx1; _Pragma("unroll") for (int k = 0; k < 4; ++k) { \
            const int e_ = __builtin_amdgcn_readlane(iv_, (((c) * 4 + k) & 63)); const v4u* up_ = UT + (size_t)e_ * 128 + lane; const v4u* vp_ = VTb + (size_t)e_ * 128 + lane; \
            U[k][0] = up_[0]; U[k][1] = up_[64]; V[k][0] = vp_[0]; V[k][1] = vp_[64]; } } while (0)
#define P10_COMPUTE(U, V, c) do { float d[4]; \
            _Pragma("unroll") for (int k = 0; k < 4; ++k) d[k] = dot8(U[k][1], hB, dot8(U[k][0], hA, 0.f)); \
            float a0 = up32 ? d[2] : d[0]; const float s0 = up32 ? d[0] : d[2]; a0 += __shfl_xor(s0, 32); \
            float a1 = up32 ? d[3] : d[1]; const float s1 = up32 ? d[1] : d[3]; a1 += __shfl_xor(s1, 32); \
            float c0 = up16 ? a1 : a0; const float s2 = up16 ? a0 : a1; c0 += __shfl_xor(s2, 16); \
            c0 += __shfl_xor(c0, 8); c0 += __shfl_xor(c0, 4); c0 += __shfl_xor(c0, 2); c0 += __shfl_xor(c0, 1); \
            const float gsel = ((c) < 16) ? gt0 : gt1; \
            const float gk = __shfl(gsel, (((c) * 4) & 63) + (lane >> 4)); \
            const float coef = gk * gelu_erf(c0); \
            _Pragma("unroll") for (int k = 0; k < 4; ++k) { const float ck = __uint_as_float(__builtin_amdgcn_readlane(__float_as_uint(coef), 16 * k)); AXPY8(acc, 0, V[k][0], ck); AXPY8(acc, 8, V[k][1], ck); } } while (0)
        P10_ISSUE(UA, VA, 0);
#pragma unroll 1
        for (int c = 0; c < 32; c += 2) {
            P10_ISSUE(UB, VB, c + 1);
            P10_COMPUTE(UA, VA, c);
            if (c + 2 < 32) P10_ISSUE(UA, VA, c + 2);
            P10_COMPUTE(UB, VB, c + 1);
        }
#undef P10_COMPUTE
#undef P10_ISSUE
        const v4u pA = *((const v4u*)(PLE + (size_t)tok * 1024) + lane), pB = *((const v4u*)(PLE + (size_t)tok * 1024) + 64 + lane);
        float y[16];
        y[0] = ALPHA * bf_lo(hA.x) + acc[0] + bf_lo(pA.x); y[1] = ALPHA * bf_hi(hA.x) + acc[1] + bf_hi(pA.x); y[2] = ALPHA * bf_lo(hA.y) + acc[2] + bf_lo(pA.y); y[3] = ALPHA * bf_hi(hA.y) + acc[3] + bf_hi(pA.y);
        y[4] = ALPHA * bf_lo(hA.z) + acc[4] + bf_lo(pA.z); y[5] = ALPHA * bf_hi(hA.z) + acc[5] + bf_hi(pA.z); y[6] = ALPHA * bf_lo(hA.w) + acc[6] + bf_lo(pA.w); y[7] = ALPHA * bf_hi(hA.w) + acc[7] + bf_hi(pA.w);
        y[8] = ALPHA * bf_lo(hB.x) + acc[8] + bf_lo(pB.x); y[9] = ALPHA * bf_hi(hB.x) + acc[9] + bf_hi(pB.x); y[10] = ALPHA * bf_lo(hB.y) + acc[10] + bf_lo(pB.y); y[11] = ALPHA * bf_hi(hB.y) + acc[11] + bf_hi(pB.y);
        y[12] = ALPHA * bf_lo(hB.z) + acc[12] + bf_lo(pB.z); y[13] = ALPHA * bf_hi(hB.z) + acc[13] + bf_hi(pB.z); y[14] = ALPHA * bf_lo(hB.w) + acc[14] + bf_lo(pB.w); y[15] = ALPHA * bf_hi(hB.w) + acc[15] + bf_hi(pB.w);
        float s = 0.f;
#pragma unroll
        for (int i = 0; i < 16; ++i) s += y[i];
        const float mean = wave_sum(s) * (1.f / DM); float s2 = 0.f;
#pragma unroll
        for (int i = 0; i < 16; ++i) { y[i] -= mean; s2 += y[i] * y[i]; }
        const float rstd = 1.f / sqrtf(wave_sum(s2) * (1.f / DM) + LN_EPS);
        float* op = F.out + (size_t)tok * 1024 + 8 * lane;
#pragma unroll
        for (int hh = 0; hh < 2; ++hh) { const float* gp = g2 + 512 * hh + 8 * lane; const float* bp = b2 + 512 * hh + 8 * lane;
            const f32x4 ga = *(const f32x4*)gp, gb = *(const f32x4*)(gp + 4), ba = *(const f32x4*)bp, bb = *(const f32x4*)(bp + 4);
            f32x4 oa, ob;
            oa.x = y[8 * hh + 0] * rstd * ga.x + ba.x; oa.y = y[8 * hh + 1] * rstd * ga.y + ba.y; oa.z = y[8 * hh + 2] * rstd * ga.z + ba.z; oa.w = y[8 * hh + 3] * rstd * ga.w + ba.w;
            ob.x = y[8 * hh + 4] * rstd * gb.x + bb.x; ob.y = y[8 * hh + 5] * rstd * gb.y + bb.y; ob.z = y[8 * hh + 6] * rstd * gb.z + bb.z; ob.w = y[8 * hh + 7] * rstd * gb.w + bb.w;
            *(f32x4*)(op + 512 * hh) = oa; *(f32x4*)(op + 512 * hh + 4) = ob; }
    }
}
struct Args { const float* in[23]; float* out; unsigned char* ws; int ph_lo, ph_hi, li, pad; };
__global__ void __launch_bounds__(NWAVES * 64, 2) fwd_kernel(Args args) {
    extern __shared__ __attribute__((aligned(16))) unsigned char lds[];
    Frame F;
    F.lds = (LAS unsigned char*)lds;
    F.MISC = (volatile LAS unsigned*)(F.lds + MISC_OFF);
    F.tid = threadIdx.x; F.lane = F.tid & 63; F.wave = __builtin_amdgcn_readfirstlane(F.tid >> 6);
    F.G = gridDim.x; { const int bx = blockIdx.x; F.vcu = (F.G % 8 == 0) ? (bx % 8) * (F.G / 8) + bx / 8 : bx; }
    F.ws = args.ws; F.out = args.out; F.in = args.in;
    F.ctl = (gu32*)(F.ws + WS_CTL);
    for (int u = F.tid; u < (LDS_BYTES - LDSCTL_OFF) / 4; u += NWAVES * 64) ((LAS unsigned*)(F.lds + LDSCTL_OFF))[u] = 0u;
    __syncthreads();
    XcdBarrier bar; bar.bar = (unsigned*)(F.ctl + CW_BAR); bar.x = 0; bar.st = nullptr;
    if (N_LAUNCHES == 1) bar = xcd_barrier_post((unsigned*)(F.ctl + CW_BAR), F.MISC + 8);
#define GRID_BAR() do { if (N_LAUNCHES == 1) xcd_barrier(bar); } while (0)
    const int lo = args.ph_lo, hi = args.ph_hi;
#ifndef PH_MASK
#define PH_MASK 0x7ff
#endif
#define IN(k) (((PH_MASK >> (k)) & 1) && lo <= (k) && (k) < hi)
#define BOTH(k) (IN(k) && IN((k) + 1))
    const int bx = (int)blockIdx.x;

    if (IN(0)) { p0_prologue(F); if (BOTH(0)) GRID_BAR(); }

    if (IN(1)) {
        pg8::Gemm g{WSP(bf16, WS_XN), WSP(bf16, WS_WIN_T), M, NPROJ, DM}; pg8::StaticOrder S; S.init(M, NPROJ, F.G, bx);
        pg8::EpiBf16<0> E{WSP(bf16, WS_PROJ), 512, nullptr, 512, SLAB, C2};
        pg8::gemm_phase<pg8::EpiBf16<0>, pg8::StaticOrder, PG8_ALIGN, PG8_SP2>(F.lds + RING_OFF, g, S, E);
        if (BOTH(1)) GRID_BAR();
    }

    if (IN(2)) {
        if (F.G == 256) { const int bh = F.vcu >> 3, s = F.vcu & 7;
            for (int i = 0; i < 4; ++i) { const int qb = (i == 0) ? s : (i == 1) ? 15 - s : (i == 2) ? 16 + s : 31 - s; attn_unit(F, bh, qb); } }
        else { for (int u = F.vcu; u < 1024; u += F.G) attn_unit(F, u >> 5, u & 31); }
        for (int u = F.vcu; u < N_MLU; u += F.G) mla_unit(F, u);
        if (BOTH(2)) GRID_BAR();
    }

    if (IN(3)) { for (int it = F.vcu; it < 256; it += F.G) ml_scan_item(F, it); if (BOTH(3)) GRID_BAR(); }

    if (IN(4)) { for (int u = F.vcu; u < N_MLU; u += F.G) mlc_unit(F, u); if (BOTH(4)) GRID_BAR(); }

    if (IN(5)) {
        { pg8::Gemm g{WSP(bf16, WS_OSB), WSP(bf16, WS_WSB_T), M, DM, 512}; pg8::StaticOrder S; S.init(M, DM, F.G, bx);
          pg8::EpiGate<false> E{WSP(bf16, WS_Y), WSP(bf16, WS_PROJ) + 7 * SLAB};
          pg8::gemm_phase<pg8::EpiGate<false>, pg8::StaticOrder, PG8_ALIGN, PG8_SP2>(F.lds + RING_OFF, g, S, E); }
        { pg8::Gemm g{WSP(bf16, WS_OML), WSP(bf16, WS_WML_T), M, DM, 512}; pg8::StaticOrder S; S.init(M, DM, F.G, bx);
          pg8::EpiGate<true> E{WSP(bf16, WS_Y), WSP(bf16, WS_PROJ) + 9 * SLAB};
          pg8::gemm_phase<pg8::EpiGate<true>, pg8::StaticOrder, PG8_ALIGN, PG8_SP2>(F.lds + RING_OFF, g, S, E); }
        if (BOTH(5)) GRID_BAR();
    }

    if (IN(6)) {
        { pg8::Gemm g{WSP(bf16, WS_Y), WSP(bf16, WS_WOUT_T), M, DM, DM}; pg8::StaticOrder S; S.init(M, DM, F.G, bx);
          pg8::EpiPre1 E{WSP(float, WS_PRE1), F.in[0], WSP(float, WS_STATS), F.in[2], F.in[3]};
          pg8::gemm_phase<pg8::EpiPre1, pg8::StaticOrder, PG8_ALIGN, PG8_SP2>(F.lds + RING_OFF, g, S, E); }
        { pg8::Gemm g{WSP(bf16, WS_PB), WSP(bf16, WS_WPLE_T), M, DM, 256}; pg8::StaticOrder S; S.init(M, DM, F.G, bx);
          pg8::EpiBf16<0> E{WSP(bf16, WS_PLE), DM, nullptr, 0, 0, 1.f};
          pg8::gemm_phase<pg8::EpiBf16<0>, pg8::StaticOrder, PG8_ALIGN, PG8_SP2>(F.lds + RING_OFF, g, S, E); }
        if (BOTH(6)) GRID_BAR();
    }

    if (IN(7)) { p7_ln1_tables(F); if (BOTH(7)) GRID_BAR(); }

    if (IN(8)) {
        pg8::Gemm g{WSP(bf16, WS_H1B), WSP(bf16, WS_WQG_T), M, 3072, DM}; pg8::StaticOrder S; S.init(M, 3072, F.G, bx);
        pg8::EpiQG E{WSP(bf16, WS_Q), WSP(bf16, WS_PLE)};
        pg8::gemm_phase<pg8::EpiQG, pg8::StaticOrder, PG8_ALIGN, PG8_SP2>(F.lds + RING_OFF, g, S, E);
        if (BOTH(8)) GRID_BAR();
    }

    if (IN(9)) { p9_route(F); if (BOTH(9)) GRID_BAR(); }

    if (IN(10)) { p10_experts(F); }
#undef IN
#undef BOTH
#undef GRID_BAR
}

extern "C" void kernel_launch(void* const* d_in, const int* in_sizes, int n_in, void* d_out, int out_size, void* d_ws, size_t ws_size, hipStream_t stream) {
    static int grid = 0;
    if (grid == 0) {
        if (n_in != 23 || in_sizes[0] != M * DM || out_size != M * DM || ws_size < WS_END) {
            fprintf(stderr, "kernel_launch: built for 23 inputs, x/out of %d floats, >= %zu bytes of workspace; got n_in %d, in0 %d, out %d, ws %zu; nothing launched\n", M * DM, (size_t)WS_END, n_in, n_in > 0 ? in_sizes[0] : -1, out_size, ws_size);
            grid = -1; return; }
        int dev = 0, cus = 0;
        if (hipGetDevice(&dev) != hipSuccess || hipDeviceGetAttribute(&cus, hipDeviceAttributeMultiprocessorCount, dev) != hipSuccess) { fprintf(stderr, "kernel_launch: device query failed\n"); grid = -1; return; }
        if (hipFuncSetAttribute((const void*)fwd_kernel, hipFuncAttributeMaxDynamicSharedMemorySize, LDS_BYTES) != hipSuccess) { fprintf(stderr, "kernel_launch: hipFuncSetAttribute failed\n"); grid = -1; return; }
        int per_cu = 0;
        if (hipOccupancyMaxActiveBlocksPerMultiprocessor(&per_cu, (const void*)fwd_kernel, NWAVES * 64, LDS_BYTES) != hipSuccess || per_cu < 1)
            fprintf(stderr, "kernel_launch: note: occupancy query reports %d workgroups per CU\n", per_cu);
        (void)hipGetLastError();
        grid = cus;
    }
    if (grid < 0) return;
    if (hipMemsetAsync((char*)d_ws + WS_CTL, 0, CTL_ZERO_BYTES, stream) != hipSuccess) { fprintf(stderr, "kernel_launch: hipMemsetAsync failed\n"); return; }
    Args a{};
    for (int i = 0; i < 23; ++i) a.in[i] = (const float*)d_in[i];
    a.out = (float*)d_out; a.ws = (unsigned char*)d_ws;
    for (int li = 0; li < N_LAUNCHES; ++li) {
        if (N_LAUNCHES == 1) { a.ph_lo = 0; a.ph_hi = N_PHASES; } else { a.ph_lo = li; a.ph_hi = li + 1; }
        a.li = li;
        hipLaunchKernelGGL(fwd_kernel, dim3(grid), dim3(NWAVES * 64), LDS_BYTES, stream, a);
        const hipError_t le = hipPeekAtLastError();
        if (le != hipSuccess) { fprintf(stderr, "kernel_launch: launch %d failed: %s\n", li, hipGetErrorName(le)); break; }
    }
}
```

```cpp
#include <hip/hip_runtime.h>
#include <cstdio>
#include <cstdint>
#include <cmath>
namespace pg8 {
#define PG8_LAS __attribute__((address_space(3)))
typedef unsigned short bf16_t;
typedef short bf16x8 __attribute__((ext_vector_type(8)));
typedef float f32x4 __attribute__((ext_vector_type(4)));
typedef unsigned u32x4 __attribute__((ext_vector_type(4)));
constexpr int BM = 256, BK = 64, HALF = 128, HTB = HALF * BK * 2  , STAGE_BYTES = 8 * HTB, NXCD = 8, WGM = 8;

__host__ __device__ __forceinline__ int lds_byte(int r, int c) { const int st = (r >> 4) * 2 + (c >> 5), rr = r & 15, cc = c & 31, ob = rr * 64 + cc * 2; return st * 1024 + (ob ^ (((ob >> 9) & 1) << 5)); }
__host__ __device__ __forceinline__ void stage_rc(int b, int& R, int& C) { const int st = b / 1024, sb = b % 1024, swz = sb ^ (((sb >> 9) & 1) << 5); R = (st >> 1) * 16 + swz / 64; C = (st & 1) * 32 + (swz % 64) / 2; }
__host__ __device__ __forceinline__ int perm32(int rho) { const int n = rho >> 4, i = rho & 15; return 8 * (i >> 2) + 4 * n + (i & 3); }

struct Unit { int pm, pn; };
struct Gemm { const bf16_t* A; const bf16_t* Bt; int M, N, K; };

struct StaticOrder {
    int nM, nN, nwg, G, c;
    __host__ __device__ void init(int M, int N, int G_, int c_) { nM = M / BM; nN = N / BM; nwg = nM * nN; G = G_; c = c_; }
    __host__ __device__ bool next(int i, Unit& u) const {
        const long L = (long)i * G + c; if (L >= nwg) return false;
        int wgid = (int)L; { const int q = nwg / NXCD, r = nwg % NXCD, xcd = wgid % NXCD, off = wgid / NXCD; wgid = (xcd < r ? xcd * (q + 1) : r * (q + 1) + (xcd - r) * q) + off; }
        const int nig = WGM * nN, gid = wgid / nig, fm = gid * WGM, gsz = (nM - fm) < WGM ? (nM - fm) : WGM;
        u.pm = fm + ((wgid % nig) % gsz); u.pn = (wgid % nig) / gsz; return true;
    }
    __device__ __forceinline__ void a_ready(const Unit&) const {}
    __device__ __forceinline__ void done(const Unit&) const {}
};

__device__ __forceinline__ unsigned cvt_pk_bf16(float lo, float hi) { unsigned r; asm volatile("v_cvt_pk_bf16_f32 %0, %1, %2" : "=v"(r) : "v"(lo), "v"(hi)); return r; }
typedef float f32x2 __attribute__((ext_vector_type(2)));
__device__ __forceinline__ f32x2 gelu_pk(f32x2 v) {
    const f32x2 av = __builtin_elementwise_abs(v), d = av * 0.2316418882f + 1.0f;
    f32x2 t; t.x = __builtin_amdgcn_rcpf(d.x); t.y = __builtin_amdgcn_rcpf(d.y);
    f32x2 q = t * 0.5307027145f + (-0.7265760135f); q = q * t + 0.7107068705f; q = q * t + (-0.142248368f); q = q * t + 0.127414796f; q = q * t;
    const f32x2 s = (v * v) * (-0.72134752044f);
    f32x2 e; e.x = __builtin_amdgcn_exp2f(s.x); e.y = __builtin_amdgcn_exp2f(s.y);
    const f32x2 m = v * (q * e), r = v - m;
    f32x2 o; o.x = v.x < 0.f ? m.x : r.x; o.y = v.y < 0.f ? m.y : r.y; return o;
}

template <int ACT  > struct EpiBf16 {
    static constexpr bool PERM = true, AFTER_DRAIN = false; static constexpr int MID_T = -1; static_assert(ACT == 0 || ACT == 1, "EpiBf16: ACT is 0 (none) or 1 (gelu_pk)");
    bf16_t* O; int ldc; const float* bias; int split_cols; size_t split_stride; float scale0;
    __device__ __forceinline__ void operator()(const f32x4 (&acc)[2][2][4][2], const Unit& u, int wr, int wc, int fr, int fq) const {
        const int row0 = u.pm * BM + wr * 64 + fr; int colt = u.pn * BM; bf16_t* base = O;
        float sc = 1.f; if (split_cols) { const int t = colt / split_cols; base += (size_t)t * split_stride; colt -= t * split_cols; if (t == 0) sc = scale0; }
        const int col0 = colt + wc * 32 + 8 * fq, bcol0 = u.pn * BM + wc * 32 + 8 * fq;
        f32x4 bv[2][2];
#pragma unroll
        for (int bj = 0; bj < 2; ++bj)
#pragma unroll
            for (int n = 0; n < 2; ++n) bv[bj][n] = bias ? *(const f32x4*)(bias + bcol0 + bj * HALF + 4 * n) : (f32x4){0.f, 0.f, 0.f, 0.f};
#pragma unroll
        for (int ai = 0; ai < 2; ++ai)
#pragma unroll
            for (int m = 0; m < 4; ++m) { bf16_t* rowp = base + (size_t)(row0 + ai * HALF + m * 16) * ldc + col0;
#pragma unroll
                for (int bj = 0; bj < 2; ++bj) { f32x4 v0 = acc[ai][bj][m][0] + bv[bj][0], v1 = acc[ai][bj][m][1] + bv[bj][1];
                    if (ACT == 1) { f32x2 a = gelu_pk((f32x2){v0[0], v0[1]}), b = gelu_pk((f32x2){v0[2], v0[3]}), c = gelu_pk((f32x2){v1[0], v1[1]}), d = gelu_pk((f32x2){v1[2], v1[3]});
                        v0 = (f32x4){a.x, a.y, b.x, b.y}; v1 = (f32x4){c.x, c.y, d.x, d.y}; }
                    v0 = v0 * sc; v1 = v1 * sc; u32x4 w; w.x = cvt_pk_bf16(v0[0], v0[1]); w.y = cvt_pk_bf16(v0[2], v0[3]); w.z = cvt_pk_bf16(v1[0], v1[1]); w.w = cvt_pk_bf16(v1[2], v1[3]);
                    *(u32x4*)(rowp + bj * HALF) = w; } }
    }
};

struct PanelStats {
    unsigned* xbuf;
    unsigned* cnt;
    unsigned* tmo;
    int ntn; float eps;
    unsigned code;
    __device__ __forceinline__ bool run(const f32x4 (&v)[2][2][4][2], const Unit& u, int wr, int wc, int fr, int fq, PG8_LAS unsigned char* lds, int wid, int lane) const {
        typedef float f32x2v __attribute__((ext_vector_type(2)));
        PG8_LAS f32x2v* P = (PG8_LAS f32x2v*)lds;
        PG8_LAS f32x2v* S = (PG8_LAS f32x2v*)(lds + 8192);
        PG8_LAS unsigned* flag = (PG8_LAS unsigned*)(lds + 8192 + 2048);
#pragma unroll
        for (int ai = 0; ai < 2; ++ai)
#pragma unroll
            for (int m = 0; m < 4; ++m) {
                float s = 0.f;
#pragma unroll
                for (int bj = 0; bj < 2; ++bj)
#pragma unroll
                    for (int n = 0; n < 2; ++n) { const f32x4 x = v[ai][bj][m][n]; s += (x[0] + x[1]) + (x[2] + x[3]); }
                s += __shfl_xor(s, 16); s += __shfl_xor(s, 32);
                const float mw = s * (1.0f / 64.0f); float q = 0.f;
#pragma unroll
                for (int bj = 0; bj < 2; ++bj)
#pragma unroll
                    for (int n = 0; n < 2; ++n) { const f32x4 d = v[ai][bj][m][n] - mw; q += (d[0] * d[0] + d[1] * d[1]) + (d[2] * d[2] + d[3] * d[3]); }
                q += __shfl_xor(q, 16); q += __shfl_xor(q, 32);
                if (fq == 0) P[(ai * HALF + wr * 64 + m * 16 + fr) * 4 + wc] = (f32x2v){mw, q};
            }
        asm volatile("s_waitcnt lgkmcnt(0)" ::: "memory"); __builtin_amdgcn_s_barrier(); asm volatile("" ::: "memory");
#if defined(BROKEN_EXCHANGE_NO_WAIT)
#warning BROKEN CONTROL BUILD: the row-statistics exchange does not wait; results are wrong by design
        if (blockIdx.x >= 64) { const long long t0_ = clock64(); while (clock64() - t0_ < 60000) __builtin_amdgcn_s_sleep(8); }
#endif
        const int row = wid * 32 + (lane & 31);
        if (lane < 32) {
            const f32x2v a = P[row * 4 + 0], b = P[row * 4 + 1], c = P[row * 4 + 2], d = P[row * 4 + 3];
            const float mt = (a.x + b.x + c.x + d.x) * 0.25f;
            const float da = a.x - mt, db = b.x - mt, dc = c.x - mt, dd = d.x - mt;
            const float m2 = (a.y + b.y) + (c.y + d.y) + 64.0f * ((da * da + db * db) + (dc * dc + dd * dd));
            unsigned long long* slot = (unsigned long long*)xbuf + ((size_t)(u.pm * BM + row) * 4 + u.pn);
            __hip_atomic_store(slot, ((unsigned long long)__float_as_uint(m2) << 32) | __float_as_uint(mt), __ATOMIC_RELAXED, __HIP_MEMORY_SCOPE_AGENT);
        }
        asm volatile("s_waitcnt vmcnt(0)" ::: "memory");
        if (lane == 0) __hip_atomic_fetch_add(cnt + 64 * u.pm, 1u, __ATOMIC_RELAXED, __HIP_MEMORY_SCOPE_AGENT);
        if (wid == 0) {
            bool dead = false; const unsigned long long t0 = __builtin_amdgcn_s_memrealtime(); const unsigned want = 8u * (unsigned)ntn;
            for (;;) {
#if defined(BROKEN_EXCHANGE_NO_WAIT)
                break;
#endif
                if ((unsigned)__builtin_amdgcn_readfirstlane(__hip_atomic_load(cnt + 64 * u.pm, __ATOMIC_RELAXED, __HIP_MEMORY_SCOPE_AGENT)) >= want) break;
                if (__builtin_amdgcn_s_memrealtime() - t0 > 2000000ull) {
                    if (lane == 0) { unsigned expect = 0u; __hip_atomic_compare_exchange_strong(tmo + 1, &expect, code | (unsigned)(u.pm & 0xff), __ATOMIC_RELAXED, __ATOMIC_RELAXED, __HIP_MEMORY_SCOPE_AGENT);
                                     __hip_atomic_store(tmo, 1u, __ATOMIC_RELAXED, __HIP_MEMORY_SCOPE_AGENT); }
                    dead = true; break; }
                __builtin_amdgcn_s_sleep(2);
            }
            __builtin_amdgcn_fence(__ATOMIC_ACQUIRE, "agent");
            if (lane == 0) flag[0] = dead ? 1u : 0u;
        }
        asm volatile("s_waitcnt vmcnt(0) lgkmcnt(0)" ::: "memory"); __builtin_amdgcn_s_barrier(); asm volatile("" ::: "memory");
        const bool bad = flag[0] != 0u;
        if (lane < 32) {
            const unsigned long long* slot = (const unsigned long long*)xbuf + (size_t)(u.pm * BM + row) * 4; float mt[4], m2[4]; float ms = 0.f;
#pragma unroll
            for (int t = 0; t < 4; ++t) { if (t < ntn) { const unsigned long long w = __hip_atomic_load(slot + t, __ATOMIC_RELAXED, __HIP_MEMORY_SCOPE_AGENT); mt[t] = __uint_as_float((unsigned)w); m2[t] = __uint_as_float((unsigned)(w >> 32)); } else { mt[t] = 0.f; m2[t] = 0.f; } ms += mt[t]; }
            const float mean = ms / (float)ntn; float q = 0.f;
#pragma unroll
            for (int t = 0; t < 4; ++t) if (t < ntn) { const float dm = mt[t] - mean; q += m2[t] + 256.0f * dm * dm; }
            S[row] = (f32x2v){mean, 1.0f / sqrtf(q / (256.0f * (float)ntn) + eps)};
        }
        asm volatile("s_waitcnt lgkmcnt(0)" ::: "memory"); __builtin_amdgcn_s_barrier(); asm volatile("" ::: "memory");
        return bad;
    }
};
struct EpiLnRes {
    static constexpr bool PERM = false, AFTER_DRAIN = true; static constexpr int MID_T = -1;
    const float* base; float* out; int ldc; const float* bias; PanelStats st; unsigned poison;
    __device__ __forceinline__ void fused(f32x4 (&acc)[2][2][4][2], const Unit& u, int wr, int wc, int fr, int fq, PG8_LAS unsigned char* lds, int wid, int lane) const {
        typedef float f32x2v __attribute__((ext_vector_type(2)));
        const PG8_LAS f32x2v* S = (const PG8_LAS f32x2v*)(lds + 8192);
        const int col0 = u.pn * BM + wc * 32 + 4 * fq;
#pragma unroll
        for (int bj = 0; bj < 2; ++bj)
#pragma unroll
            for (int n = 0; n < 2; ++n) { const f32x4 bv = bias ? *(const f32x4*)(bias + col0 + bj * HALF + n * 16) : (f32x4){0.f, 0.f, 0.f, 0.f};
#pragma unroll
                for (int ai = 0; ai < 2; ++ai)
#pragma unroll
                    for (int m = 0; m < 4; ++m) acc[ai][bj][m][n] += bv; }
        f32x4 pre[4][2][2];
#pragma unroll
        for (int m = 0; m < 4; ++m) { const size_t off = (size_t)(u.pm * BM + wr * 64 + m * 16 + fr) * ldc + col0;
#pragma unroll
            for (int bj = 0; bj < 2; ++bj)
#pragma unroll
                for (int n = 0; n < 2; ++n) pre[m][bj][n] = *(const f32x4*)(base + off + bj * HALF + n * 16); }
        const bool bad = st.run(acc, u, wr, wc, fr, fq, lds, wid, lane) || poison != 0u;
        const float qnan = __builtin_nanf("");
#pragma unroll
        for (int ai = 0; ai < 2; ++ai)
#pragma unroll
            for (int m = 0; m < 4; ++m) { const int r = ai * HALF + wr * 64 + m * 16 + fr; const f32x2v sr = S[r]; const size_t off = (size_t)(u.pm * BM + r) * ldc + col0;
#pragma unroll
                for (int bj = 0; bj < 2; ++bj)
#pragma unroll
                    for (int n = 0; n < 2; ++n) { const f32x4 bs = ai == 0 ? pre[m][bj][n] : *(const f32x4*)(base + off + bj * HALF + n * 16); f32x4 o = bs + (acc[ai][bj][m][n] - sr.x) * sr.y;
                        if (bad) o = (f32x4){qnan, qnan, qnan, qnan}; *(f32x4*)(out + off + bj * HALF + n * 16) = o; }
                if (m & 1) asm volatile("" ::: "memory"); }
    }
};
struct EpiLnResLn {
    static constexpr bool PERM = false, AFTER_DRAIN = true; static constexpr int MID_T = -1;
    const float* base; float* out; bf16_t* xn; int ldc; const float* bias; PanelStats st1, st2; unsigned poison;
    __device__ __forceinline__ void fused(f32x4 (&acc)[2][2][4][2], const Unit& u, int wr, int wc, int fr, int fq, PG8_LAS unsigned char* lds, int wid, int lane) const {
        typedef float f32x2v __attribute__((ext_vector_type(2))); typedef unsigned u32x2v __attribute__((ext_vector_type(2)));
        const PG8_LAS f32x2v* S = (const PG8_LAS f32x2v*)(lds + 8192);
        const int col0 = u.pn * BM + wc * 32 + 4 * fq;
#pragma unroll
        for (int bj = 0; bj < 2; ++bj)
#pragma unroll
            for (int n = 0; n < 2; ++n) { const f32x4 bv = bias ? *(const f32x4*)(bias + col0 + bj * HALF + n * 16) : (f32x4){0.f, 0.f, 0.f, 0.f};
#pragma unroll
                for (int ai = 0; ai < 2; ++ai)
#pragma unroll
                    for (int m = 0; m < 4; ++m) acc[ai][bj][m][n] += bv; }
        bool bad = st1.run(acc, u, wr, wc, fr, fq, lds, wid, lane) || poison != 0u;
        const float qnan = __builtin_nanf("");
#pragma unroll
        for (int ai = 0; ai < 2; ++ai)
#pragma unroll
            for (int m = 0; m < 4; ++m) { const int r = ai * HALF + wr * 64 + m * 16 + fr; const f32x2v sr = S[r]; const size_t off = (size_t)(u.pm * BM + r) * ldc + col0;
#pragma unroll
                for (int bj = 0; bj < 2; ++bj)
#pragma unroll
                    for (int n = 0; n < 2; ++n) { const f32x4 bs = *(const f32x4*)(base + off + bj * HALF + n * 16); acc[ai][bj][m][n] = bs + (acc[ai][bj][m][n] - sr.x) * sr.y; }
                asm volatile("" : "+v"(acc[ai][0][m][0]), "+v"(acc[ai][0][m][1]), "+v"(acc[ai][1][m][0]), "+v"(acc[ai][1][m][1]));
                if (m & 1) asm volatile("" ::: "memory"); }
        const bool bad1 = bad;
        bad = st2.run(acc, u, wr, wc, fr, fq, lds, wid, lane) || bad;
#pragma unroll
        for (int ai = 0; ai < 2; ++ai)
#pragma unroll
            for (int m = 0; m < 4; ++m) { const int r = ai * HALF + wr * 64 + m * 16 + fr; const f32x2v sr = S[r]; const size_t off = (size_t)(u.pm * BM + r) * ldc + col0;
#pragma unroll
                for (int bj = 0; bj < 2; ++bj)
#pragma unroll
                    for (int n = 0; n < 2; ++n) { const f32x4 x1 = acc[ai][bj][m][n]; *(f32x4*)(out + off + bj * HALF + n * 16) = bad1 ? (f32x4){qnan, qnan, qnan, qnan} : x1;
                        const f32x4 o = (x1 - sr.x) * sr.y; u32x2v w; w.x = cvt_pk_bf16(o[0], o[1]); w.y = cvt_pk_bf16(o[2], o[3]);
                        if (bad) { w.x = 0x7fc07fc0u; w.y = 0x7fc07fc0u; } *(u32x2v*)(xn + off + bj * HALF + n * 16) = w; }
                asm volatile("" ::: "memory"); }
    }
};

template <class Epi, class Sched, bool ALIGN_EPI = false, bool SP2 = false>
__device__ __forceinline__ void gemm_phase(PG8_LAS unsigned char* lds, const Gemm g, const Sched& S, const Epi& E) {
    const int tid = threadIdx.x, wid = __builtin_amdgcn_readfirstlane(tid >> 6), lane = tid & 63, wr = wid >> 2, wc = wid & 3, fr = lane & 15, fq = lane >> 4;
    const int K = g.K, nt = K / BK;
    unsigned voffA[2], voffB[2];
#pragma unroll
    for (int i = 0; i < 2; ++i) { int R, C; stage_rc(tid * 16 + i * 8192, R, C); const int Rb = Epi::PERM ? ((R & ~31) + perm32(R & 31)) : R;
        voffA[i] = (unsigned)(R * K + C) * 2u; voffB[i] = (unsigned)(Rb * K + C) * 2u; }
    const size_t kstep = (size_t)(BK * 2);
    const size_t hstep = (size_t)HALF * K * 2;
    const size_t tstep = 2 * hstep;
    const unsigned ldsw = (unsigned)wid * 1024u;
    const int aoff = lds_byte(wr * 64 + fr, fq * 8), boff = lds_byte(wc * 32 + fr, fq * 8);
#define PG8_SA(b, h) (((b) * 2 + (h)) * HTB)
#define PG8_SB(b, h) ((4 + (b) * 2 + (h)) * HTB)
#define PG8_STAGE(bufoff, gbase, voff) do { _Pragma("unroll") for (int _i = 0; _i < 2; ++_i) \
        __builtin_amdgcn_global_load_lds((const unsigned*)((const char*)(gbase) + (voff)[_i]), (PG8_LAS unsigned*)(lds + (bufoff) + ldsw + _i * 8192), 16, 0, 0); } while (0)
#define PG8_LDA(dst, b, h) do { _Pragma("unroll") for (int m = 0; m < 4; ++m) _Pragma("unroll") for (int k = 0; k < 2; ++k) dst[m][k] = *(const PG8_LAS bf16x8*)(lds + PG8_SA(b, h) + aoff + m * 2048 + k * 1024); } while (0)
#define PG8_LDB(dst, b, h) do { _Pragma("unroll") for (int n = 0; n < 2; ++n) _Pragma("unroll") for (int k = 0; k < 2; ++k) dst[n][k] = *(const PG8_LAS bf16x8*)(lds + PG8_SB(b, h) + boff + n * 2048 + k * 1024); } while (0)
#define PG8_MMA(ai, bj, At, Bt) do { __builtin_amdgcn_s_setprio(1); _Pragma("unroll") for (int m = 0; m < 4; ++m) _Pragma("unroll") for (int n = 0; n < 2; ++n) _Pragma("unroll") for (int k = 0; k < 2; ++k) \
        acc[ai][bj][m][n] = __builtin_amdgcn_mfma_f32_16x16x32_bf16(Bt[n][k], At[m][k], acc[ai][bj][m][n], 0, 0, 0); __builtin_amdgcn_s_setprio(0); } while (0)
#define PG8_WAIT_V(n) asm volatile("s_waitcnt vmcnt(" #n ")" ::: "memory")
#define PG8_WAIT_L(n) asm volatile("s_waitcnt lgkmcnt(" #n ")" ::: "memory")
#define PG8_BAR __builtin_amdgcn_s_barrier()
#define PG8_SCHED __builtin_amdgcn_sched_barrier(0)
    Unit cur, nxt; int ui = 0;
    if (!S.next(0, cur)) return;
    f32x4 acc[2][2][4][2];
#pragma unroll
    for (int a = 0; a < 2; ++a)
#pragma unroll
        for (int b = 0; b < 2; ++b)
#pragma unroll
            for (int m = 0; m < 4; ++m)
#pragma unroll
                for (int n = 0; n < 2; ++n) acc[a][b][m][n] = (f32x4){0.f, 0.f, 0.f, 0.f};
    bf16x8 At[4][2], B0[2][2], B1[2][2];
    const char* cA = (const char*)g.A + (size_t)cur.pm * tstep; const char* cB = (const char*)g.Bt + (size_t)cur.pn * tstep;
    S.a_ready(cur);
    if constexpr (SP2) {
        PG8_STAGE(PG8_SB(0, 0), cB, voffB); PG8_STAGE(PG8_SB(0, 1), cB + hstep, voffB); PG8_STAGE(PG8_SA(0, 0), cA, voffA); PG8_STAGE(PG8_SA(0, 1), cA + hstep, voffA);
        if (wr == 1) PG8_BAR;
        PG8_WAIT_V(2); PG8_BAR;
        PG8_STAGE(PG8_SB(1, 0), cB + kstep, voffB); PG8_STAGE(PG8_SA(1, 0), cA + kstep, voffA); PG8_STAGE(PG8_SB(1, 1), cB + hstep + kstep, voffB);
        PG8_WAIT_V(6); PG8_BAR;
    } else {
        PG8_STAGE(PG8_SB(0, 0), cB, voffB); PG8_STAGE(PG8_SA(0, 0), cA, voffA); PG8_STAGE(PG8_SB(0, 1), cB + hstep, voffB); PG8_STAGE(PG8_SA(0, 1), cA + hstep, voffA);
        if (wr == 1) PG8_BAR;
        PG8_WAIT_V(4); PG8_BAR;
        PG8_STAGE(PG8_SB(1, 0), cB + kstep, voffB); PG8_STAGE(PG8_SA(1, 0), cA + kstep, voffA); PG8_STAGE(PG8_SB(1, 1), cB + hstep + kstep, voffB);
        PG8_WAIT_V(6); PG8_BAR;
    }
    for (;;) {
        const bool has_next = S.next(ui + 1, nxt);
        const char* nA = has_next ? (const char*)g.A + (size_t)nxt.pm * tstep : cA; const char* nB = has_next ? (const char*)g.Bt + (size_t)nxt.pn * tstep : cB;
        if constexpr (Epi::MID_T >= 0) {
        for (int t = 0; t < Epi::MID_T; t += 2) {
            const bool last = (t == nt - 2);
            const char* a1 = cA + (size_t)(t + 1) * kstep;
            const char* a2 = last ? nA : cA + (size_t)(t + 2) * kstep; const char* b2 = last ? nB : cB + (size_t)(t + 2) * kstep;
            const char* a3 = a2 + kstep; const char* b3 = b2 + kstep;
            if (last && has_next) S.a_ready(nxt);
            if constexpr (SP2) {
            PG8_LDB(B0, 0, 0); PG8_LDB(B1, 0, 1); PG8_SCHED; PG8_LDA(At, 0, 0); PG8_STAGE(PG8_SA(1, 1), a1 + hstep, voffA);
            PG8_WAIT_V(8); PG8_WAIT_L(0); PG8_BAR; PG8_MMA(0, 0, At, B0); PG8_MMA(0, 1, At, B1); PG8_BAR; PG8_SCHED;
            PG8_LDA(At, 0, 1); PG8_STAGE(PG8_SB(0, 0), b2, voffB); PG8_STAGE(PG8_SB(0, 1), b2 + hstep, voffB); PG8_STAGE(PG8_SA(0, 0), a2, voffA);
            PG8_WAIT_V(8); PG8_WAIT_L(0); PG8_BAR; PG8_MMA(1, 0, At, B0); PG8_MMA(1, 1, At, B1); PG8_BAR; PG8_SCHED;
            PG8_LDB(B0, 1, 0); PG8_LDB(B1, 1, 1); PG8_SCHED; PG8_LDA(At, 1, 0); PG8_STAGE(PG8_SA(0, 1), a2 + hstep, voffA);
            PG8_WAIT_V(8); PG8_WAIT_L(0); PG8_BAR; PG8_MMA(0, 0, At, B0); PG8_MMA(0, 1, At, B1); PG8_BAR; PG8_SCHED;
            PG8_LDA(At, 1, 1); PG8_STAGE(PG8_SB(1, 0), b3, voffB); PG8_STAGE(PG8_SB(1, 1), b3 + hstep, voffB); PG8_STAGE(PG8_SA(1, 0), a3, voffA);
            PG8_WAIT_V(8); PG8_WAIT_L(0); PG8_BAR; PG8_MMA(1, 0, At, B0); PG8_MMA(1, 1, At, B1); PG8_BAR; PG8_SCHED;
            } else {
            PG8_LDB(B0, 0, 0); PG8_SCHED; PG8_LDA(At, 0, 0); PG8_STAGE(PG8_SA(1, 1), a1 + hstep, voffA);
            PG8_WAIT_L(8); PG8_BAR; PG8_WAIT_L(0); PG8_MMA(0, 0, At, B0); PG8_BAR; PG8_SCHED;
            PG8_LDB(B1, 0, 1); PG8_STAGE(PG8_SB(0, 0), b2, voffB);
            PG8_BAR; PG8_WAIT_L(0); PG8_MMA(0, 1, At, B1); PG8_BAR;
            PG8_LDA(At, 0, 1); PG8_STAGE(PG8_SA(0, 0), a2, voffA);
            PG8_BAR; PG8_WAIT_L(0); PG8_MMA(1, 0, At, B0); PG8_BAR; PG8_SCHED;
            PG8_STAGE(PG8_SB(0, 1), b2 + hstep, voffB);
            PG8_WAIT_V(6); PG8_BAR; PG8_MMA(1, 1, At, B1); PG8_BAR;
            PG8_LDB(B0, 1, 0); PG8_SCHED; PG8_LDA(At, 1, 0); PG8_STAGE(PG8_SA(0, 1), a2 + hstep, voffA);
            PG8_WAIT_L(8); PG8_BAR; PG8_WAIT_L(0); PG8_MMA(0, 0, At, B0); PG8_BAR; PG8_SCHED;
            PG8_LDB(B1, 1, 1); PG8_STAGE(PG8_SB(1, 0), b3, voffB);
            PG8_BAR; PG8_WAIT_L(0); PG8_MMA(0, 1, At, B1); PG8_BAR;
            PG8_LDA(At, 1, 1); PG8_STAGE(PG8_SA(1, 0), a3, voffA);
            PG8_BAR; PG8_WAIT_L(0); PG8_MMA(1, 0, At, B0); PG8_BAR; PG8_SCHED;
            PG8_STAGE(PG8_SB(1, 1), b3 + hstep, voffB);
            PG8_WAIT_V(6); PG8_BAR; PG8_MMA(1, 1, At, B1); PG8_BAR;
            }
        }
        E.mid(acc, cur, wr, wc, fr, fq);
        for (int t = Epi::MID_T; t < nt; t += 2) {
            const bool last = (t == nt - 2);
            const char* a1 = cA + (size_t)(t + 1) * kstep;
            const char* a2 = last ? nA : cA + (size_t)(t + 2) * kstep; const char* b2 = last ? nB : cB + (size_t)(t + 2) * kstep;
            const char* a3 = a2 + kstep; const char* b3 = b2 + kstep;
            if (last && has_next) S.a_ready(nxt);
            if constexpr (SP2) {
            PG8_LDB(B0, 0, 0); PG8_LDB(B1, 0, 1); PG8_SCHED; PG8_LDA(At, 0, 0); PG8_STAGE(PG8_SA(1, 1), a1 + hstep, voffA);
            PG8_WAIT_V(8); PG8_WAIT_L(0); PG8_BAR; PG8_MMA(0, 0, At, B0); PG8_MMA(0, 1, At, B1); PG8_BAR; PG8_SCHED;
            PG8_LDA(At, 0, 1); PG8_STAGE(PG8_SB(0, 0), b2, voffB); PG8_STAGE(PG8_SB(0, 1), b2 + hstep, voffB); PG8_STAGE(PG8_SA(0, 0), a2, voffA);
            PG8_WAIT_V(8); PG8_WAIT_L(0); PG8_BAR; PG8_MMA(1, 0, At, B0); PG8_MMA(1, 1, At, B1); PG8_BAR; PG8_SCHED;
            PG8_LDB(B0, 1, 0); PG8_LDB(B1, 1, 1); PG8_SCHED; PG8_LDA(At, 1, 0); PG8_STAGE(PG8_SA(0, 1), a2 + hstep, voffA);
            PG8_WAIT_V(8); PG8_WAIT_L(0); PG8_BAR; PG8_MMA(0, 0, At, B0); PG8_MMA(0, 1, At, B1); PG8_BAR; PG8_SCHED;
            PG8_LDA(At, 1, 1); PG8_STAGE(PG8_SB(1, 0), b3, voffB); PG8_STAGE(PG8_SB(1, 1), b3 + hstep, voffB); PG8_STAGE(PG8_SA(1, 0), a3, voffA);
            PG8_WAIT_V(8); PG8_WAIT_L(0); PG8_BAR; PG8_MMA(1, 0, At, B0); PG8_MMA(1, 1, At, B1); PG8_BAR; PG8_SCHED;
            } else {
            PG8_LDB(B0, 0, 0); PG8_SCHED; PG8_LDA(At, 0, 0); PG8_STAGE(PG8_SA(1, 1), a1 + hstep, voffA);
            PG8_WAIT_L(8); PG8_BAR; PG8_WAIT_L(0); PG8_MMA(0, 0, At, B0); PG8_BAR; PG8_SCHED;
            PG8_LDB(B1, 0, 1); PG8_STAGE(PG8_SB(0, 0), b2, voffB);
            PG8_BAR; PG8_WAIT_L(0); PG8_MMA(0, 1, At, B1); PG8_BAR;
            PG8_LDA(At, 0, 1); PG8_STAGE(PG8_SA(0, 0), a2, voffA);
            PG8_BAR; PG8_WAIT_L(0); PG8_MMA(1, 0, At, B0); PG8_BAR; PG8_SCHED;
            PG8_STAGE(PG8_SB(0, 1), b2 + hstep, voffB);
            PG8_WAIT_V(6); PG8_BAR; PG8_MMA(1, 1, At, B1); PG8_BAR;
            PG8_LDB(B0, 1, 0); PG8_SCHED; PG8_LDA(At, 1, 0); PG8_STAGE(PG8_SA(0, 1), a2 + hstep, voffA);
            PG8_WAIT_L(8); PG8_BAR; PG8_WAIT_L(0); PG8_MMA(0, 0, At, B0); PG8_BAR; PG8_SCHED;
            PG8_LDB(B1, 1, 1); PG8_STAGE(PG8_SB(1, 0), b3, voffB);
            PG8_BAR; PG8_WAIT_L(0); PG8_MMA(0, 1, At, B1); PG8_BAR;
            PG8_LDA(At, 1, 1); PG8_STAGE(PG8_SA(1, 0), a3, voffA);
            PG8_BAR; PG8_WAIT_L(0); PG8_MMA(1, 0, At, B0); PG8_BAR; PG8_SCHED;
            PG8_STAGE(PG8_SB(1, 1), b3 + hstep, voffB);
            PG8_WAIT_V(6); PG8_BAR; PG8_MMA(1, 1, At, B1); PG8_BAR;
            }
        }
        } else {
        for (int t = 0; t < nt; t += 2) {
            const bool last = (t == nt - 2);
            const char* a1 = cA + (size_t)(t + 1) * kstep;
            const char* a2 = last ? nA : cA + (size_t)(t + 2) * kstep; const char* b2 = last ? nB : cB + (size_t)(t + 2) * kstep;
            const char* a3 = a2 + kstep; const char* b3 = b2 + kstep;
            if (last && has_next) S.a_ready(nxt);
            if constexpr (SP2) {
            PG8_LDB(B0, 0, 0); PG8_LDB(B1, 0, 1); PG8_SCHED; PG8_LDA(At, 0, 0); PG8_STAGE(PG8_SA(1, 1), a1 + hstep, voffA);
            PG8_WAIT_V(8); PG8_WAIT_L(0); PG8_BAR; PG8_MMA(0, 0, At, B0); PG8_MMA(0, 1, At, B1); PG8_BAR; PG8_SCHED;
            PG8_LDA(At, 0, 1); PG8_STAGE(PG8_SB(0, 0), b2, voffB); PG8_STAGE(PG8_SB(0, 1), b2 + hstep, voffB); PG8_STAGE(PG8_SA(0, 0), a2, voffA);
            PG8_WAIT_V(8); PG8_WAIT_L(0); PG8_BAR; PG8_MMA(1, 0, At, B0); PG8_MMA(1, 1, At, B1); PG8_BAR; PG8_SCHED;
            PG8_LDB(B0, 1, 0); PG8_LDB(B1, 1, 1); PG8_SCHED; PG8_LDA(At, 1, 0); PG8_STAGE(PG8_SA(0, 1), a2 + hstep, voffA);
            PG8_WAIT_V(8); PG8_WAIT_L(0); PG8_BAR; PG8_MMA(0, 0, At, B0); PG8_MMA(0, 1, At, B1); PG8_BAR; PG8_SCHED;
            PG8_LDA(At, 1, 1); PG8_STAGE(PG8_SB(1, 0), b3, voffB); PG8_STAGE(PG8_SB(1, 1), b3 + hstep, voffB); PG8_STAGE(PG8_SA(1, 0), a3, voffA);
            PG8_WAIT_V(8); PG8_WAIT_L(0); PG8_BAR; PG8_MMA(1, 0, At, B0); PG8_MMA(1, 1, At, B1); PG8_BAR; PG8_SCHED;
            } else {
            PG8_LDB(B0, 0, 0); PG8_SCHED; PG8_LDA(At, 0, 0); PG8_STAGE(PG8_SA(1, 1), a1 + hstep, voffA);
            PG8_WAIT_L(8); PG8_BAR; PG8_WAIT_L(0); PG8_MMA(0, 0, At, B0); PG8_BAR; PG8_SCHED;
            PG8_LDB(B1, 0, 1); PG8_STAGE(PG8_SB(0, 0), b2, voffB);
            PG8_BAR; PG8_WAIT_L(0); PG8_MMA(0, 1, At, B1); PG8_BAR;
            PG8_LDA(At, 0, 1); PG8_STAGE(PG8_SA(0, 0), a2, voffA);
            PG8_BAR; PG8_WAIT_L(0); PG8_MMA(1, 0, At, B0); PG8_BAR; PG8_SCHED;
            PG8_STAGE(PG8_SB(0, 1), b2 + hstep, voffB);
            PG8_WAIT_V(6); PG8_BAR; PG8_MMA(1, 1, At, B1); PG8_BAR;
            PG8_LDB(B0, 1, 0); PG8_SCHED; PG8_LDA(At, 1, 0); PG8_STAGE(PG8_SA(0, 1), a2 + hstep, voffA);
            PG8_WAIT_L(8); PG8_BAR; PG8_WAIT_L(0); PG8_MMA(0, 0, At, B0); PG8_BAR; PG8_SCHED;
            PG8_LDB(B1, 1, 1); PG8_STAGE(PG8_SB(1, 0), b3, voffB);
            PG8_BAR; PG8_WAIT_L(0); PG8_MMA(0, 1, At, B1); PG8_BAR;
            PG8_LDA(At, 1, 1); PG8_STAGE(PG8_SA(1, 0), a3, voffA);
            PG8_BAR; PG8_WAIT_L(0); PG8_MMA(1, 0, At, B0); PG8_BAR; PG8_SCHED;
            PG8_STAGE(PG8_SB(1, 1), b3 + hstep, voffB);
            PG8_WAIT_V(6); PG8_BAR; PG8_MMA(1, 1, At, B1); PG8_BAR;
            }
        }
        }
        if constexpr (ALIGN_EPI) { if (wr == 0) PG8_BAR; }
        if constexpr (!Epi::AFTER_DRAIN) { E(acc, cur, wr, wc, fr, fq); S.done(cur); }
        if (!has_next) break;
#pragma unroll
        for (int a = 0; a < 2; ++a)
#pragma unroll
            for (int b = 0; b < 2; ++b)
#pragma unroll
                for (int m = 0; m < 4; ++m)
#pragma unroll
                    for (int n = 0; n < 2; ++n) acc[a][b][m][n] = (f32x4){0.f, 0.f, 0.f, 0.f};
        cur = nxt; cA = nA; cB = nB; ++ui;
        if constexpr (ALIGN_EPI) { if (wr == 1) PG8_BAR; }
    }
    PG8_WAIT_V(0);
    if constexpr (!ALIGN_EPI) { if (wr == 0) PG8_BAR; }
    PG8_BAR;
    if constexpr (Epi::AFTER_DRAIN) { E.fused(acc, cur, wr, wc, fr, fq, lds, wid, lane); S.done(cur); }
#undef PG8_SA
#undef PG8_SB
#undef PG8_STAGE
#undef PG8_LDA
#undef PG8_LDB
#undef PG8_MMA
#undef PG8_WAIT_V
#undef PG8_WAIT_L
#undef PG8_BAR
#undef PG8_SCHED
}
}
#ifndef PG8_SP2
#define PG8_SP2 true
#endif
#ifndef PG8_ALIGN
#define PG8_ALIGN true
#endif
constexpr int NWAVES = 8;
#ifndef MK_N_LAUNCHES
#define MK_N_LAUNCHES 1
#endif
#ifndef SB_EARLY_EXIT
#define SB_EARLY_EXIT 1
#endif
constexpr int N_PHASES = 11;
constexpr int N_LAUNCHES = MK_N_LAUNCHES;

constexpr int BATCH = 4, SEQ = 8192, DM = 1024, M = BATCH * SEQ;
constexpr int INW = 5640, NPROJ = 5632, GATE_COL = 3584;
constexpr int NCHUNK = SEQ / 128;
constexpr int N_MLU = BATCH * 4 * NCHUNK;
constexpr float ALPHA = 1.18920711500272107f;
constexpr float LN_EPS = 1e-5f;
constexpr float LOG2E = 1.4426950408889634f;
constexpr float C2 = 0.125f * LOG2E;

constexpr size_t MiB = 1u << 20;
constexpr size_t WS_CTL = 0, CTL_ZERO_BYTES = 1 * MiB;
constexpr size_t WS_WIN_T = 1 * MiB;
constexpr size_t WS_WSB_T = 12 * MiB;
constexpr size_t WS_WOUT_T = 14 * MiB;
constexpr size_t WS_WQG_T = 16 * MiB;
constexpr size_t WS_WPLE_T = 22 * MiB;
constexpr size_t WS_STATS = 23 * MiB;
constexpr size_t WS_GI = 24 * MiB;
constexpr size_t WS_GF = 25 * MiB;
constexpr size_t WS_MLN = 26 * MiB;
constexpr size_t WS_MLS = 27 * MiB;
constexpr size_t WS_XN = 32 * MiB;
constexpr size_t WS_OCAT = 32 * MiB;
constexpr size_t WS_C = 448 * MiB;
constexpr size_t WS_UT = 32 * MiB;
constexpr size_t WS_VT = 48 * MiB;
constexpr float U_SCALE = 64.f, V_SCALE = 8.f;
constexpr size_t WS_PROJ = 96 * MiB;
constexpr size_t SLAB = (size_t)M * 512;
constexpr size_t WS_Y = 96 * MiB;
constexpr size_t WS_PLE = 160 * MiB;
constexpr size_t WS_H1B = 224 * MiB;
constexpr size_t WS_PRE1 = 320 * MiB;
constexpr size_t WS_Q = 320 * MiB;
constexpr size_t WS_IDX = 96 * MiB;
constexpr size_t WS_GATE = 112 * MiB;
constexpr size_t WS_PB = 480 * MiB;
constexpr size_t WS_END = 496 * MiB;
constexpr int CW_TMO = 0, CW_CODE = 1;
constexpr int CW_BAR = 4096;

constexpr int RING_OFF = 0, RING_BYTES = 131072;
constexpr int LDSCTL_OFF = RING_BYTES, MISC_OFF = LDSCTL_OFF + 320;
constexpr int LDS_BYTES = 147456;
#define GAS __attribute__((address_space(1)))
#define LAS __attribute__((address_space(3)))
typedef unsigned short bf16;
typedef unsigned v4u __attribute__((ext_vector_type(4)));
typedef float f32x4 __attribute__((ext_vector_type(4)));
typedef short bf16x8 __attribute__((ext_vector_type(8)));
typedef GAS unsigned gu32;
typedef GAS unsigned long long gu64;
#define RLX_AGENT __ATOMIC_RELAXED, __HIP_MEMORY_SCOPE_AGENT
#define LDS_WAIT() asm volatile("s_waitcnt lgkmcnt(0)" ::: "memory")
#define VM_WAIT() asm volatile("s_waitcnt vmcnt(0)" ::: "memory")
__device__ __forceinline__ unsigned long long rt() { return __builtin_amdgcn_s_memrealtime(); }
__device__ __forceinline__ unsigned f2bf(float f) { unsigned u = __builtin_bit_cast(unsigned, f); return (u + 0x7fffu + ((u >> 16) & 1u)) >> 16; }
__device__ __forceinline__ unsigned pk2(float lo, float hi) { return f2bf(lo) | (f2bf(hi) << 16); }

#define XB_TMO      128
#define XB_XCNT(j)  (256  + 64 * (j))
#define XB_XSUB(j)  (1280 + 64 * (j))
#define XB_XGEN(j)  (2304 + 64 * (j))
#define XB_TOP      3328
#define XB_TOPGEN   3392
#define XCD_BAR_WORDS 3456
#define XB_SPIN_CAP (1u << 18)

__device__ __forceinline__ unsigned xb_ld(unsigned* p)              { return __hip_atomic_load(p, __ATOMIC_RELAXED, __HIP_MEMORY_SCOPE_AGENT); }
__device__ __forceinline__ unsigned xb_add(unsigned* p, unsigned v) { return __hip_atomic_fetch_add(p, v, __ATOMIC_RELAXED, __HIP_MEMORY_SCOPE_AGENT); }
__device__ __forceinline__ unsigned xb_xcc_id() { return (unsigned)__builtin_amdgcn_s_getreg((3 << 11) | 20) & 0xFu; }
#define XB_SPIN(cond, bar) do { unsigned _sp = 0; while (cond) { __builtin_amdgcn_s_sleep(1); \
    if ((++_sp & 255u) == 0u) { if (xb_ld(&(bar)[XB_TMO])) break; if (_sp > XB_SPIN_CAP) { atomicAdd(&(bar)[XB_TMO], 1u); break; } } } } while (0)

struct XcdBarrier {
    unsigned* bar; unsigned x;
    volatile LAS unsigned* st;
};

__device__ __forceinline__ XcdBarrier xcd_barrier_post(unsigned* bar, volatile LAS unsigned* st) {
    XcdBarrier b; b.bar = bar; b.x = xb_xcc_id(); b.st = st;
    if (threadIdx.x == 0) (void)xb_add(&bar[XB_XCNT(b.x)], 1u);
    return b;
}
__device__ __forceinline__ void xcd_barrier_complete(unsigned* bar, unsigned x, unsigned& nloc, unsigned& nx) {
    const unsigned G = gridDim.x * gridDim.y * gridDim.z;
    unsigned sum, cnt, mine, sp = 0u;
    for (;;) {
        sum = 0u; cnt = 0u; mine = 0u;
#pragma unroll
        for (unsigned j = 0; j < 16; ++j) { const unsigned c = xb_ld(&bar[XB_XCNT(j)]); sum += c; cnt += (c > 0u) ? 1u : 0u; mine = (j == x) ? c : mine; }
        if (sum == G) break;
        __builtin_amdgcn_s_sleep(1);
        if ((++sp & 255u) == 0u) { if (xb_ld(&bar[XB_TMO])) break; if (sp > XB_SPIN_CAP) { atomicAdd(&bar[XB_TMO], 1u); break; } }
    }
    nloc = mine > 0u ? mine : 1u; nx = cnt > 0u ? cnt : 1u;
}

__device__ __forceinline__ void xcd_barrier(const XcdBarrier& b) {
    asm volatile("s_waitcnt vmcnt(0)" ::: "memory");
    __syncthreads();
    if (threadIdx.x == 0) {
        unsigned* bar = b.bar;
        __builtin_amdgcn_s_waitcnt(0);
        unsigned nloc = b.st[0], nx = b.st[1];
        if (nloc == 0u) { xcd_barrier_complete(bar, b.x, nloc, nx); b.st[0] = nloc; b.st[1] = nx; }
        const unsigned old = xb_add(&bar[XB_XSUB(b.x)], 1u);
        const unsigned gen = old / nloc;
        if (old + 1u == (gen + 1u) * nloc) {
            __builtin_amdgcn_fence(__ATOMIC_RELEASE, "agent");
            asm volatile("s_waitcnt vmcnt(0)" ::: "memory");
            const unsigned og = xb_add(&bar[XB_TOP], 1u);
            const unsigned tg = og / nx;
            if (og + 1u == (tg + 1u) * nx) xb_add(&bar[XB_TOPGEN], 1u);
            else XB_SPIN(xb_ld(&bar[XB_TOPGEN]) == tg, bar);
            __builtin_amdgcn_fence(__ATOMIC_ACQUIRE, "agent");
            xb_add(&bar[XB_XGEN(b.x)], 1u);
            asm volatile("s_waitcnt vmcnt(0)" ::: "memory");
        } else {
            XB_SPIN(xb_ld(&bar[XB_XGEN(b.x)]) == gen, bar);
            __builtin_amdgcn_fence(__ATOMIC_ACQUIRE, "agent");
            asm volatile("s_waitcnt vmcnt(0)" ::: "memory");
        }
    }
    __syncthreads();
}
typedef float f32x16 __attribute__((ext_vector_type(16)));
typedef float f32x2 __attribute__((ext_vector_type(2)));
typedef unsigned u32x2 __attribute__((ext_vector_type(2)));
typedef __bf16 bf16x2_t __attribute__((ext_vector_type(2)));

struct Frame {
    LAS unsigned char* lds;
    volatile LAS unsigned* MISC;
    gu32* ctl;
    int tid, lane, wave;
    int vcu, G;
    const float* const* in;
    float* out;
    unsigned char* ws;
};
#define WSP(T, off) ((T*)(F.ws + (off)))

#define DPP_F(v, CTRL) __uint_as_float((unsigned)__builtin_amdgcn_mov_dpp((int)__float_as_uint(v), (CTRL), 0xF, 0xF, true))
__device__ __forceinline__ float wave_sum(float v) {
    v += DPP_F(v, 0xB1); v += DPP_F(v, 0x4E); v += DPP_F(v, 0x141); v += DPP_F(v, 0x140);
    v += __uint_as_float((unsigned)__builtin_amdgcn_ds_swizzle((int)__float_as_uint(v), 0x401F));
    auto rr = __builtin_amdgcn_permlane32_swap(__float_as_uint(v), __float_as_uint(v), false, false);
    return __uint_as_float(rr[0]) + __uint_as_float(rr[1]);
}
__device__ __forceinline__ float wave_max(float v) {
    v = fmaxf(v, DPP_F(v, 0xB1)); v = fmaxf(v, DPP_F(v, 0x4E)); v = fmaxf(v, DPP_F(v, 0x141)); v = fmaxf(v, DPP_F(v, 0x140));
    v = fmaxf(v, __uint_as_float((unsigned)__builtin_amdgcn_ds_swizzle((int)__float_as_uint(v), 0x401F)));
    auto rr = __builtin_amdgcn_permlane32_swap(__float_as_uint(v), __float_as_uint(v), false, false);
    return fmaxf(__uint_as_float(rr[0]), __uint_as_float(rr[1]));
}
__device__ __forceinline__ float reduce8_transposed(const float (&d)[8], bool up16, bool up8) {
    float a_[4];
#pragma unroll
    for (int i = 0; i < 4; ++i) { auto rr = __builtin_amdgcn_permlane32_swap(__float_as_uint(d[i]), __float_as_uint(d[4 + i]), false, false); a_[i] = __uint_as_float(rr[0]) + __uint_as_float(rr[1]); }
    float b_[2];
#pragma unroll
    for (int i = 0; i < 2; ++i) { const float keep = up16 ? a_[2 + i] : a_[i], send = up16 ? a_[i] : a_[2 + i];
        b_[i] = keep + __uint_as_float((unsigned)__builtin_amdgcn_ds_swizzle((int)__float_as_uint(send), 0x401F)); }
    const float keep = up8 ? b_[1] : b_[0], send = up8 ? b_[0] : b_[1];
    float c0 = keep + DPP_F(send, 0x128);
    c0 += DPP_F(c0, 0x141); c0 += DPP_F(c0, 0x4E); c0 += DPP_F(c0, 0xB1);
    return c0;
}
__device__ __forceinline__ float bf_lo(unsigned u) { return __uint_as_float(u << 16); }
__device__ __forceinline__ float bf_hi(unsigned u) { return __uint_as_float(u & 0xffff0000u); }
__device__ __forceinline__ unsigned cvtpk(float lo, float hi) { f32x2 v = {lo, hi}; bf16x2_t b = __builtin_convertvector(v, bf16x2_t); return __builtin_bit_cast(unsigned, b); }
__device__ __forceinline__ float sigmoidf_fast(float x) { return __builtin_amdgcn_rcpf(1.0f + __builtin_amdgcn_exp2f(-x * LOG2E)); }
__device__ __forceinline__ float siluf_fast(float x) { return x * sigmoidf_fast(x); }
__device__ __forceinline__ int crow(int r, int hi) { return (r & 3) + 8 * (r >> 2) + 4 * hi; }
__device__ __forceinline__ float dot2_bf16(unsigned w, unsigned x, float acc) { return __builtin_amdgcn_fdot2_f32_bf16(__builtin_bit_cast(bf16x2_t, w), __builtin_bit_cast(bf16x2_t, x), acc, false); }
#define MFMA32(a, b, c) __builtin_amdgcn_mfma_f32_32x32x16_bf16((a), (b), (c), 0, 0, 0)

namespace pg8 {
template <bool ADD> struct EpiGate {
    static constexpr bool PERM = true, AFTER_DRAIN = false; static constexpr int MID_T = -1;
    bf16_t* Y; const bf16_t* G;
    __device__ __forceinline__ void operator()(const f32x4 (&acc)[2][2][4][2], const Unit& u, int wr, int wc, int fr, int fq) const {
        const int row0 = u.pm * BM + wr * 64 + fr, col0 = u.pn * BM + wc * 32 + 8 * fq;
#pragma unroll
        for (int ai = 0; ai < 2; ++ai)
#pragma unroll
            for (int m = 0; m < 4; ++m) { const size_t row = (size_t)(row0 + ai * HALF + m * 16);
#pragma unroll
                for (int bj = 0; bj < 2; ++bj) { const int col = col0 + bj * HALF;
                    const u32x4 g = *(const u32x4*)(G + (size_t)(col >> 9) * SLAB + row * 512 + (col & 511));
                    const f32x4 v0 = acc[ai][bj][m][0], v1 = acc[ai][bj][m][1];
                    float y[8];
                    y[0] = sigmoidf_fast(bf_lo(g.x)) * v0[0]; y[1] = sigmoidf_fast(bf_hi(g.x)) * v0[1]; y[2] = sigmoidf_fast(bf_lo(g.y)) * v0[2]; y[3] = sigmoidf_fast(bf_hi(g.y)) * v0[3];
                    y[4] = sigmoidf_fast(bf_lo(g.z)) * v1[0]; y[5] = sigmoidf_fast(bf_hi(g.z)) * v1[1]; y[6] = sigmoidf_fast(bf_lo(g.w)) * v1[2]; y[7] = sigmoidf_fast(bf_hi(g.w)) * v1[3];
                    u32x4* yp = (u32x4*)(Y + row * 1024 + col);
                    if (ADD) { const u32x4 o = *yp; y[0] += bf_lo(o.x); y[1] += bf_hi(o.x); y[2] += bf_lo(o.y); y[3] += bf_hi(o.y); y[4] += bf_lo(o.z); y[5] += bf_hi(o.z); y[6] += bf_lo(o.w); y[7] += bf_hi(o.w); }
                    u32x4 w; w.x = cvtpk(y[0], y[1]); w.y = cvtpk(y[2], y[3]); w.z = cvtpk(y[4], y[5]); w.w = cvtpk(y[6], y[7]);
                    *yp = w; } }
    }
};
__device__ __forceinline__ float sig_den(float x) { return 1.0f + __builtin_amdgcn_exp2f(fminf(-x * LOG2E, 60.0f)); }
struct EpiGate2 {
    static constexpr bool PERM = true, AFTER_DRAIN = false; static constexpr int MID_T = 8;
    bf16_t* Y; const bf16_t* Gsb; const bf16_t* Gml;
    __device__ __forceinline__ void mid(f32x4 (&acc)[2][2][4][2], const Unit& u, int wr, int wc, int fr, int fq) const {
        const int row0 = u.pm * BM + wr * 64 + fr, col0 = u.pn * BM + wc * 32 + 8 * fq;
#pragma unroll
        for (int ai = 0; ai < 2; ++ai)
#pragma unroll
            for (int m = 0; m < 4; ++m) { const size_t row = (size_t)(row0 + ai * HALF + m * 16);
#pragma unroll
                for (int bj = 0; bj < 2; ++bj) { const int col = col0 + bj * HALF; const size_t go = (size_t)(col >> 9) * SLAB + row * 512 + (col & 511);
                    const u32x4 a = *(const u32x4*)(Gsb + go), b = *(const u32x4*)(Gml + go);
                    f32x4& v0 = acc[ai][bj][m][0]; f32x4& v1 = acc[ai][bj][m][1];
                    v0[0] *= sig_den(bf_lo(b.x)) * __builtin_amdgcn_rcpf(sig_den(bf_lo(a.x))); v0[1] *= sig_den(bf_hi(b.x)) * __builtin_amdgcn_rcpf(sig_den(bf_hi(a.x)));
                    v0[2] *= sig_den(bf_lo(b.y)) * __builtin_amdgcn_rcpf(sig_den(bf_lo(a.y))); v0[3] *= sig_den(bf_hi(b.y)) * __builtin_amdgcn_rcpf(sig_den(bf_hi(a.y)));
                    v1[0] *= sig_den(bf_lo(b.z)) * __builtin_amdgcn_rcpf(sig_den(bf_lo(a.z))); v1[1] *= sig_den(bf_hi(b.z)) * __builtin_amdgcn_rcpf(sig_den(bf_hi(a.z)));
                    v1[2] *= sig_den(bf_lo(b.w)) * __builtin_amdgcn_rcpf(sig_den(bf_lo(a.w))); v1[3] *= sig_den(bf_hi(b.w)) * __builtin_amdgcn_rcpf(sig_den(bf_hi(a.w)));
                    asm volatile("" ::: "memory"); __builtin_amdgcn_sched_barrier(0); } }
    }
    __device__ __forceinline__ void operator()(const f32x4 (&acc)[2][2][4][2], const Unit& u, int wr, int wc, int fr, int fq) const {
        const int row0 = u.pm * BM + wr * 64 + fr, col0 = u.pn * BM + wc * 32 + 8 * fq;
#pragma unroll
        for (int ai = 0; ai < 2; ++ai)
#pragma unroll
            for (int m = 0; m < 4; ++m) { const size_t row = (size_t)(row0 + ai * HALF + m * 16);
#pragma unroll
                for (int bj = 0; bj < 2; ++bj) { const int col = col0 + bj * HALF;
                    const u32x4 b = *(const u32x4*)(Gml + (size_t)(col >> 9) * SLAB + row * 512 + (col & 511));
                    const f32x4 v0 = acc[ai][bj][m][0], v1 = acc[ai][bj][m][1];
                    u32x4 w;
                    w.x = cvtpk(v0[0] * __builtin_amdgcn_rcpf(sig_den(bf_lo(b.x))), v0[1] * __builtin_amdgcn_rcpf(sig_den(bf_hi(b.x)))); w.y = cvtpk(v0[2] * __builtin_amdgcn_rcpf(sig_den(bf_lo(b.y))), v0[3] * __builtin_amdgcn_rcpf(sig_den(bf_hi(b.y))));
                    w.z = cvtpk(v1[0] * __builtin_amdgcn_rcpf(sig_den(bf_lo(b.z))), v1[1] * __builtin_amdgcn_rcpf(sig_den(bf_hi(b.z)))); w.w = cvtpk(v1[2] * __builtin_amdgcn_rcpf(sig_den(bf_lo(b.w))), v1[3] * __builtin_amdgcn_rcpf(sig_den(bf_hi(b.w))));
                    *(u32x4*)(Y + row * 1024 + col) = w; } }
    }
};
struct EpiPre1 {
    static constexpr bool PERM = false, AFTER_DRAIN = false; static constexpr int MID_T = -1;
    float* P; const float* x; const float* stats; const float* g0; const float* b0;
    __device__ __forceinline__ void operator()(const f32x4 (&acc)[2][2][4][2], const Unit& u, int wr, int wc, int fr, int fq) const {
        const int row0 = u.pm * BM + wr * 64 + fr, col0 = u.pn * BM + wc * 32 + 4 * fq;
        f32x4 gv[2][2], bv[2][2];
#pragma unroll
        for (int bj = 0; bj < 2; ++bj)
#pragma unroll
            for (int n = 0; n < 2; ++n) { gv[bj][n] = *(const f32x4*)(g0 + col0 + bj * HALF + n * 16); bv[bj][n] = *(const f32x4*)(b0 + col0 + bj * HALF + n * 16); }
#pragma unroll
        for (int ai = 0; ai < 2; ++ai)
#pragma unroll
            for (int m = 0; m < 4; ++m) { const size_t row = (size_t)(row0 + ai * HALF + m * 16); const f32x2 st = *(const f32x2*)(stats + row * 2);
#pragma unroll
                for (int bj = 0; bj < 2; ++bj)
#pragma unroll
                    for (int n = 0; n < 2; ++n) { const size_t off = row * 1024 + col0 + bj * HALF + n * 16; const f32x4 xv = *(const f32x4*)(x + off);
                        const f32x4 h0 = (xv - st.x) * st.y * gv[bj][n] + bv[bj][n];
                        *(f32x4*)(P + off) = h0 * ALPHA + acc[ai][bj][m][n]; } }
    }
};
struct EpiQG {
    static constexpr bool PERM = true, AFTER_DRAIN = false; static constexpr int MID_T = -1;
    bf16_t* Q; bf16_t* PLE;
    __device__ __forceinline__ void operator()(const f32x4 (&acc)[2][2][4][2], const Unit& u, int wr, int wc, int fr, int fq) const {
        const int row0 = u.pm * BM + wr * 64 + fr, colt = u.pn * BM, col0 = colt + wc * 32 + 8 * fq;
        const bool isq = colt < 2048;
#pragma unroll
        for (int ai = 0; ai < 2; ++ai)
#pragma unroll
            for (int m = 0; m < 4; ++m) { const size_t row = (size_t)(row0 + ai * HALF + m * 16);
#pragma unroll
                for (int bj = 0; bj < 2; ++bj) { const int col = col0 + bj * HALF; const f32x4 v0 = acc[ai][bj][m][0], v1 = acc[ai][bj][m][1];
                    if (isq) { u32x4 w; w.x = cvtpk(v0[0], v0[1]); w.y = cvtpk(v0[2], v0[3]); w.z = cvtpk(v1[0], v1[1]); w.w = cvtpk(v1[2], v1[3]);
                        *(u32x4*)(Q + row * 2048 + col) = w; }
                    else { u32x4* pp = (u32x4*)(PLE + row * 1024 + (col - 2048)); const u32x4 o = *pp; u32x4 w;
                        w.x = cvtpk(sigmoidf_fast(v0[0]) * bf_lo(o.x), sigmoidf_fast(v0[1]) * bf_hi(o.x)); w.y = cvtpk(sigmoidf_fast(v0[2]) * bf_lo(o.y), sigmoidf_fast(v0[3]) * bf_hi(o.y));
                        w.z = cvtpk(sigmoidf_fast(v1[0]) * bf_lo(o.z), sigmoidf_fast(v1[1]) * bf_hi(o.z)); w.w = cvtpk(sigmoidf_fast(v1[2]) * bf_lo(o.w), sigmoidf_fast(v1[3]) * bf_hi(o.w));
                        *pp = w; } } }
    }
};
}

__device__ __forceinline__ void p0_transpose_item(const float* W, int ldw, int K, int nblk, int shift_from, int shift, bf16* WT, int row_off, LAS float* scr, int item, int lane, int ldt = 0, int kofs = 0) {
    const int kb = item / nblk, nb = item % nblk, k0 = 64 * kb, n0 = 32 * nb, sn0 = n0 + (n0 >= shift_from ? shift : 0);
#pragma unroll 8
    for (int i = 0; i < 32; ++i) { const int kk = 2 * i + (lane >> 5); scr[kk * 33 + (lane & 31)] = W[(size_t)(k0 + kk) * ldw + sn0 + (lane & 31)]; }
    LDS_WAIT(); asm volatile("" ::: "memory");
    const int c = lane & 7;
#pragma unroll
    for (int j = 0; j < 4; ++j) { const int n = (lane >> 3) + 8 * j; const LAS float* s = scr + (8 * c) * 33 + n;
        v4u o; o.x = pk2(s[0 * 33], s[1 * 33]); o.y = pk2(s[2 * 33], s[3 * 33]); o.z = pk2(s[4 * 33], s[5 * 33]); o.w = pk2(s[6 * 33], s[7 * 33]);
        *(GAS v4u*)(WT + (size_t)(row_off + n0 + n) * (ldt ? ldt : K) + kofs + k0 + 8 * c) = o; }
    LDS_WAIT(); asm volatile("" ::: "memory");
}
__device__ __forceinline__ float log_sigmoidf(float x) { return -(fmaxf(-x, 0.f) + log1pf(expf(-fabsf(x)))); }

__device__ __forceinline__ void p0_prologue(Frame& F) {
    const int gw = F.vcu * NWAVES + F.wave, NGW = F.G * NWAVES, lane = F.lane;
    {
        LAS float* scr = (LAS float*)(F.lds + RING_OFF + F.wave * 16384);
        constexpr int I_IN = 16 * (NPROJ / 32), I_SB = 8 * 32, I_ML = 8 * 32, I_OUT = 16 * 32, I_WQ = 16 * 64, I_WG = 16 * 32, I_PLE = 4 * 32;
        constexpr int NITEMS = I_IN + I_SB + I_ML + I_OUT + I_WQ + I_WG + I_PLE;
        for (int it = gw; it < NITEMS; it += NGW) {
            int r = it;
            if (r < I_IN) { p0_transpose_item(F.in[4], INW, 1024, NPROJ / 32, GATE_COL, 8, WSP(bf16, WS_WIN_T), 0, scr, r, lane); continue; } r -= I_IN;
            if (r < I_SB) { p0_transpose_item(F.in[9], 1024, 512, 32, 1 << 30, 0, WSP(bf16, WS_WSB_T), 0, scr, r, lane, 1024, 0); continue; } r -= I_SB;
            if (r < I_ML) { p0_transpose_item(F.in[10], 1024, 512, 32, 1 << 30, 0, WSP(bf16, WS_WSB_T), 0, scr, r, lane, 1024, 512); continue; } r -= I_ML;
            if (r < I_OUT) { p0_transpose_item(F.in[11], 1024, 1024, 32, 1 << 30, 0, WSP(bf16, WS_WOUT_T), 0, scr, r, lane); continue; } r -= I_OUT;
            if (r < I_WQ) { p0_transpose_item(F.in[14], 2048, 1024, 64, 1 << 30, 0, WSP(bf16, WS_WQG_T), 0, scr, r, lane); continue; } r -= I_WQ;
            if (r < I_WG) { p0_transpose_item(F.in[19], 1024, 1024, 32, 1 << 30, 0, WSP(bf16, WS_WQG_T), 2048, scr, r, lane); continue; } r -= I_WG;
            p0_transpose_item(F.in[20], 1024, 256, 32, 1 << 30, 0, WSP(bf16, WS_WPLE_T), 0, scr, r, lane);
        }
    }
    {
        const float* p = F.in[1]; bf16* PB = WSP(bf16, WS_PB);
        const size_t nchunk = (size_t)M * 256 / 8, stride = (size_t)F.G * NWAVES * 64;
        for (size_t i = (size_t)F.vcu * NWAVES * 64 + F.tid; i < nchunk; i += stride) {
            const f32x4 a = *(const GAS f32x4*)(p + i * 8), b = *(const GAS f32x4*)(p + i * 8 + 4);
            v4u o; o.x = pk2(a.x, a.y); o.y = pk2(a.z, a.w); o.z = pk2(b.x, b.y); o.w = pk2(b.z, b.w);
            *(GAS v4u*)(PB + i * 8) = o; }
    }
    __syncthreads();
    LAS float* WGt = (LAS float*)(F.lds + RING_OFF);
    for (int i = F.tid; i < 8192; i += NWAVES * 64) { const int k = i >> 3, c = i & 7; WGt[c * 1024 + k] = F.in[4][(size_t)k * INW + GATE_COL + c]; }
    __syncthreads();
    const float* x = F.in[0]; const float* g0 = F.in[2]; const float* b0 = F.in[3];
    f32x4 gv[4], bv[4];
#pragma unroll
    for (int j = 0; j < 4; ++j) { gv[j] = *(const f32x4*)(g0 + 256 * j + 4 * lane); bv[j] = *(const f32x4*)(b0 + 256 * j + 4 * lane); }
    bf16* XN = WSP(bf16, WS_XN); float* stats = WSP(float, WS_STATS); float* GI = WSP(float, WS_GI); float* GF = WSP(float, WS_GF);
    const float big = F.in[5][(lane >> 3) & 3], bfg = F.in[6][(lane >> 3) & 3];
    const bool up16 = (lane & 16) != 0, up8 = (lane & 8) != 0;
    f32x4 vn[4];
    if (gw < M) {
#pragma unroll
        for (int j = 0; j < 4; ++j) vn[j] = ((const GAS f32x4*)(x + (size_t)gw * DM) + lane)[64 * j]; }
    for (int m = gw; m < M; m += NGW) {
        f32x4 v[4]; float s = 0.f;
#pragma unroll
        for (int j = 0; j < 4; ++j) v[j] = vn[j];
        { const int mn = (m + NGW < M) ? m + NGW : m;
#pragma unroll
            for (int j = 0; j < 4; ++j) vn[j] = ((const GAS f32x4*)(x + (size_t)mn * DM) + lane)[64 * j]; }
        __builtin_amdgcn_sched_barrier(0);
#pragma unroll
        for (int j = 0; j < 4; ++j) s += (v[j].x + v[j].y) + (v[j].z + v[j].w);
        const float mean = wave_sum(s) * (1.f / DM); float s2 = 0.f;
#pragma unroll
        for (int j = 0; j < 4; ++j) { v[j] = v[j] - mean; s2 += (v[j].x * v[j].x + v[j].y * v[j].y) + (v[j].z * v[j].z + v[j].w * v[j].w); }
        const float rstd = 1.f / sqrtf(wave_sum(s2) * (1.f / DM) + LN_EPS);
        GAS unsigned long long* o8 = (GAS unsigned long long*)(XN + (size_t)m * DM) + lane;
        float part[8];
#pragma unroll
        for (int c = 0; c < 8; ++c) part[c] = 0.f;
#pragma unroll
        for (int j = 0; j < 4; ++j) { const f32x4 y = v[j] * rstd * gv[j] + bv[j];
            o8[64 * j] = (unsigned long long)pk2(y.x, y.y) | ((unsigned long long)pk2(y.z, y.w) << 32);
#pragma unroll
            for (int c = 0; c < 8; ++c) { const f32x4 w = *(const LAS f32x4*)(WGt + c * 1024 + 256 * j + 4 * lane); part[c] += (y.x * w.x + y.y * w.y) + (y.z * w.z + y.w * w.w); } }
        const float sel = reduce8_transposed(part, up16, up8);
        if (lane == 0) { stats[(size_t)m * 2] = mean; stats[(size_t)m * 2 + 1] = rstd; }
        if ((lane & 7) == 0) { const int c = lane >> 3; if (c < 4) GI[(size_t)m * 4 + c] = sel + big; else GF[(size_t)m * 4 + (c - 4)] = log_sigmoidf(sel + bfg); }
    }
}
template <bool MASK>
__device__ __forceinline__ void sb_block(const f32x16& x, float& R, int kbase, int qg, int hi, unsigned (&pw)[8]) {
    float bt[16], om[16];
#pragma unroll
    for (int r = 0; r < 16; ++r) {
        const float xv = fminf(fmaxf(x[r], -60.f), 60.f);
        const float e = __builtin_amdgcn_exp2f(-xv);
        const float be = __builtin_amdgcn_rcpf(1.0f + e);
        bt[r] = be; om[r] = e * be;
        if (MASK) { const bool c = (kbase + crow(r, hi)) < qg; om[r] = c ? om[r] : 1.f; bt[r] = c ? bt[r] : 0.f; }
    }
    float ex[16], T[4];
#pragma unroll
    for (int g = 0; g < 4; ++g) { ex[4 * g + 3] = 1.f; ex[4 * g + 2] = om[4 * g + 3]; ex[4 * g + 1] = ex[4 * g + 2] * om[4 * g + 2]; ex[4 * g] = ex[4 * g + 1] * om[4 * g + 1]; T[g] = ex[4 * g] * om[4 * g]; }
    float S[4], up[4];
#pragma unroll
    for (int g = 0; g < 4; ++g) { auto rr = __builtin_amdgcn_permlane32_swap(__float_as_uint(T[g]), __float_as_uint(T[g]), false, false);
        const float lo_v = __uint_as_float(rr[0]), up_v = __uint_as_float(rr[1]); S[g] = lo_v * up_v; up[g] = up_v; }
    float base[4];
    base[3] = R; base[2] = base[3] * S[3]; base[1] = base[2] * S[2]; base[0] = base[1] * S[1];
    R = base[0] * S[0];
    float w[16];
#pragma unroll
    for (int g = 0; g < 4; ++g) { const float off = base[g] * (hi == 0 ? up[g] : 1.f);
#pragma unroll
        for (int i = 0; i < 4; ++i) w[4 * g + i] = bt[4 * g + i] * (off * ex[4 * g + i]); }
#pragma unroll
    for (int i = 0; i < 8; ++i) pw[i] = cvtpk(w[2 * i], w[2 * i + 1]);
}

constexpr int AT_KS = 0, AT_KSB = 64 * 144, AT_VT = 2 * AT_KSB, AT_VTB = 64 * 136, AT_FL = AT_VT + 2 * AT_VTB;
__device__ __forceinline__ void attn_unit(Frame& F, int bh, int qb) {
    const int tid = F.tid, lane = F.lane, wave = F.wave, r32 = lane & 31, hi = lane >> 5;
    const int b = bh >> 3, h = bh & 7;
    const size_t rowbase = (size_t)b * SEQ;
    const int q0 = qb * 256, qw = q0 + wave * 32;
    const bf16* PROJ = WSP(bf16, WS_PROJ);
    const bf16* Qs = PROJ + (rowbase + qw) * 512 + h * 64;
    const bf16* Ks = PROJ + SLAB + rowbase * 512 + h * 64;
    const bf16* Vs = PROJ + 2 * SLAB + rowbase * 512 + h * 64;
    bf16x8 qr[4];
#pragma unroll
    for (int ks = 0; ks < 4; ++ks) qr[ks] = *(const bf16x8*)(Qs + (size_t)r32 * 512 + ks * 16 + hi * 8);
    LAS unsigned char* L = F.lds + RING_OFF;
    LAS unsigned* FL = (LAS unsigned*)(L + AT_FL);
    const int skey = tid >> 3, sch = tid & 7;
    f32x16 o0, o1;
#pragma unroll
    for (int r = 0; r < 16; ++r) { o0[r] = 0.f; o1[r] = 0.f; }
    float R = 1.f; bool wdone = false;
    const int NT = (q0 + 256) >> 6;
    v4u kreg, vreg, kreg2, vreg2;
#define AT_LOAD(KR, VR, kt) do { const size_t ro_ = (size_t)((kt) * 64 + skey) * 512 + sch * 8; KR = *(const v4u*)(Ks + ro_); VR = *(const v4u*)(Vs + ro_); } while (0)
#define AT_WRITE(buf) do { *(LAS v4u*)(L + AT_KS + (buf) * AT_KSB + skey * 144 + sch * 16) = kreg; \
        LAS unsigned short* vt_ = (LAS unsigned short*)(L + AT_VT + (buf) * AT_VTB) + (sch * 8) * 68 + skey; \
        vt_[0 * 68] = (unsigned short)(vreg.x & 0xffffu); vt_[1 * 68] = (unsigned short)(vreg.x >> 16); vt_[2 * 68] = (unsigned short)(vreg.y & 0xffffu); vt_[3 * 68] = (unsigned short)(vreg.y >> 16); \
        vt_[4 * 68] = (unsigned short)(vreg.z & 0xffffu); vt_[5 * 68] = (unsigned short)(vreg.z >> 16); vt_[6 * 68] = (unsigned short)(vreg.w & 0xffffu); vt_[7 * 68] = (unsigned short)(vreg.w >> 16); } while (0)
    AT_LOAD(kreg, vreg, NT - 1); AT_WRITE(0);
    AT_LOAD(kreg, vreg, max(NT - 2, 0)); AT_LOAD(kreg2, vreg2, max(NT - 3, 0));
    __syncthreads();
    int cur = 0, par = 0;
    for (int kt = NT - 1; kt >= 0; --kt) {
        if (!wdone && 64 * kt < qw + 31) {
            const bool full = (64 * kt + 63 < qw);
#pragma unroll
            for (int kbi = 0; kbi < 2; ++kbi) { const int kb = 1 - kbi; const int kbase = 64 * kt + 32 * kb;
                if (kbase < qw + 31) {
                    f32x16 x;
#pragma unroll
                    for (int r = 0; r < 16; ++r) x[r] = 0.f;
#pragma unroll
                    for (int ks = 0; ks < 4; ++ks) { const bf16x8 a = *(const LAS bf16x8*)(L + AT_KS + cur * AT_KSB + (32 * kb + r32) * 144 + (16 * ks + 8 * hi) * 2); x = MFMA32(a, qr[ks], x); }
                    unsigned pw[8];
                    if (full) sb_block<false>(x, R, kbase, qw + r32, hi, pw); else sb_block<true>(x, R, kbase, qw + r32, hi, pw);
#pragma unroll
                    for (int s2 = 0; s2 < 2; ++s2) { v4u av; av.x = pw[4 * s2]; av.y = pw[4 * s2 + 1]; av.z = pw[4 * s2 + 2]; av.w = pw[4 * s2 + 3]; const bf16x8 a = __builtin_bit_cast(bf16x8, av);
#pragma unroll
                        for (int dt = 0; dt < 2; ++dt) { const LAS unsigned char* vp = L + AT_VT + cur * AT_VTB + (32 * dt + r32) * 136 + (32 * kb + 16 * s2 + 4 * hi) * 2;
                            const u32x2 b0 = *(const LAS u32x2*)vp, b1 = *(const LAS u32x2*)(vp + 16);
                            v4u bv; bv.x = b0.x; bv.y = b0.y; bv.z = b1.x; bv.w = b1.y; const bf16x8 bb = __builtin_bit_cast(bf16x8, bv);
                            if (dt == 0) o0 = MFMA32(a, bb, o0); else o1 = MFMA32(a, bb, o1); } }
                }
            }
#if SB_EARLY_EXIT
            wdone = __all(R == 0.f);
#endif
        }
        if (lane == 0) FL[par * 8 + wave] = wdone ? 1u : 0u;
        if (kt > 0) AT_WRITE(cur ^ 1);
        kreg = kreg2; vreg = vreg2; AT_LOAD(kreg2, vreg2, max(kt - 3, 0));
        __syncthreads();
        unsigned alld = 1u;
#pragma unroll
        for (int w = 0; w < 8; ++w) alld &= FL[par * 8 + w];
        cur ^= 1; par ^= 1;
        if (alld) break;
    }
#undef AT_LOAD
#undef AT_WRITE
    bf16* Ow = WSP(bf16, WS_OCAT) + (rowbase + qw) * 1024 + h * 64 + r32;
#pragma unroll
    for (int r = 0; r < 16; ++r) { const int q = crow(r, hi); Ow[(size_t)q * 1024] = (bf16)f2bf(o0[r]); Ow[(size_t)q * 1024 + 32] = (bf16)f2bf(o1[r]); }
    __syncthreads();
}

template <bool TRANS>
__device__ __forceinline__ void ml_stage_conv(Frame& F, const bf16* raw, int t0, const float* cw, const float* cb, float scale, LAS bf16* dst) {
    const int cg = F.tid & 15, rr = F.tid >> 4;
    float w[4][8], bb[8];
#pragma unroll
    for (int j = 0; j < 4; ++j) { const f32x4 a = *(const f32x4*)(cw + j * 1024 + cg * 8), c = *(const f32x4*)(cw + j * 1024 + cg * 8 + 4);
        w[j][0] = a.x; w[j][1] = a.y; w[j][2] = a.z; w[j][3] = a.w; w[j][4] = c.x; w[j][5] = c.y; w[j][6] = c.z; w[j][7] = c.w; }
    { const f32x4 a = *(const f32x4*)(cb + cg * 8), c = *(const f32x4*)(cb + cg * 8 + 4); bb[0] = a.x; bb[1] = a.y; bb[2] = a.z; bb[3] = a.w; bb[4] = c.x; bb[5] = c.y; bb[6] = c.z; bb[7] = c.w; }
#pragma unroll
    for (int p = 0; p < 4; ++p) { const int s = p * 32 + rr;
        float y[8];
#pragma unroll
        for (int i = 0; i < 8; ++i) y[i] = bb[i];
#pragma unroll
        for (int j = 0; j < 4; ++j) { const int t = t0 + s - j;
            v4u rv = {0u, 0u, 0u, 0u};
            if (t >= 0) rv = *(const v4u*)(raw + (size_t)t * 512 + cg * 8);
            y[0] += w[j][0] * bf_lo(rv.x); y[1] += w[j][1] * bf_hi(rv.x); y[2] += w[j][2] * bf_lo(rv.y); y[3] += w[j][3] * bf_hi(rv.y);
            y[4] += w[j][4] * bf_lo(rv.z); y[5] += w[j][5] * bf_hi(rv.z); y[6] += w[j][6] * bf_lo(rv.w); y[7] += w[j][7] * bf_hi(rv.w); }
#pragma unroll
        for (int i = 0; i < 8; ++i) y[i] = siluf_fast(y[i]) * scale;
        if (!TRANS) { v4u o; o.x = cvtpk(y[0], y[1]); o.y = cvtpk(y[2], y[3]); o.z = cvtpk(y[4], y[5]); o.w = cvtpk(y[6], y[7]); *(LAS v4u*)(dst + s * 136 + cg * 8) = o; }
        else {
#pragma unroll
            for (int i = 0; i < 8; ++i) dst[(cg * 8 + i) * 136 + s] = (bf16)f2bf(y[i]); }
    }
}
__device__ __forceinline__ void scan_add128(float a0, float a1, int lane, float& o0, float& o1) {
    float v = a0 + a1;
#pragma unroll
    for (int d = 1; d < 64; d <<= 1) { const float t = __shfl_up(v, d); if (lane >= d) v += t; }
    const float exv = v - (a0 + a1); o0 = exv + a0; o1 = exv + a0 + a1;
}
__device__ __forceinline__ void scan_max128(float a0, float a1, int lane, float& o0, float& o1) {
    float v = fmaxf(a0, a1);
#pragma unroll
    for (int d = 1; d < 64; d <<= 1) { const float t = __shfl_up(v, d); if (lane >= d) v = fmaxf(v, t); }
    float pv = __shfl_up(v, 1); if (lane == 0) pv = -INFINITY;
    o0 = fmaxf(pv, a0); o1 = fmaxf(o0, a1);
}

constexpr int ML_T0 = 0, ML_T1 = 34816, ML_T2 = 69632, ML_SM = 104448;
__device__ __forceinline__ void mla_unit(Frame& F, int u) {
    const int tid = F.tid, lane = F.lane, wave = F.wave, r32 = lane & 31, hi = lane >> 5;
    const int bhd = u >> 6, ch = u & 63, b = bhd >> 2, hd = bhd & 3;
    const size_t rowbase = (size_t)b * SEQ; const int t0 = ch * 128;
    LAS unsigned char* L = F.lds + RING_OFF;
    LAS bf16* KT = (LAS bf16*)(L + ML_T0); LAS bf16* VT = (LAS bf16*)(L + ML_T1);
    LAS float* BC = (LAS float*)(L + ML_SM); LAS float* EE = BC + 128; LAS float* SC = BC + 256;
    const bf16* PROJ = WSP(bf16, WS_PROJ);
    const float* GI = WSP(float, WS_GI); const float* GF = WSP(float, WS_GF);
    if (wave == 0) {
        const size_t r0 = rowbase + t0 + 2 * lane;
        const float f0 = GF[r0 * 4 + hd], f1 = GF[(r0 + 1) * 4 + hd], i0 = GI[r0 * 4 + hd], i1 = GI[(r0 + 1) * 4 + hd];
        float c0, c1; scan_add128(f0, f1, lane, c0, c1);
        const float blast = __shfl(c1, 63);
        const float w0 = blast - c0 + i0, w1 = blast - c1 + i1;
        const float mloc = wave_max(fmaxf(w0, w1));
        EE[2 * lane] = __expf(w0 - mloc); EE[2 * lane + 1] = __expf(w1 - mloc);
        if (lane == 0) { float* S = WSP(float, WS_MLS); S[u] = mloc; S[1024 + u] = blast; }
    }
    ml_stage_conv<true>(F, PROJ + 4 * SLAB + rowbase * 512 + hd * 128, t0, F.in[7] + 512 + hd * 128, F.in[8] + 512 + hd * 128, 0.08838834764831845f, KT);
    __syncthreads();
    {
        const bf16* Vs = PROJ + 5 * SLAB + (rowbase + t0) * 512 + hd * 128;
        const int cg = tid & 15, rr = tid >> 4;
#pragma unroll
        for (int p = 0; p < 4; ++p) { const int s = p * 32 + rr; const float e = EE[s]; const v4u rv = *(const v4u*)(Vs + (size_t)s * 512 + cg * 8);
            LAS bf16* d = VT + (cg * 8) * 136 + s;
            d[0 * 136] = (bf16)f2bf(e * bf_lo(rv.x)); d[1 * 136] = (bf16)f2bf(e * bf_hi(rv.x)); d[2 * 136] = (bf16)f2bf(e * bf_lo(rv.y)); d[3 * 136] = (bf16)f2bf(e * bf_hi(rv.y));
            d[4 * 136] = (bf16)f2bf(e * bf_lo(rv.z)); d[5 * 136] = (bf16)f2bf(e * bf_hi(rv.z)); d[6 * 136] = (bf16)f2bf(e * bf_lo(rv.w)); d[7 * 136] = (bf16)f2bf(e * bf_hi(rv.w)); }
    }
    if (tid < 128) {
        float n = 0.f; const LAS bf16* kr = KT + tid * 136;
#pragma unroll 4
        for (int s8 = 0; s8 < 16; ++s8) { const v4u kv = *(const LAS v4u*)(kr + s8 * 8); const LAS float* ep = EE + s8 * 8;
            n += ep[0] * bf_lo(kv.x) + ep[1] * bf_hi(kv.x) + ep[2] * bf_lo(kv.y) + ep[3] * bf_hi(kv.y) + ep[4] * bf_lo(kv.z) + ep[5] * bf_hi(kv.z) + ep[6] * bf_lo(kv.w) + ep[7] * bf_hi(kv.w); }
        WSP(float, WS_MLN)[(size_t)u * 128 + tid] = n;
    }
    __syncthreads();
    {
        const int dvt = wave >> 1, eh = wave & 1;
        f32x16 c0, c1;
#pragma unroll
        for (int r = 0; r < 16; ++r) { c0[r] = 0.f; c1[r] = 0.f; }
#pragma unroll
        for (int ks = 0; ks < 8; ++ks) { const bf16x8 a = *(const LAS bf16x8*)(VT + (32 * dvt + r32) * 136 + 16 * ks + 8 * hi);
            const bf16x8 b0 = *(const LAS bf16x8*)(KT + (64 * eh + r32) * 136 + 16 * ks + 8 * hi), b1 = *(const LAS bf16x8*)(KT + (64 * eh + 32 + r32) * 136 + 16 * ks + 8 * hi);
            c0 = MFMA32(a, b0, c0); c1 = MFMA32(a, b1, c1); }
        bf16* Cg = WSP(bf16, WS_C) + (size_t)u * 16384 + 64 * eh + r32;
#pragma unroll
        for (int r = 0; r < 16; ++r) { const int dv = 32 * dvt + crow(r, hi); Cg[(size_t)dv * 128] = (bf16)f2bf(c0[r]); Cg[(size_t)dv * 128 + 32] = (bf16)f2bf(c1[r]); }
    }
    __syncthreads();
}

__device__ __forceinline__ void ml_scan_item(Frame& F, int item, const size_t dummy = 0) {
    const int tid = F.tid; const int bhd = item >> 4, part = item & 15;
    LAS float* SM = (LAS float*)(F.lds + RING_OFF);
    float* S = WSP(float, WS_MLS);
    if (tid < 64) SM[tid] = S[bhd * 64 + tid]; else if (tid < 128) SM[tid] = S[1024 + bhd * 64 + (tid - 64)];
    unsigned* Cw = WSP(unsigned, WS_C) + (size_t)bhd * 64 * 8192 + (size_t)(part * 8 + (tid >> 6)) * 64 + (tid & 63);
    unsigned cl[64];
#pragma unroll
    for (int j = 0; j < 64; ++j) cl[j] = Cw[(size_t)j * 8192];
    const bool do_n = (part == 0 && tid < 128);
    float* Nw = WSP(float, WS_MLN) + (size_t)bhd * 64 * 128 + (tid & 127);
    float nlv[64];
#pragma unroll
    for (int j = 0; j < 64; ++j) nlv[j] = do_n ? Nw[(size_t)j * 128] : 0.f;
    __syncthreads();
    float c0 = 0.f, c1 = 0.f, m = 0.f, n = 0.f;
#pragma unroll
    for (int j = 0; j < 64; ++j) {
        const float ml = SM[j], bl = SM[64 + j];
        (dummy ? (unsigned*)(F.ws + dummy) + (Cw - WSP(unsigned, WS_C)) : Cw)[(size_t)j * 8192] = cvtpk(c0, c1);
        const float nl = nlv[j]; if (do_n) (dummy ? (float*)(F.ws + dummy + 40 * MiB) + (Nw - WSP(float, WS_MLN)) : Nw)[(size_t)j * 128] = n;
        if (part == 0 && tid == 0) (dummy ? (float*)(F.ws + dummy + 48 * MiB) : S)[2048 + bhd * 64 + j] = m;
        const float mn = fmaxf(bl + m, ml), a = __expf(bl + m - mn), g = __expf(ml - mn);
        c0 = a * c0 + g * bf_lo(cl[j]); c1 = a * c1 + g * bf_hi(cl[j]); n = a * n + g * nl; m = mn;
    }
    __syncthreads();
}

__device__ __forceinline__ void mlc_unit(Frame& F, int u) {
    const int tid = F.tid, lane = F.lane, wave = F.wave, r32 = lane & 31, hi = lane >> 5;
    const int bhd = u >> 6, ch = u & 63, b = bhd >> 2, hd = bhd & 3;
    const size_t rowbase = (size_t)b * SEQ; const int t0 = ch * 128;
    LAS unsigned char* L = F.lds + RING_OFF;
    LAS bf16* QS = (LAS bf16*)(L + ML_T0); LAS bf16* KS = (LAS bf16*)(L + ML_T1); LAS bf16* VT = (LAS bf16*)(L + ML_T2);
    LAS float* AA = (LAS float*)(L + ML_SM); LAS float* MM = AA + 128; LAS float* AT = AA + 256; LAS float* EM = AA + 384; LAS float* NP = AA + 512; LAS float* NQ = AA + 640; LAS float* INV = AA + 768;
    const bf16* PROJ = WSP(bf16, WS_PROJ);
    const float* GI = WSP(float, WS_GI); const float* GF = WSP(float, WS_GF);
    const float mprev = WSP(float, WS_MLS)[2048 + u];
    if (wave == 0) {
        const size_t r0 = rowbase + t0 + 2 * lane;
        const float f0 = GF[r0 * 4 + hd], f1 = GF[(r0 + 1) * 4 + hd], i0 = GI[r0 * 4 + hd], i1 = GI[(r0 + 1) * 4 + hd];
        float c0, c1; scan_add128(f0, f1, lane, c0, c1);
        const float a0 = i0 - c0, a1 = i1 - c1;
        float p0, p1; scan_max128(a0, a1, lane, p0, p1);
        const float m0 = fmaxf(mprev, p0), m1 = fmaxf(mprev, p1);
        AA[2 * lane] = a0; AA[2 * lane + 1] = a1; MM[2 * lane] = m0; MM[2 * lane + 1] = m1;
        AT[2 * lane] = __expf(mprev - m0); AT[2 * lane + 1] = __expf(mprev - m1);
        EM[2 * lane] = __expf(-(c0 + m0)); EM[2 * lane + 1] = __expf(-(c1 + m1));
    } else if (wave == 1) {
        const float* Np = WSP(float, WS_MLN) + (size_t)u * 128; NP[2 * lane] = Np[2 * lane]; NP[2 * lane + 1] = Np[2 * lane + 1];
    }
    ml_stage_conv<false>(F, PROJ + 3 * SLAB + rowbase * 512 + hd * 128, t0, F.in[7] + hd * 128, F.in[8] + hd * 128, 1.0f, QS);
    ml_stage_conv<false>(F, PROJ + 4 * SLAB + rowbase * 512 + hd * 128, t0, F.in[7] + 512 + hd * 128, F.in[8] + 512 + hd * 128, 0.08838834764831845f, KS);
    {
        const bf16* Vs = PROJ + 5 * SLAB + (rowbase + t0) * 512 + hd * 128;
        const int cg = tid & 15, rr = tid >> 4;
#pragma unroll
        for (int p = 0; p < 4; ++p) { const int s = p * 32 + rr; const v4u rv = *(const v4u*)(Vs + (size_t)s * 512 + cg * 8);
            LAS bf16* d = VT + (cg * 8) * 136 + s;
            d[0 * 136] = (bf16)(rv.x & 0xffffu); d[1 * 136] = (bf16)(rv.x >> 16); d[2 * 136] = (bf16)(rv.y & 0xffffu); d[3 * 136] = (bf16)(rv.y >> 16);
            d[4 * 136] = (bf16)(rv.z & 0xffffu); d[5 * 136] = (bf16)(rv.z >> 16); d[6 * 136] = (bf16)(rv.w & 0xffffu); d[7 * 136] = (bf16)(rv.w >> 16); }
    }
    __syncthreads();
    if (tid < 128) {
        float n = 0.f; const LAS bf16* qrow = QS + tid * 136;
#pragma unroll 4
        for (int e8 = 0; e8 < 16; ++e8) { const v4u qv = *(const LAS v4u*)(qrow + e8 * 8); const LAS float* np = NP + e8 * 8;
            n += np[0] * bf_lo(qv.x) + np[1] * bf_hi(qv.x) + np[2] * bf_lo(qv.y) + np[3] * bf_hi(qv.y) + np[4] * bf_lo(qv.z) + np[5] * bf_hi(qv.z) + np[6] * bf_lo(qv.w) + np[7] * bf_hi(qv.w); }
        NQ[tid] = n;
    }
    const int tt = wave >> 1, dh = wave & 1;
    f32x16 acc0, acc1;
#pragma unroll
    for (int r = 0; r < 16; ++r) { acc0[r] = 0.f; acc1[r] = 0.f; }
    {
        const bf16* Cg = WSP(bf16, WS_C) + (size_t)u * 16384;
#pragma unroll
        for (int ks = 0; ks < 8; ++ks) { const bf16x8 a = *(const LAS bf16x8*)(QS + (32 * tt + r32) * 136 + 16 * ks + 8 * hi);
            const bf16x8 b0 = *(const bf16x8*)(Cg + (size_t)(64 * dh + r32) * 128 + 16 * ks + 8 * hi), b1 = *(const bf16x8*)(Cg + (size_t)(64 * dh + 32 + r32) * 128 + 16 * ks + 8 * hi);
            acc0 = MFMA32(a, b0, acc0); acc1 = MFMA32(a, b1, acc1); }
#pragma unroll
        for (int r = 0; r < 16; ++r) { const float at = AT[32 * tt + crow(r, hi)]; acc0[r] *= at; acc1[r] *= at; }
    }
    float den = 0.f;
    const int tg = 32 * tt + r32; const float mmt = MM[tg];
    for (int st = 0; st <= tt; ++st) {
        f32x16 sT;
#pragma unroll
        for (int r = 0; r < 16; ++r) sT[r] = 0.f;
#pragma unroll
        for (int ks = 0; ks < 8; ++ks) { const bf16x8 a = *(const LAS bf16x8*)(KS + (32 * st + r32) * 136 + 16 * ks + 8 * hi); const bf16x8 bq = *(const LAS bf16x8*)(QS + (32 * tt + r32) * 136 + 16 * ks + 8 * hi);
            sT = MFMA32(a, bq, sT); }
        float p[16];
#pragma unroll
        for (int r = 0; r < 16; ++r) { const int s = 32 * st + crow(r, hi); const float wgt = (s <= tg) ? __expf(AA[s] - mmt) : 0.f; p[r] = sT[r] * wgt; den += p[r]; }
#pragma unroll
        for (int s2 = 0; s2 < 2; ++s2) { v4u av; av.x = cvtpk(p[8 * s2], p[8 * s2 + 1]); av.y = cvtpk(p[8 * s2 + 2], p[8 * s2 + 3]); av.z = cvtpk(p[8 * s2 + 4], p[8 * s2 + 5]); av.w = cvtpk(p[8 * s2 + 6], p[8 * s2 + 7]);
            const bf16x8 a = __builtin_bit_cast(bf16x8, av);
#pragma unroll
            for (int d = 0; d < 2; ++d) { const LAS bf16* vp = VT + (64 * dh + 32 * d + r32) * 136 + 32 * st + 16 * s2 + 4 * hi;
                const u32x2 b0 = *(const LAS u32x2*)vp, b1 = *(const LAS u32x2*)(vp + 8);
                v4u bv; bv.x = b0.x; bv.y = b0.y; bv.z = b1.x; bv.w = b1.y; const bf16x8 bb = __builtin_bit_cast(bf16x8, bv);
                if (d == 0) acc0 = MFMA32(a, bb, acc0); else acc1 = MFMA32(a, bb, acc1); } }
    }
    { auto rr = __builtin_amdgcn_permlane32_swap(__float_as_uint(den), __float_as_uint(den), false, false); den = __uint_as_float(rr[0]) + __uint_as_float(rr[1]); }
    __syncthreads();
    if (dh == 0 && hi == 0) { const float dn = AT[tg] * NQ[tg] + den; INV[tg] = 1.0f / fmaxf(fabsf(dn), EM[tg]); }
    __syncthreads();
    {
        const bf16* Og = PROJ + 6 * SLAB + (rowbase + t0) * 512 + hd * 128 + 64 * dh + r32;
        bf16* Out = WSP(bf16, WS_OCAT) + (rowbase + t0) * 1024 + 512 + hd * 128 + 64 * dh + r32;
#pragma unroll
        for (int r = 0; r < 16; ++r) { const int t = 32 * tt + crow(r, hi); const float iv = INV[t];
            const float g0 = sigmoidf_fast(bf_lo((unsigned)Og[(size_t)t * 512])), g1 = sigmoidf_fast(bf_lo((unsigned)Og[(size_t)t * 512 + 32]));
            Out[(size_t)t * 1024] = (bf16)f2bf(acc0[r] * iv * g0); Out[(size_t)t * 1024 + 32] = (bf16)f2bf(acc1[r] * iv * g1); }
    }
    __syncthreads();
}
__device__ __forceinline__ void p7_ln1_tables(Frame& F) {
    const int gw = F.vcu * NWAVES + F.wave, NGW = F.G * NWAVES, lane = F.lane;
    const float* g1 = F.in[12]; const float* b1 = F.in[13];
    f32x4 gv[4], bv[4];
#pragma unroll
    for (int j = 0; j < 4; ++j) { gv[j] = *(const f32x4*)(g1 + 256 * j + 4 * lane); bv[j] = *(const f32x4*)(b1 + 256 * j + 4 * lane); }
    const bf16* MIX = WSP(bf16, WS_PRE1); bf16* H1B = WSP(bf16, WS_H1B); const float* x = F.in[0]; const float* stats = WSP(float, WS_STATS);
    f32x4 g0v[4], b0v[4];
#pragma unroll
    for (int j = 0; j < 4; ++j) { g0v[j] = *(const f32x4*)(F.in[2] + 256 * j + 4 * lane); b0v[j] = *(const f32x4*)(F.in[3] + 256 * j + 4 * lane); }
    f32x4 xn[4]; u32x2 mn4[4]; f32x2 stn = {0.f, 1.f};
    if (gw < M) { stn = *(const f32x2*)(stats + (size_t)gw * 2);
#pragma unroll
        for (int j = 0; j < 4; ++j) { xn[j] = ((const GAS f32x4*)(x + (size_t)gw * DM) + lane)[64 * j]; mn4[j] = ((const GAS u32x2*)(MIX + (size_t)gw * DM) + lane)[64 * j]; } }
    for (int m = gw; m < M; m += NGW) {
        f32x4 xc[4]; u32x2 mc[4]; const f32x2 stc = stn;
#pragma unroll
        for (int j = 0; j < 4; ++j) { xc[j] = xn[j]; mc[j] = mn4[j]; }
        { const int mnx = (m + NGW < M) ? m + NGW : m; stn = *(const f32x2*)(stats + (size_t)mnx * 2);
#pragma unroll
            for (int j = 0; j < 4; ++j) { xn[j] = ((const GAS f32x4*)(x + (size_t)mnx * DM) + lane)[64 * j]; mn4[j] = ((const GAS u32x2*)(MIX + (size_t)mnx * DM) + lane)[64 * j]; } }
        __builtin_amdgcn_sched_barrier(0);
        const float mean0 = stc.x, rstd0 = stc.y;
        f32x4 v[4]; float s = 0.f;
#pragma unroll
        for (int j = 0; j < 4; ++j) { const f32x4 xv = xc[j]; const u32x2 mv = mc[j];
            const f32x4 h0 = (xv - mean0) * rstd0 * g0v[j] + b0v[j];
            v[j].x = ALPHA * h0.x + bf_lo(mv.x); v[j].y = ALPHA * h0.y + bf_hi(mv.x); v[j].z = ALPHA * h0.z + bf_lo(mv.y); v[j].w = ALPHA * h0.w + bf_hi(mv.y);
            s += (v[j].x + v[j].y) + (v[j].z + v[j].w); }
        const float mean = wave_sum(s) * (1.f / DM); float s2 = 0.f;
#pragma unroll
        for (int j = 0; j < 4; ++j) { v[j] = v[j] - mean; s2 += (v[j].x * v[j].x + v[j].y * v[j].y) + (v[j].z * v[j].z + v[j].w * v[j].w); }
        const float rstd = 1.f / sqrtf(wave_sum(s2) * (1.f / DM) + LN_EPS);
        GAS unsigned long long* o8 = (GAS unsigned long long*)(H1B + (size_t)m * DM) + lane;
#pragma unroll
        for (int j = 0; j < 4; ++j) { const f32x4 y = v[j] * rstd * gv[j] + bv[j]; o8[64 * j] = (unsigned long long)pk2(y.x, y.y) | ((unsigned long long)pk2(y.z, y.w) << 32); }
    }
    const size_t nchunk = (size_t)16384 * 1024 / 16, stride = (size_t)F.G * NWAVES * 64;
#pragma unroll 1
    for (int tb = 0; tb < 2; ++tb) { const float* src = F.in[17 + tb]; unsigned char* dst = WSP(unsigned char, tb == 0 ? WS_UT : WS_VT); const float sc = tb == 0 ? U_SCALE : V_SCALE;
        for (size_t i = (size_t)F.vcu * NWAVES * 64 + F.tid; i < nchunk; i += stride) {
            v4u o;
#pragma unroll
            for (int w = 0; w < 4; ++w) { const f32x4 a = *(const GAS f32x4*)(src + i * 16 + w * 4); int pk = 0;
                pk = __builtin_amdgcn_cvt_pk_fp8_f32(a.x * sc, a.y * sc, pk, false); pk = __builtin_amdgcn_cvt_pk_fp8_f32(a.z * sc, a.w * sc, pk, true); o[w] = (unsigned)pk; }
            *(GAS v4u*)(dst + i * 16) = o; } }
}

constexpr int RT_K1 = 0, RT_K2 = 34816, RT_VL = 69632, RT_FL = 102400;
#define CE_DESC(a, b) do { const float hi_ = fmaxf(a, b), lo_ = fminf(a, b); a = hi_; b = lo_; } while (0)
__device__ __forceinline__ void sort16_desc(f32x16& v) {
#pragma unroll
    for (int k = 2; k <= 16; k <<= 1)
#pragma unroll
        for (int j = k >> 1; j > 0; j >>= 1)
#pragma unroll
            for (int i = 0; i < 16; ++i) { const int l = i ^ j; if (l > i) { float a = v[i], b = v[l]; if ((i & k) == 0) { CE_DESC(a, b); } else { CE_DESC(b, a); } v[i] = a; v[l] = b; } }
}
__device__ __forceinline__ void merge16_desc(f32x16& a, const f32x16& b) {
#pragma unroll
    for (int i = 0; i < 16; ++i) a[i] = fmaxf(a[i], b[15 - i]);
#pragma unroll
    for (int j = 8; j > 0; j >>= 1)
#pragma unroll
        for (int i = 0; i < 16; ++i) { const int l = i ^ j; if (l > i) { float x = a[i], y = a[l]; CE_DESC(x, y); a[i] = x; a[l] = y; } }
}
__host__ __device__ constexpr int cand_ij(int n) { int c = 0; for (int i = 0; i < 16; ++i) for (int j = 0; j < 16; ++j) if ((i + 1) * (j + 1) <= 16) { if (c == n) return i * 16 + j; ++c; } return 0; }
__device__ __forceinline__ void p9_route(Frame& F) {
    const int tid = F.tid, lane = F.lane, wave = F.wave, r32 = lane & 31, hi = lane >> 5;
    LAS unsigned char* L = F.lds + RING_OFF;
    for (int i = tid; i < 2 * 128 * 32; i += NWAVES * 64) { const int which = i >> 12, row = (i >> 5) & 127, c4 = (i & 31) * 4;
        const f32x4 a = *(const f32x4*)(F.in[15 + which] + row * 128 + c4);
        u32x2 o; o.x = pk2(a.x, a.y); o.y = pk2(a.z, a.w);
        *(LAS u32x2*)(L + (which ? RT_K2 : RT_K1) + row * 272 + c4 * 2) = o; }
    __syncthreads();
    const bf16* Q = WSP(bf16, WS_Q); int* IDX = WSP(int, WS_IDX); float* GATE = WSP(float, WS_GATE);
    LAS float* VL = (LAS float*)(L + RT_VL) + (wave * 32 + r32) * 32;
    const int gw = F.vcu * NWAVES + wave, NGW = F.G * NWAVES;
    for (int unit = gw; unit < (M / 32) * 8; unit += NGW) {
        const int tg = unit >> 3, hd = unit & 7; const size_t tok = (size_t)tg * 32 + r32;
        const bf16* qp = Q + tok * 2048 + hd * 256;
        f32x16 top[2];
#pragma unroll
        for (int half = 0; half < 2; ++half) {
            f32x16 s0, s1, s2, s3;
#pragma unroll
            for (int r = 0; r < 16; ++r) { s0[r] = 0.f; s1[r] = 0.f; s2[r] = 0.f; s3[r] = 0.f; }
            const LAS unsigned char* KB = L + (half ? RT_K2 : RT_K1);
#pragma unroll
            for (int ks = 0; ks < 8; ++ks) { const bf16x8 bq = *(const bf16x8*)(qp + half * 128 + ks * 16 + hi * 8);
                const LAS unsigned char* ka = KB + r32 * 272 + (16 * ks + 8 * hi) * 2;
                s0 = MFMA32(*(const LAS bf16x8*)(ka), bq, s0); s1 = MFMA32(*(const LAS bf16x8*)(ka + 32 * 272), bq, s1);
                s2 = MFMA32(*(const LAS bf16x8*)(ka + 64 * 272), bq, s2); s3 = MFMA32(*(const LAS bf16x8*)(ka + 96 * 272), bq, s3); }
#pragma unroll
            for (int r = 0; r < 16; ++r) { const unsigned key = (unsigned)crow(r, hi);
                s0[r] = __uint_as_float((__float_as_uint(s0[r]) & ~127u) | key); s1[r] = __uint_as_float((__float_as_uint(s1[r]) & ~127u) | (key + 32u));
                s2[r] = __uint_as_float((__float_as_uint(s2[r]) & ~127u) | (key + 64u)); s3[r] = __uint_as_float((__float_as_uint(s3[r]) & ~127u) | (key + 96u)); }
            sort16_desc(s0); sort16_desc(s1); sort16_desc(s2); sort16_desc(s3);
            merge16_desc(s0, s1); merge16_desc(s2, s3); merge16_desc(s0, s2);
            f32x16 pa, pb;
#pragma unroll
            for (int i = 0; i < 16; ++i) { auto rr = __builtin_amdgcn_permlane32_swap(__float_as_uint(s0[i]), __float_as_uint(s0[i]), false, false); pa[i] = __uint_as_float(rr[0]); pb[i] = __uint_as_float(rr[1]); }
            merge16_desc(pa, pb);
            top[half] = pa;
        }
        if (hi == 0) {
#pragma unroll
            for (int i = 0; i < 16; ++i) { VL[i] = top[0][i]; VL[16 + i] = top[1][i]; } }
        float l1[16], l2[16];
#pragma unroll
        for (int i = 0; i < 16; ++i) { l1[i] = __uint_as_float(__float_as_uint(top[0][i]) & ~127u); l2[i] = __uint_as_float(__float_as_uint(top[1][i]) & ~127u); }
        f32x16 c0, c1, c2, c3;
        {
            int n = 0;
#pragma unroll
            for (int i = 0; i < 16; ++i)
#pragma unroll
                for (int j = 0; j < 16; ++j) if ((i + 1) * (j + 1) <= 16) { const float cv = __uint_as_float((__float_as_uint(l1[i] + l2[j]) & ~255u) | (unsigned)(i * 16 + j));
                    if (n < 16) c0[n & 15] = cv; else if (n < 32) c1[n & 15] = cv; else if (n < 48) c2[n & 15] = cv; else c3[n & 15] = cv; ++n; }
        }
#pragma unroll
        for (int m = 2; m < 16; ++m) c3[m] = -INFINITY;
        sort16_desc(c0); sort16_desc(c1); sort16_desc(c2); sort16_desc(c3);
        merge16_desc(c0, c1); merge16_desc(c2, c3); merge16_desc(c0, c2);
        const f32x16 fa = c0;
        const float topv = __uint_as_float(__float_as_uint(fa[0]) & ~255u);
        float esum = 0.f, ev[8]; int ex[8];
#pragma unroll
        for (int k = 0; k < 16; ++k) { const unsigned bits = __float_as_uint(fa[k]); const float e = __expf(__uint_as_float(bits & ~255u) - topv); esum += e;
            if ((k >> 3) == hi) { ev[k & 7] = e; const int ci = (bits >> 4) & 15, cj = bits & 15;
                ex[k & 7] = (int)((__float_as_uint(VL[ci]) & 127u) * 128u + (__float_as_uint(VL[16 + cj]) & 127u)); } }
        const float inv = 1.0f / esum;
        int* ip = IDX + tok * 128 + hd * 16 + hi * 8; float* gp = GATE + tok * 128 + hd * 16 + hi * 8;
        *(int4*)ip = make_int4(ex[0], ex[1], ex[2], ex[3]); *(int4*)(ip + 4) = make_int4(ex[4], ex[5], ex[6], ex[7]);
        *(f32x4*)gp = (f32x4){ev[0] * inv, ev[1] * inv, ev[2] * inv, ev[3] * inv}; *(f32x4*)(gp + 4) = (f32x4){ev[4] * inv, ev[5] * inv, ev[6] * inv, ev[7] * inv};
    }
    __syncthreads();
}

__device__ __forceinline__ float gelu_erf(float x) { return 0.5f * x * (1.0f + erff(x * 0.70710678118654752f)); }
__device__ __forceinline__ float dot16_fp8(const v4u& u, const float (&h)[16], float acc) {
    f32x2 a2 = {acc, 0.f};
#pragma unroll
    for (int w = 0; w < 4; ++w) { const f32x2 a = __builtin_amdgcn_cvt_pk_f32_fp8((int)u[w], false), b = __builtin_amdgcn_cvt_pk_f32_fp8((int)u[w], true);
        a2 = __builtin_elementwise_fma(a, (f32x2){h[4 * w], h[4 * w + 1]}, a2); a2 = __builtin_elementwise_fma(b, (f32x2){h[4 * w + 2], h[4 * w + 3]}, a2); }
    return a2.x + a2.y;
}
__device__ __forceinline__ void axpy16_fp8(float (&acc)[16], const v4u& v, float c) {
#pragma unroll
    for (int w = 0; w < 4; ++w) { const f32x2 a = __builtin_amdgcn_cvt_pk_f32_fp8((int)v[w], false), b = __builtin_amdgcn_cvt_pk_f32_fp8((int)v[w], true);
        acc[4 * w] = fmaf(c, a.x, acc[4 * w]); acc[4 * w + 1] = fmaf(c, a.y, acc[4 * w + 1]); acc[4 * w + 2] = fmaf(c, b.x, acc[4 * w + 2]); acc[4 * w + 3] = fmaf(c, b.y, acc[4 * w + 3]); }
}
__device__ __forceinline__ void unpack16(const v4u& a, const v4u& b, float (&h)[16]) {
    h[0] = bf_lo(a.x); h[1] = bf_hi(a.x); h[2] = bf_lo(a.y); h[3] = bf_hi(a.y); h[4] = bf_lo(a.z); h[5] = bf_hi(a.z); h[6] = bf_lo(a.w); h[7] = bf_hi(a.w);
    h[8] = bf_lo(b.x); h[9] = bf_hi(b.x); h[10] = bf_lo(b.y); h[11] = bf_hi(b.y); h[12] = bf_lo(b.z); h[13] = bf_hi(b.z); h[14] = bf_lo(b.w); h[15] = bf_hi(b.w);
}
__device__ __forceinline__ float gelu_as(float v) {
    const float av = fabsf(v), t = __builtin_amdgcn_rcpf(fmaf(av, 0.2316418882f, 1.0f));
    float q = fmaf(t, 0.5307027145f, -0.7265760135f); q = fmaf(q, t, 0.7107068705f); q = fmaf(q, t, -0.142248368f); q = fmaf(q, t, 0.127414796f); q = q * t;
    const float e = __builtin_amdgcn_exp2f(v * v * -0.72134752044f), m = v * (q * e);
    return v < 0.f ? m : v - m;
}
#ifndef P10_TPW_DEF
#define P10_TPW_DEF 4
#endif
constexpr int P10_TPW = P10_TPW_DEF, P10_NS = 16, P10_SH = 10;
constexpr int P10_WB = 13056, P10_SIDX = 0, P10_SCF = 2048, P10_HB = 4096, P10_DESC = 12288;
#define P10_DECODE(D, T_, J_, N_) const int T_ = (D) & 3, J_ = ((D) >> 2) & 127, N_ = (D) >> 9
#define P10_ISSUE(RS, BUF, I) do { const int d_ = __builtin_amdgcn_readfirstlane(DESC[(I)]); P10_DECODE(d_, t_, j_, n_); \
        const int ev_ = SIDX[t_ * 128 + j_ + min(lane & 7, max(n_ - 1, 0))]; \
        _Pragma("unroll") for (int k = 0; k < 8; ++k) { const int e_ = __builtin_amdgcn_readlane(ev_, k); BUF[k] = __builtin_bit_cast(v4u, __builtin_amdgcn_raw_buffer_load_b128(RS, voff, e_ * 1024, 0)); } } while (0)
#define P10_COMP_U(BUF, I) do { const int d_ = __builtin_amdgcn_readfirstlane(DESC[(I)]); P10_DECODE(d_, t_, j_, n_); \
        float h[16]; { const LAS v4u* hp = (const LAS v4u*)(HB + t_ * 1024) + 2 * lane; const v4u x0_ = hp[0], x1_ = hp[1]; unpack16(x0_, x1_, h); } \
        float d[8]; _Pragma("unroll") for (int k = 0; k < 8; ++k) d[k] = dot16_fp8(BUF[k], h, 0.f); \
        const float c0 = reduce8_transposed(d, up16, up8); \
        const float act = gelu_as(c0 * (1.0f / U_SCALE)) * (1.0f / V_SCALE);       \
        if ((lane & 7) == 0 && (lane >> 3) < n_) { LAS float* cp = SCF + t_ * 128 + j_ + (lane >> 3); *cp = *cp * act; } } while (0)
#define P10_AXPY8(ACC, BUF) do { _Pragma("unroll") for (int k = 0; k < 8; ++k) { const float ck = (k < n_) ? __uint_as_float(__builtin_amdgcn_readlane(__float_as_uint(cv_), k)) : 0.f; axpy16_fp8(ACC, BUF[k], ck); } } while (0)
#define P10_COMP_V(BUF, I) do { const int d_ = __builtin_amdgcn_readfirstlane(DESC[(I)]); P10_DECODE(d_, t_, j_, n_); \
        const float cv_ = SCF[t_ * 128 + j_ + min(lane & 7, max(n_ - 1, 0))]; \
        if (t_ == 0) P10_AXPY8(acc[0], BUF); else if (t_ == 1) P10_AXPY8(acc[1], BUF); else if (t_ == 2) P10_AXPY8(acc[2], BUF); else P10_AXPY8(acc[3], BUF); } while (0)
#define P10_SB __builtin_amdgcn_sched_barrier(0)
template <int MODE> __device__ __forceinline__ void p10_experts(Frame& F, float* outp) {
    const int lane = F.lane;
    const bf16* H1B = WSP(bf16, WS_H1B); const bf16* PLE = WSP(bf16, WS_PLE); const int* IDX = WSP(int, WS_IDX); const float* GATE = WSP(float, WS_GATE);
    const auto rsU = __builtin_amdgcn_make_buffer_rsrc((void*)WSP(unsigned char, WS_UT), 0, 16384 * 1024, 0x00020000);
    const auto rsV = __builtin_amdgcn_make_buffer_rsrc((void*)WSP(unsigned char, WS_VT), 0, 16384 * 1024, 0x00020000);
    const int voff = lane * 16;
    const float* g2 = F.in[21]; const float* b2 = F.in[22];
    const bool up16 = (lane & 16) != 0, up8 = (lane & 8) != 0;
    LAS unsigned char* LW = F.lds + RING_OFF + F.wave * P10_WB;
    LAS int* SIDX = (LAS int*)(LW + P10_SIDX); LAS float* SCF = (LAS float*)(LW + P10_SCF); LAS bf16* HB = (LAS bf16*)(LW + P10_HB); LAS int* DESC = (LAS int*)(LW + P10_DESC);
    constexpr int TPB = NWAVES * P10_TPW;
    for (int blk = F.vcu; blk < M / TPB; blk += F.G) {
        const int tok0 = blk * TPB + F.wave * P10_TPW;
        int seg[P10_TPW][P10_NS + 1];
#pragma unroll
        for (int t = 0; t < P10_TPW; ++t) { const size_t tk = (size_t)(tok0 + t);
            const int i0 = IDX[tk * 128 + lane], i1 = IDX[tk * 128 + 64 + lane]; const float g0 = GATE[tk * 128 + lane], g1 = GATE[tk * 128 + 64 + lane];
            { const v4u* hp = (const v4u*)(H1B + tk * 1024) + 2 * lane; LAS v4u* hd = (LAS v4u*)(HB + t * 1024) + 2 * lane; hd[0] = hp[0]; hd[1] = hp[1]; }
            const int k0 = i0 >> P10_SH, k1 = i1 >> P10_SH; int r0 = 0, r1 = 0, base = 0;
#pragma unroll
            for (int k = 0; k < P10_NS; ++k) { const unsigned long long b0 = __ballot(k0 == k), b1 = __ballot(k1 == k);
                const int below0 = (int)__builtin_amdgcn_mbcnt_hi((unsigned)(b0 >> 32), __builtin_amdgcn_mbcnt_lo((unsigned)b0, 0u)), below1 = (int)__builtin_amdgcn_mbcnt_hi((unsigned)(b1 >> 32), __builtin_amdgcn_mbcnt_lo((unsigned)b1, 0u));
                const int n0 = __builtin_popcountll(b0), n1 = __builtin_popcountll(b1);
                r0 = (k0 == k) ? base + below0 : r0; r1 = (k1 == k) ? base + n0 + below1 : r1; seg[t][k] = base; base += n0 + n1; }
            seg[t][P10_NS] = base;
            SIDX[t * 128 + r0] = i0; SCF[t * 128 + r0] = g0; SIDX[t * 128 + r1] = i1; SCF[t * 128 + r1] = g1; }
        int nd = 0;
#pragma unroll
        for (int s = 0; s < P10_NS; ++s)
#pragma unroll
            for (int t = 0; t < P10_TPW; ++t) { for (int c = (seg[t][s] + 7) >> 3; c < (seg[t][s + 1] + 7) >> 3; ++c) { if (lane == 0) DESC[nd] = t | ((8 * c) << 2) | (8 << 9); ++nd; } }
        if (lane < 3) DESC[nd + lane] = 0;
        const int ndp = (nd + 1) & ~1;
        v4u BA[8], BB[8];
        P10_ISSUE(rsU, BA, 0); P10_SB;
#pragma unroll 1
        for (int i = 0; i < ndp; i += 2) {
            P10_ISSUE(rsU, BB, i + 1); P10_SB;
            P10_COMP_U(BA, i); P10_SB;
            P10_ISSUE(rsU, BA, i + 2); P10_SB;
            P10_COMP_U(BB, i + 1); P10_SB;
        }
        float acc[4][16];
#pragma unroll
        for (int t = 0; t < 4; ++t)
#pragma unroll
            for (int i = 0; i < 16; ++i) acc[t][i] = 0.f;
        P10_ISSUE(rsV, BA, 0); P10_SB;
#pragma unroll 1
        for (int i = 0; i < ndp; i += 2) {
            P10_ISSUE(rsV, BB, i + 1); P10_SB;
            P10_COMP_V(BA, i); P10_SB;
            P10_ISSUE(rsV, BA, i + 2); P10_SB;
            P10_COMP_V(BB, i + 1); P10_SB;
        }
#pragma unroll
        for (int t = 0; t < P10_TPW; ++t) { const int tok = tok0 + t;
            float h[16], pl[16];
            { const LAS v4u* hp = (const LAS v4u*)(HB + t * 1024) + 2 * lane; const v4u x0_ = hp[0], x1_ = hp[1]; unpack16(x0_, x1_, h); }
            { const v4u* pp = (const v4u*)(PLE + (size_t)tok * 1024) + 2 * lane; unpack16(pp[0], pp[1], pl); }
            float y[16]; float sm = 0.f;
#pragma unroll
            for (int i = 0; i < 16; ++i) { y[i] = ALPHA * h[i] + acc[t][i] + pl[i]; sm += y[i]; }
            const float mean = wave_sum(sm) * (1.f / DM); float s2 = 0.f;
#pragma unroll
            for (int i = 0; i < 16; ++i) { y[i] -= mean; s2 += y[i] * y[i]; }
            const float rstd = 1.f / sqrtf(wave_sum(s2) * (1.f / DM) + LN_EPS);
            float* op = outp + (size_t)tok * 1024 + 16 * lane; const float* gp = g2 + 16 * lane; const float* bp = b2 + 16 * lane;
#pragma unroll
            for (int q = 0; q < 4; ++q) { const f32x4 ga = *(const f32x4*)(gp + 4 * q), ba = *(const f32x4*)(bp + 4 * q); f32x4 o;
                o.x = y[4 * q] * rstd * ga.x + ba.x; o.y = y[4 * q + 1] * rstd * ga.y + ba.y; o.z = y[4 * q + 2] * rstd * ga.z + ba.z; o.w = y[4 * q + 3] * rstd * ga.w + ba.w;
                *(f32x4*)(op + 4 * q) = o; }
        }
    }
}
struct Args { const float* in[23]; float* out; unsigned char* ws; int ph_lo, ph_hi, li, pad; };
__global__ void __launch_bounds__(NWAVES * 64, 2) fwd_kernel(Args args) {
    extern __shared__ __attribute__((aligned(16))) unsigned char lds[];
    Frame F;
    F.lds = (LAS unsigned char*)lds;
    F.MISC = (volatile LAS unsigned*)(F.lds + MISC_OFF);
    F.tid = threadIdx.x; F.lane = F.tid & 63; F.wave = __builtin_amdgcn_readfirstlane(F.tid >> 6);
    F.G = gridDim.x; { const int bx = blockIdx.x; F.vcu = (F.G % 8 == 0) ? (bx % 8) * (F.G / 8) + bx / 8 : bx; }
    F.ws = args.ws; F.out = args.out; F.in = args.in;
    F.ctl = (gu32*)(F.ws + WS_CTL);
    for (int u = F.tid; u < (LDS_BYTES - LDSCTL_OFF) / 4; u += NWAVES * 64) ((LAS unsigned*)(F.lds + LDSCTL_OFF))[u] = 0u;
    __syncthreads();
    XcdBarrier bar; bar.bar = (unsigned*)(F.ctl + CW_BAR); bar.x = 0; bar.st = nullptr;
    if (N_LAUNCHES == 1) bar = xcd_barrier_post((unsigned*)(F.ctl + CW_BAR), F.MISC + 8);
#ifdef PROBE_BAR2
#define GRID_BAR() do { if (N_LAUNCHES == 1) { xcd_barrier(bar); xcd_barrier(bar); } } while (0)
#else
#define GRID_BAR() do { if (N_LAUNCHES == 1) xcd_barrier(bar); } while (0)
#endif
    const int lo = args.ph_lo, hi = args.ph_hi;
#ifndef PH_MASK
#define PH_MASK 0x7ff
#endif
#define IN(k) (((PH_MASK >> (k)) & 1) && lo <= (k) && (k) < hi)
#define BOTH(k) (IN(k) && IN((k) + 1))
#ifndef REP_MASK
#define REP_MASK 0
#endif
#define REPS(k) for (int rep_ = 0; rep_ < 1 + ((REP_MASK >> (k)) & 1); ++rep_)
    const int bx = (int)blockIdx.x;

    if (IN(0)) { p0_prologue(F);
#ifdef PROBE_P0
        __syncthreads(); p0_prologue(F);
#endif
        if (BOTH(0)) GRID_BAR(); }

    if (IN(1)) {
        REPS(1) {
        pg8::Gemm g{WSP(bf16, WS_XN), WSP(bf16, WS_WIN_T), M, NPROJ, DM}; pg8::StaticOrder S; S.init(M, NPROJ, F.G, bx);
        pg8::EpiBf16<0> E{WSP(bf16, WS_PROJ), 512, nullptr, 512, SLAB, C2};
        pg8::gemm_phase<pg8::EpiBf16<0>, pg8::StaticOrder, PG8_ALIGN, PG8_SP2>(F.lds + RING_OFF, g, S, E); }
        if (BOTH(1)) GRID_BAR();
    }

    if (IN(2)) {
#define P2_ATTN() do { if (F.G == 256) { const int bh = F.vcu >> 3, s = F.vcu & 7; \
            for (int i = 0; i < 4; ++i) { const int qb = (i == 0) ? s : (i == 1) ? 15 - s : (i == 2) ? 16 + s : 31 - s; attn_unit(F, bh, qb); } } \
        else { for (int u = F.vcu; u < 1024; u += F.G) attn_unit(F, u >> 5, u & 31); } } while (0)
#define P2_MLA() do { for (int u = F.vcu; u < N_MLU; u += F.G) mla_unit(F, u); } while (0)
        P2_ATTN();
#ifdef PROBE_P2A
        P2_ATTN();
#endif
        P2_MLA();
#ifdef PROBE_P2B
        P2_MLA();
#endif
        if (BOTH(2)) GRID_BAR();
    }

    if (IN(3)) { for (int it = F.vcu; it < 256; it += F.G) ml_scan_item(F, it);
#ifdef PROBE_P3
        for (int it = F.vcu; it < 256; it += F.G) ml_scan_item(F, it, WS_Y);
#endif
        if (BOTH(3)) GRID_BAR(); }

    if (IN(4)) { REPS(4) for (int u = F.vcu; u < N_MLU; u += F.G) mlc_unit(F, u); if (BOTH(4)) GRID_BAR(); }

    if (IN(5)) {
        pg8::Gemm g{WSP(bf16, WS_OCAT), WSP(bf16, WS_WSB_T), M, DM, DM}; pg8::StaticOrder S; S.init(M, DM, F.G, bx);
        pg8::EpiGate2 E{WSP(bf16, WS_Y), WSP(bf16, WS_PROJ) + 7 * SLAB, WSP(bf16, WS_PROJ) + 9 * SLAB};
        pg8::gemm_phase<pg8::EpiGate2, pg8::StaticOrder, PG8_ALIGN, PG8_SP2>(F.lds + RING_OFF, g, S, E);
        if (BOTH(5)) GRID_BAR();
    }

    if (IN(6)) {
#define P6_OUTPROJ() do { pg8::Gemm g{WSP(bf16, WS_Y), WSP(bf16, WS_WOUT_T), M, DM, DM}; pg8::StaticOrder S; S.init(M, DM, F.G, bx); \
          pg8::EpiBf16<0> E{WSP(bf16, WS_PRE1), DM, nullptr, 0, 0, 1.f}; \
          pg8::gemm_phase<pg8::EpiBf16<0>, pg8::StaticOrder, PG8_ALIGN, PG8_SP2>(F.lds + RING_OFF, g, S, E); } while (0)
#define P6_PLE() do { pg8::Gemm g{WSP(bf16, WS_PB), WSP(bf16, WS_WPLE_T), M, DM, 256}; pg8::StaticOrder S; S.init(M, DM, F.G, bx); \
          pg8::EpiBf16<0> E{WSP(bf16, WS_PLE), DM, nullptr, 0, 0, 1.f}; \
          pg8::gemm_phase<pg8::EpiBf16<0>, pg8::StaticOrder, PG8_ALIGN, PG8_SP2>(F.lds + RING_OFF, g, S, E); } while (0)
        P6_OUTPROJ(); P6_PLE();
#ifdef PROBE_P6A
        P6_OUTPROJ();
#endif
#ifdef PROBE_P6B
        P6_PLE();
#endif
        if (BOTH(6)) GRID_BAR();
    }

    if (IN(7)) { REPS(7) p7_ln1_tables(F); if (BOTH(7)) GRID_BAR(); }

    if (IN(8)) {
        pg8::Gemm g{WSP(bf16, WS_H1B), WSP(bf16, WS_WQG_T), M, 3072, DM}; pg8::StaticOrder S; S.init(M, 3072, F.G, bx);
        pg8::EpiQG E{WSP(bf16, WS_Q), WSP(bf16, WS_PLE)};
        pg8::gemm_phase<pg8::EpiQG, pg8::StaticOrder, PG8_ALIGN, PG8_SP2>(F.lds + RING_OFF, g, S, E);
        if (BOTH(8)) GRID_BAR();
    }

    if (IN(9)) { REPS(9) p9_route(F); if (BOTH(9)) GRID_BAR(); }

    if (IN(10)) { p10_experts<0>(F, F.out);
#ifdef PROBE_P10
        p10_experts<PROBE_P10>(F, WSP(float, WS_PRE1));
#endif
    }
#undef IN
#undef BOTH
#undef GRID_BAR
}

extern "C" void kernel_launch(void* const* d_in, const int* in_sizes, int n_in, void* d_out, int out_size, void* d_ws, size_t ws_size, hipStream_t stream) {
    static int grid = 0;
    if (grid == 0) {
        if (n_in != 23 || in_sizes[0] != M * DM || out_size != M * DM || ws_size < WS_END) {
            fprintf(stderr, "kernel_launch: built for 23 inputs, x/out of %d floats, >= %zu bytes of workspace; got n_in %d, in0 %d, out %d, ws %zu; nothing launched\n", M * DM, (size_t)WS_END, n_in, n_in > 0 ? in_sizes[0] : -1, out_size, ws_size);
            grid = -1; return; }
        int dev = 0, cus = 0;
        if (hipGetDevice(&dev) != hipSuccess || hipDeviceGetAttribute(&cus, hipDeviceAttributeMultiprocessorCount, dev) != hipSuccess) { fprintf(stderr, "kernel_launch: device query failed\n"); grid = -1; return; }
        if (hipFuncSetAttribute((const void*)fwd_kernel, hipFuncAttributeMaxDynamicSharedMemorySize, LDS_BYTES) != hipSuccess) { fprintf(stderr, "kernel_launch: hipFuncSetAttribute failed\n"); grid = -1; return; }
        int per_cu = 0;
        if (hipOccupancyMaxActiveBlocksPerMultiprocessor(&per_cu, (const void*)fwd_kernel, NWAVES * 64, LDS_BYTES) != hipSuccess || per_cu < 1)
            fprintf(stderr, "kernel_launch: note: occupancy query reports %d workgroups per CU\n", per_cu);
        (void)hipGetLastError();
        grid = cus;
    }
    if (grid < 0) return;
    if (hipMemsetAsync((char*)d_ws + WS_CTL, 0, CTL_ZERO_BYTES, stream) != hipSuccess) { fprintf(stderr, "kernel_launch: hipMemsetAsync failed\n"); return; }
    Args a{};
    for (int i = 0; i < 23; ++i) a.in[i] = (const float*)d_in[i];
    a.out = (float*)d_out; a.ws = (unsigned char*)d_ws;
    for (int li = 0; li < N_LAUNCHES; ++li) {
        if (N_LAUNCHES == 1) { a.ph_lo = 0; a.ph_hi = N_PHASES; } else { a.ph_lo = li; a.ph_hi = li + 1; }
        a.li = li;
        hipLaunchKernelGGL(fwd_kernel, dim3(grid), dim3(NWAVES * 64), LDS_BYTES, stream, a);
        const hipError_t le = hipPeekAtLastError();
        if (le != hipSuccess) { fprintf(stderr, "kernel_launch: launch %d failed: %s\n", li, hipGetErrorName(le)); break; }
    }
}
```

```cpp
#include <hip/hip_runtime.h>
#include <cstdio>
#include <cstdint>
#include <cmath>
namespace pg8 {
#define PG8_LAS __attribute__((address_space(3)))
typedef unsigned short bf16_t;
typedef short bf16x8 __attribute__((ext_vector_type(8)));
typedef float f32x4 __attribute__((ext_vector_type(4)));
typedef unsigned u32x4 __attribute__((ext_vector_type(4)));
constexpr int BM = 256, BK = 64, HALF = 128, HTB = HALF * BK * 2  , STAGE_BYTES = 8 * HTB, NXCD = 8, WGM = 8;

__host__ __device__ __forceinline__ int lds_byte(int r, int c) { const int st = (r >> 4) * 2 + (c >> 5), rr = r & 15, cc = c & 31, ob = rr * 64 + cc * 2; return st * 1024 + (ob ^ (((ob >> 9) & 1) << 5)); }
__host__ __device__ __forceinline__ void stage_rc(int b, int& R, int& C) { const int st = b / 1024, sb = b % 1024, swz = sb ^ (((sb >> 9) & 1) << 5); R = (st >> 1) * 16 + swz / 64; C = (st & 1) * 32 + (swz % 64) / 2; }
__host__ __device__ __forceinline__ int perm32(int rho) { const int n = rho >> 4, i = rho & 15; return 8 * (i >> 2) + 4 * n + (i & 3); }

struct Unit { int pm, pn; };
struct Gemm { const bf16_t* A; const bf16_t* Bt; int M, N, K; };

struct StaticOrder {
    int nM, nN, nwg, G, c;
    __host__ __device__ void init(int M, int N, int G_, int c_) { nM = M / BM; nN = N / BM; nwg = nM * nN; G = G_; c = c_; }
    __host__ __device__ bool next(int i, Unit& u) const {
        const long L = (long)i * G + c; if (L >= nwg) return false;
        int wgid = (int)L; { const int q = nwg / NXCD, r = nwg % NXCD, xcd = wgid % NXCD, off = wgid / NXCD; wgid = (xcd < r ? xcd * (q + 1) : r * (q + 1) + (xcd - r) * q) + off; }
        const int nig = WGM * nN, gid = wgid / nig, fm = gid * WGM, gsz = (nM - fm) < WGM ? (nM - fm) : WGM;
        u.pm = fm + ((wgid % nig) % gsz); u.pn = (wgid % nig) / gsz; return true;
    }
    __device__ __forceinline__ void a_ready(const Unit&) const {}
    __device__ __forceinline__ void done(const Unit&) const {}
};

__device__ __forceinline__ unsigned cvt_pk_bf16(float lo, float hi) { unsigned r; asm volatile("v_cvt_pk_bf16_f32 %0, %1, %2" : "=v"(r) : "v"(lo), "v"(hi)); return r; }
typedef float f32x2 __attribute__((ext_vector_type(2)));
__device__ __forceinline__ f32x2 gelu_pk(f32x2 v) {
    const f32x2 av = __builtin_elementwise_abs(v), d = av * 0.2316418882f + 1.0f;
    f32x2 t; t.x = __builtin_amdgcn_rcpf(d.x); t.y = __builtin_amdgcn_rcpf(d.y);
    f32x2 q = t * 0.5307027145f + (-0.7265760135f); q = q * t + 0.7107068705f; q = q * t + (-0.142248368f); q = q * t + 0.127414796f; q = q * t;
    const f32x2 s = (v * v) * (-0.72134752044f);
    f32x2 e; e.x = __builtin_amdgcn_exp2f(s.x); e.y = __builtin_amdgcn_exp2f(s.y);
    const f32x2 m = v * (q * e), r = v - m;
    f32x2 o; o.x = v.x < 0.f ? m.x : r.x; o.y = v.y < 0.f ? m.y : r.y; return o;
}

template <int ACT  > struct EpiBf16 {
    static constexpr bool PERM = true, AFTER_DRAIN = false; static constexpr int MID_T = -1; static_assert(ACT == 0 || ACT == 1 || ACT == 7, "EpiBf16: ACT is 0 (none) or 1 (gelu_pk); 7 = timing probe without stores");
    bf16_t* O; int ldc; const float* bias; int split_cols; size_t split_stride; float scale0;
    __device__ __forceinline__ void operator()(const f32x4 (&acc)[2][2][4][2], const Unit& u, int wr, int wc, int fr, int fq) const {
        const int row0 = u.pm * BM + wr * 64 + fr; int colt = u.pn * BM; bf16_t* base = O;
        float sc = 1.f; if (split_cols) { const int t = colt / split_cols; base += (size_t)t * split_stride; colt -= t * split_cols; if (t == 0) sc = scale0; }
        const int col0 = colt + wc * 32 + 8 * fq, bcol0 = u.pn * BM + wc * 32 + 8 * fq;
        f32x4 bv[2][2];
#pragma unroll
        for (int bj = 0; bj < 2; ++bj)
#pragma unroll
            for (int n = 0; n < 2; ++n) bv[bj][n] = bias ? *(const f32x4*)(bias + bcol0 + bj * HALF + 4 * n) : (f32x4){0.f, 0.f, 0.f, 0.f};
#pragma unroll
        for (int ai = 0; ai < 2; ++ai)
#pragma unroll
            for (int m = 0; m < 4; ++m) { bf16_t* rowp = base + (size_t)(row0 + ai * HALF + m * 16) * ldc + col0;
#pragma unroll
                for (int bj = 0; bj < 2; ++bj) { f32x4 v0 = acc[ai][bj][m][0] + bv[bj][0], v1 = acc[ai][bj][m][1] + bv[bj][1];
                    if (ACT == 1) { f32x2 a = gelu_pk((f32x2){v0[0], v0[1]}), b = gelu_pk((f32x2){v0[2], v0[3]}), c = gelu_pk((f32x2){v1[0], v1[1]}), d = gelu_pk((f32x2){v1[2], v1[3]});
                        v0 = (f32x4){a.x, a.y, b.x, b.y}; v1 = (f32x4){c.x, c.y, d.x, d.y}; }
                    v0 = v0 * sc; v1 = v1 * sc; u32x4 w; w.x = cvt_pk_bf16(v0[0], v0[1]); w.y = cvt_pk_bf16(v0[2], v0[3]); w.z = cvt_pk_bf16(v1[0], v1[1]); w.w = cvt_pk_bf16(v1[2], v1[3]);
                    if (ACT != 7 || u.pm < 0) *(u32x4*)(rowp + bj * HALF) = w; } }
    }
};

struct PanelStats {
    unsigned* xbuf;
    unsigned* cnt;
    unsigned* tmo;
    int ntn; float eps;
    unsigned code;
    __device__ __forceinline__ bool run(const f32x4 (&v)[2][2][4][2], const Unit& u, int wr, int wc, int fr, int fq, PG8_LAS unsigned char* lds, int wid, int lane) const {
        typedef float f32x2v __attribute__((ext_vector_type(2)));
        PG8_LAS f32x2v* P = (PG8_LAS f32x2v*)lds;
        PG8_LAS f32x2v* S = (PG8_LAS f32x2v*)(lds + 8192);
        PG8_LAS unsigned* flag = (PG8_LAS unsigned*)(lds + 8192 + 2048);
#pragma unroll
        for (int ai = 0; ai < 2; ++ai)
#pragma unroll
            for (int m = 0; m < 4; ++m) {
                float s = 0.f;
#pragma unroll
                for (int bj = 0; bj < 2; ++bj)
#pragma unroll
                    for (int n = 0; n < 2; ++n) { const f32x4 x = v[ai][bj][m][n]; s += (x[0] + x[1]) + (x[2] + x[3]); }
                s += __shfl_xor(s, 16); s += __shfl_xor(s, 32);
                const float mw = s * (1.0f / 64.0f); float q = 0.f;
#pragma unroll
                for (int bj = 0; bj < 2; ++bj)
#pragma unroll
                    for (int n = 0; n < 2; ++n) { const f32x4 d = v[ai][bj][m][n] - mw; q += (d[0] * d[0] + d[1] * d[1]) + (d[2] * d[2] + d[3] * d[3]); }
                q += __shfl_xor(q, 16); q += __shfl_xor(q, 32);
                if (fq == 0) P[(ai * HALF + wr * 64 + m * 16 + fr) * 4 + wc] = (f32x2v){mw, q};
            }
        asm volatile("s_waitcnt lgkmcnt(0)" ::: "memory"); __builtin_amdgcn_s_barrier(); asm volatile("" ::: "memory");
#if defined(BROKEN_EXCHANGE_NO_WAIT)
#warning BROKEN CONTROL BUILD: the row-statistics exchange does not wait; results are wrong by design
        if (blockIdx.x >= 64) { const long long t0_ = clock64(); while (clock64() - t0_ < 60000) __builtin_amdgcn_s_sleep(8); }
#endif
        const int row = wid * 32 + (lane & 31);
        if (lane < 32) {
            const f32x2v a = P[row * 4 + 0], b = P[row * 4 + 1], c = P[row * 4 + 2], d = P[row * 4 + 3];
            const float mt = (a.x + b.x + c.x + d.x) * 0.25f;
            const float da = a.x - mt, db = b.x - mt, dc = c.x - mt, dd = d.x - mt;
            const float m2 = (a.y + b.y) + (c.y + d.y) + 64.0f * ((da * da + db * db) + (dc * dc + dd * dd));
            unsigned long long* slot = (unsigned long long*)xbuf + ((size_t)(u.pm * BM + row) * 4 + u.pn);
            __hip_atomic_store(slot, ((unsigned long long)__float_as_uint(m2) << 32) | __float_as_uint(mt), __ATOMIC_RELAXED, __HIP_MEMORY_SCOPE_AGENT);
        }
        asm volatile("s_waitcnt vmcnt(0)" ::: "memory");
        if (lane == 0) __hip_atomic_fetch_add(cnt + 64 * u.pm, 1u, __ATOMIC_RELAXED, __HIP_MEMORY_SCOPE_AGENT);
        if (wid == 0) {
            bool dead = false; const unsigned long long t0 = __builtin_amdgcn_s_memrealtime(); const unsigned want = 8u * (unsigned)ntn;
            for (;;) {
#if defined(BROKEN_EXCHANGE_NO_WAIT)
                break;
#endif
                if ((unsigned)__builtin_amdgcn_readfirstlane(__hip_atomic_load(cnt + 64 * u.pm, __ATOMIC_RELAXED, __HIP_MEMORY_SCOPE_AGENT)) >= want) break;
                if (__builtin_amdgcn_s_memrealtime() - t0 > 2000000ull) {
                    if (lane == 0) { unsigned expect = 0u; __hip_atomic_compare_exchange_strong(tmo + 1, &expect, code | (unsigned)(u.pm & 0xff), __ATOMIC_RELAXED, __ATOMIC_RELAXED, __HIP_MEMORY_SCOPE_AGENT);
                                     __hip_atomic_store(tmo, 1u, __ATOMIC_RELAXED, __HIP_MEMORY_SCOPE_AGENT); }
                    dead = true; break; }
                __builtin_amdgcn_s_sleep(2);
            }
            __builtin_amdgcn_fence(__ATOMIC_ACQUIRE, "agent");
            if (lane == 0) flag[0] = dead ? 1u : 0u;
        }
        asm volatile("s_waitcnt vmcnt(0) lgkmcnt(0)" ::: "memory"); __builtin_amdgcn_s_barrier(); asm volatile("" ::: "memory");
        const bool bad = flag[0] != 0u;
        if (lane < 32) {
            const unsigned long long* slot = (const unsigned long long*)xbuf + (size_t)(u.pm * BM + row) * 4; float mt[4], m2[4]; float ms = 0.f;
#pragma unroll
            for (int t = 0; t < 4; ++t) { if (t < ntn) { const unsigned long long w = __hip_atomic_load(slot + t, __ATOMIC_RELAXED, __HIP_MEMORY_SCOPE_AGENT); mt[t] = __uint_as_float((unsigned)w); m2[t] = __uint_as_float((unsigned)(w >> 32)); } else { mt[t] = 0.f; m2[t] = 0.f; } ms += mt[t]; }
            const float mean = ms / (float)ntn; float q = 0.f;
#pragma unroll
            for (int t = 0; t < 4; ++t) if (t < ntn) { const float dm = mt[t] - mean; q += m2[t] + 256.0f * dm * dm; }
            S[row] = (f32x2v){mean, 1.0f / sqrtf(q / (256.0f * (float)ntn) + eps)};
        }
        asm volatile("s_waitcnt lgkmcnt(0)" ::: "memory"); __builtin_amdgcn_s_barrier(); asm volatile("" ::: "memory");
        return bad;
    }
};
struct EpiLnRes {
    static constexpr bool PERM = false, AFTER_DRAIN = true; static constexpr int MID_T = -1;
    const float* base; float* out; int ldc; const float* bias; PanelStats st; unsigned poison;
    __device__ __forceinline__ void fused(f32x4 (&acc)[2][2][4][2], const Unit& u, int wr, int wc, int fr, int fq, PG8_LAS unsigned char* lds, int wid, int lane) const {
        typedef float f32x2v __attribute__((ext_vector_type(2)));
        const PG8_LAS f32x2v* S = (const PG8_LAS f32x2v*)(lds + 8192);
        const int col0 = u.pn * BM + wc * 32 + 4 * fq;
#pragma unroll
        for (int bj = 0; bj < 2; ++bj)
#pragma unroll
            for (int n = 0; n < 2; ++n) { const f32x4 bv = bias ? *(const f32x4*)(bias + col0 + bj * HALF + n * 16) : (f32x4){0.f, 0.f, 0.f, 0.f};
#pragma unroll
                for (int ai = 0; ai < 2; ++ai)
#pragma unroll
                    for (int m = 0; m < 4; ++m) acc[ai][bj][m][n] += bv; }
        f32x4 pre[4][2][2];
#pragma unroll
        for (int m = 0; m < 4; ++m) { const size_t off = (size_t)(u.pm * BM + wr * 64 + m * 16 + fr) * ldc + col0;
#pragma unroll
            for (int bj = 0; bj < 2; ++bj)
#pragma unroll
                for (int n = 0; n < 2; ++n) pre[m][bj][n] = *(const f32x4*)(base + off + bj * HALF + n * 16); }
        const bool bad = st.run(acc, u, wr, wc, fr, fq, lds, wid, lane) || poison != 0u;
        const float qnan = __builtin_nanf("");
#pragma unroll
        for (int ai = 0; ai < 2; ++ai)
#pragma unroll
            for (int m = 0; m < 4; ++m) { const int r = ai * HALF + wr * 64 + m * 16 + fr; const f32x2v sr = S[r]; const size_t off = (size_t)(u.pm * BM + r) * ldc + col0;
#pragma unroll
                for (int bj = 0; bj < 2; ++bj)
#pragma unroll
                    for (int n = 0; n < 2; ++n) { const f32x4 bs = ai == 0 ? pre[m][bj][n] : *(const f32x4*)(base + off + bj * HALF + n * 16); f32x4 o = bs + (acc[ai][bj][m][n] - sr.x) * sr.y;
                        if (bad) o = (f32x4){qnan, qnan, qnan, qnan}; *(f32x4*)(out + off + bj * HALF + n * 16) = o; }
                if (m & 1) asm volatile("" ::: "memory"); }
    }
};
struct EpiLnResLn {
    static constexpr bool PERM = false, AFTER_DRAIN = true; static constexpr int MID_T = -1;
    const float* base; float* out; bf16_t* xn; int ldc; const float* bias; PanelStats st1, st2; unsigned poison;
    __device__ __forceinline__ void fused(f32x4 (&acc)[2][2][4][2], const Unit& u, int wr, int wc, int fr, int fq, PG8_LAS unsigned char* lds, int wid, int lane) const {
        typedef float f32x2v __attribute__((ext_vector_type(2))); typedef unsigned u32x2v __attribute__((ext_vector_type(2)));
        const PG8_LAS f32x2v* S = (const PG8_LAS f32x2v*)(lds + 8192);
        const int col0 = u.pn * BM + wc * 32 + 4 * fq;
#pragma unroll
        for (int bj = 0; bj < 2; ++bj)
#pragma unroll
            for (int n = 0; n < 2; ++n) { const f32x4 bv = bias ? *(const f32x4*)(bias + col0 + bj * HALF + n * 16) : (f32x4){0.f, 0.f, 0.f, 0.f};
#pragma unroll
                for (int ai = 0; ai < 2; ++ai)
#pragma unroll
                    for (int m = 0; m < 4; ++m) acc[ai][bj][m][n] += bv; }
        bool bad = st1.run(acc, u, wr, wc, fr, fq, lds, wid, lane) || poison != 0u;
        const float qnan = __builtin_nanf("");
#pragma unroll
        for (int ai = 0; ai < 2; ++ai)
#pragma unroll
            for (int m = 0; m < 4; ++m) { const int r = ai * HALF + wr * 64 + m * 16 + fr; const f32x2v sr = S[r]; const size_t off = (size_t)(u.pm * BM + r) * ldc + col0;
#pragma unroll
                for (int bj = 0; bj < 2; ++bj)
#pragma unroll
                    for (int n = 0; n < 2; ++n) { const f32x4 bs = *(const f32x4*)(base + off + bj * HALF + n * 16); acc[ai][bj][m][n] = bs + (acc[ai][bj][m][n] - sr.x) * sr.y; }
                asm volatile("" : "+v"(acc[ai][0][m][0]), "+v"(acc[ai][0][m][1]), "+v"(acc[ai][1][m][0]), "+v"(acc[ai][1][m][1]));
                if (m & 1) asm volatile("" ::: "memory"); }
        const bool bad1 = bad;
        bad = st2.run(acc, u, wr, wc, fr, fq, lds, wid, lane) || bad;
#pragma unroll
        for (int ai = 0; ai < 2; ++ai)
#pragma unroll
            for (int m = 0; m < 4; ++m) { const int r = ai * HALF + wr * 64 + m * 16 + fr; const f32x2v sr = S[r]; const size_t off = (size_t)(u.pm * BM + r) * ldc + col0;
#pragma unroll
                for (int bj = 0; bj < 2; ++bj)
#pragma unroll
                    for (int n = 0; n < 2; ++n) { const f32x4 x1 = acc[ai][bj][m][n]; *(f32x4*)(out + off + bj * HALF + n * 16) = bad1 ? (f32x4){qnan, qnan, qnan, qnan} : x1;
                        const f32x4 o = (x1 - sr.x) * sr.y; u32x2v w; w.x = cvt_pk_bf16(o[0], o[1]); w.y = cvt_pk_bf16(o[2], o[3]);
                        if (bad) { w.x = 0x7fc07fc0u; w.y = 0x7fc07fc0u; } *(u32x2v*)(xn + off + bj * HALF + n * 16) = w; }
                asm volatile("" ::: "memory"); }
    }
};

template <class Epi, class Sched, bool ALIGN_EPI = false, bool SP2 = false>
__device__ __forceinline__ void gemm_phase(PG8_LAS unsigned char* lds, const Gemm g, const Sched& S, const Epi& E) {
    const int tid = threadIdx.x, wid = __builtin_amdgcn_readfirstlane(tid >> 6), lane = tid & 63, wr = wid >> 2, wc = wid & 3, fr = lane & 15, fq = lane >> 4;
    const int K = g.K, nt = K / BK;
    unsigned voffA[2], voffB[2];
#pragma unroll
    for (int i = 0; i < 2; ++i) { int R, C; stage_rc(tid * 16 + i * 8192, R, C); const int Rb = Epi::PERM ? ((R & ~31) + perm32(R & 31)) : R;
        voffA[i] = (unsigned)(R * K + C) * 2u; voffB[i] = (unsigned)(Rb * K + C) * 2u; }
    const size_t kstep = (size_t)(BK * 2);
    const size_t hstep = (size_t)HALF * K * 2;
    const size_t tstep = 2 * hstep;
    const unsigned ldsw = (unsigned)wid * 1024u;
    const int aoff = lds_byte(wr * 64 + fr, fq * 8), boff = lds_byte(wc * 32 + fr, fq * 8);
#define PG8_SA(b, h) (((b) * 2 + (h)) * HTB)
#define PG8_SB(b, h) ((4 + (b) * 2 + (h)) * HTB)
#define PG8_STAGE(bufoff, gbase, voff) do { _Pragma("unroll") for (int _i = 0; _i < 2; ++_i) \
        __builtin_amdgcn_global_load_lds((const unsigned*)((const char*)(gbase) + (voff)[_i]), (PG8_LAS unsigned*)(lds + (bufoff) + ldsw + _i * 8192), 16, 0, 0); } while (0)
#define PG8_LDA(dst, b, h) do { _Pragma("unroll") for (int m = 0; m < 4; ++m) _Pragma("unroll") for (int k = 0; k < 2; ++k) dst[m][k] = *(const PG8_LAS bf16x8*)(lds + PG8_SA(b, h) + aoff + m * 2048 + k * 1024); } while (0)
#define PG8_LDB(dst, b, h) do { _Pragma("unroll") for (int n = 0; n < 2; ++n) _Pragma("unroll") for (int k = 0; k < 2; ++k) dst[n][k] = *(const PG8_LAS bf16x8*)(lds + PG8_SB(b, h) + boff + n * 2048 + k * 1024); } while (0)
#define PG8_MMA(ai, bj, At, Bt) do { __builtin_amdgcn_s_setprio(1); _Pragma("unroll") for (int m = 0; m < 4; ++m) _Pragma("unroll") for (int n = 0; n < 2; ++n) _Pragma("unroll") for (int k = 0; k < 2; ++k) \
        acc[ai][bj][m][n] = __builtin_amdgcn_mfma_f32_16x16x32_bf16(Bt[n][k], At[m][k], acc[ai][bj][m][n], 0, 0, 0); __builtin_amdgcn_s_setprio(0); } while (0)
#define PG8_WAIT_V(n) asm volatile("s_waitcnt vmcnt(" #n ")" ::: "memory")
#define PG8_WAIT_L(n) asm volatile("s_waitcnt lgkmcnt(" #n ")" ::: "memory")
#define PG8_BAR __builtin_amdgcn_s_barrier()
#define PG8_SCHED __builtin_amdgcn_sched_barrier(0)
    Unit cur, nxt; int ui = 0;
    if (!S.next(0, cur)) return;
    f32x4 acc[2][2][4][2];
#pragma unroll
    for (int a = 0; a < 2; ++a)
#pragma unroll
        for (int b = 0; b < 2; ++b)
#pragma unroll
            for (int m = 0; m < 4; ++m)
#pragma unroll
                for (int n = 0; n < 2; ++n) acc[a][b][m][n] = (f32x4){0.f, 0.f, 0.f, 0.f};
    bf16x8 At[4][2], B0[2][2], B1[2][2];
    const char* cA = (const char*)g.A + (size_t)cur.pm * tstep; const char* cB = (const char*)g.Bt + (size_t)cur.pn * tstep;
    S.a_ready(cur);
    if constexpr (SP2) {
        PG8_STAGE(PG8_SB(0, 0), cB, voffB); PG8_STAGE(PG8_SB(0, 1), cB + hstep, voffB); PG8_STAGE(PG8_SA(0, 0), cA, voffA); PG8_STAGE(PG8_SA(0, 1), cA + hstep, voffA);
        if (wr == 1) PG8_BAR;
        PG8_WAIT_V(2); PG8_BAR;
        PG8_STAGE(PG8_SB(1, 0), cB + kstep, voffB); PG8_STAGE(PG8_SA(1, 0), cA + kstep, voffA); PG8_STAGE(PG8_SB(1, 1), cB + hstep + kstep, voffB);
        PG8_WAIT_V(6); PG8_BAR;
    } else {
        PG8_STAGE(PG8_SB(0, 0), cB, voffB); PG8_STAGE(PG8_SA(0, 0), cA, voffA); PG8_STAGE(PG8_SB(0, 1), cB + hstep, voffB); PG8_STAGE(PG8_SA(0, 1), cA + hstep, voffA);
        if (wr == 1) PG8_BAR;
        PG8_WAIT_V(4); PG8_BAR;
        PG8_STAGE(PG8_SB(1, 0), cB + kstep, voffB); PG8_STAGE(PG8_SA(1, 0), cA + kstep, voffA); PG8_STAGE(PG8_SB(1, 1), cB + hstep + kstep, voffB);
        PG8_WAIT_V(6); PG8_BAR;
    }
    for (;;) {
        const bool has_next = S.next(ui + 1, nxt);
        const char* nA = has_next ? (const char*)g.A + (size_t)nxt.pm * tstep : cA; const char* nB = has_next ? (const char*)g.Bt + (size_t)nxt.pn * tstep : cB;
        if constexpr (Epi::MID_T >= 0) {
        for (int t = 0; t < Epi::MID_T; t += 2) {
            const bool last = (t == nt - 2);
            const char* a1 = cA + (size_t)(t + 1) * kstep;
            const char* a2 = last ? nA : cA + (size_t)(t + 2) * kstep; const char* b2 = last ? nB : cB + (size_t)(t + 2) * kstep;
            const char* a3 = a2 + kstep; const char* b3 = b2 + kstep;
            if (last && has_next) S.a_ready(nxt);
            if constexpr (SP2) {
            PG8_LDB(B0, 0, 0); PG8_LDB(B1, 0, 1); PG8_SCHED; PG8_LDA(At, 0, 0); PG8_STAGE(PG8_SA(1, 1), a1 + hstep, voffA);
            PG8_WAIT_V(8); PG8_WAIT_L(0); PG8_BAR; PG8_MMA(0, 0, At, B0); PG8_MMA(0, 1, At, B1); PG8_BAR; PG8_SCHED;
            PG8_LDA(At, 0, 1); PG8_STAGE(PG8_SB(0, 0), b2, voffB); PG8_STAGE(PG8_SB(0, 1), b2 + hstep, voffB); PG8_STAGE(PG8_SA(0, 0), a2, voffA);
            PG8_WAIT_V(8); PG8_WAIT_L(0); PG8_BAR; PG8_MMA(1, 0, At, B0); PG8_MMA(1, 1, At, B1); PG8_BAR; PG8_SCHED;
            PG8_LDB(B0, 1, 0); PG8_LDB(B1, 1, 1); PG8_SCHED; PG8_LDA(At, 1, 0); PG8_STAGE(PG8_SA(0, 1), a2 + hstep, voffA);
            PG8_WAIT_V(8); PG8_WAIT_L(0); PG8_BAR; PG8_MMA(0, 0, At, B0); PG8_MMA(0, 1, At, B1); PG8_BAR; PG8_SCHED;
            PG8_LDA(At, 1, 1); PG8_STAGE(PG8_SB(1, 0), b3, voffB); PG8_STAGE(PG8_SB(1, 1), b3 + hstep, voffB); PG8_STAGE(PG8_SA(1, 0), a3, voffA);
            PG8_WAIT_V(8); PG8_WAIT_L(0); PG8_BAR; PG8_MMA(1, 0, At, B0); PG8_MMA(1, 1, At, B1); PG8_BAR; PG8_SCHED;
            } else {
            PG8_LDB(B0, 0, 0); PG8_SCHED; PG8_LDA(At, 0, 0); PG8_STAGE(PG8_SA(1, 1), a1 + hstep, voffA);
            PG8_WAIT_L(8); PG8_BAR; PG8_WAIT_L(0); PG8_MMA(0, 0, At, B0); PG8_BAR; PG8_SCHED;
            PG8_LDB(B1, 0, 1); PG8_STAGE(PG8_SB(0, 0), b2, voffB);
            PG8_BAR; PG8_WAIT_L(0); PG8_MMA(0, 1, At, B1); PG8_BAR;
            PG8_LDA(At, 0, 1); PG8_STAGE(PG8_SA(0, 0), a2, voffA);
            PG8_BAR; PG8_WAIT_L(0); PG8_MMA(1, 0, At, B0); PG8_BAR; PG8_SCHED;
            PG8_STAGE(PG8_SB(0, 1), b2 + hstep, voffB);
            PG8_WAIT_V(6); PG8_BAR; PG8_MMA(1, 1, At, B1); PG8_BAR;
            PG8_LDB(B0, 1, 0); PG8_SCHED; PG8_LDA(At, 1, 0); PG8_STAGE(PG8_SA(0, 1), a2 + hstep, voffA);
            PG8_WAIT_L(8); PG8_BAR; PG8_WAIT_L(0); PG8_MMA(0, 0, At, B0); PG8_BAR; PG8_SCHED;
            PG8_LDB(B1, 1, 1); PG8_STAGE(PG8_SB(1, 0), b3, voffB);
            PG8_BAR; PG8_WAIT_L(0); PG8_MMA(0, 1, At, B1); PG8_BAR;
            PG8_LDA(At, 1, 1); PG8_STAGE(PG8_SA(1, 0), a3, voffA);
            PG8_BAR; PG8_WAIT_L(0); PG8_MMA(1, 0, At, B0); PG8_BAR; PG8_SCHED;
            PG8_STAGE(PG8_SB(1, 1), b3 + hstep, voffB);
            PG8_WAIT_V(6); PG8_BAR; PG8_MMA(1, 1, At, B1); PG8_BAR;
            }
        }
        E.mid(acc, cur, wr, wc, fr, fq);
        for (int t = Epi::MID_T; t < nt; t += 2) {
            const bool last = (t == nt - 2);
            const char* a1 = cA + (size_t)(t + 1) * kstep;
            const char* a2 = last ? nA : cA + (size_t)(t + 2) * kstep; const char* b2 = last ? nB : cB + (size_t)(t + 2) * kstep;
            const char* a3 = a2 + kstep; const char* b3 = b2 + kstep;
            if (last && has_next) S.a_ready(nxt);
            if constexpr (SP2) {
            PG8_LDB(B0, 0, 0); PG8_LDB(B1, 0, 1); PG8_SCHED; PG8_LDA(At, 0, 0); PG8_STAGE(PG8_SA(1, 1), a1 + hstep, voffA);
            PG8_WAIT_V(8); PG8_WAIT_L(0); PG8_BAR; PG8_MMA(0, 0, At, B0); PG8_MMA(0, 1, At, B1); PG8_BAR; PG8_SCHED;
            PG8_LDA(At, 0, 1); PG8_STAGE(PG8_SB(0, 0), b2, voffB); PG8_STAGE(PG8_SB(0, 1), b2 + hstep, voffB); PG8_STAGE(PG8_SA(0, 0), a2, voffA);
            PG8_WAIT_V(8); PG8_WAIT_L(0); PG8_BAR; PG8_MMA(1, 0, At, B0); PG8_MMA(1, 1, At, B1); PG8_BAR; PG8_SCHED;
            PG8_LDB(B0, 1, 0); PG8_LDB(B1, 1, 1); PG8_SCHED; PG8_LDA(At, 1, 0); PG8_STAGE(PG8_SA(0, 1), a2 + hstep, voffA);
            PG8_WAIT_V(8); PG8_WAIT_L(0); PG8_BAR; PG8_MMA(0, 0, At, B0); PG8_MMA(0, 1, At, B1); PG8_BAR; PG8_SCHED;
            PG8_LDA(At, 1, 1); PG8_STAGE(PG8_SB(1, 0), b3, voffB); PG8_STAGE(PG8_SB(1, 1), b3 + hstep, voffB); PG8_STAGE(PG8_SA(1, 0), a3, voffA);
            PG8_WAIT_V(8); PG8_WAIT_L(0); PG8_BAR; PG8_MMA(1, 0, At, B0); PG8_MMA(1, 1, At, B1); PG8_BAR; PG8_SCHED;
            } else {
            PG8_LDB(B0, 0, 0); PG8_SCHED; PG8_LDA(At, 0, 0); PG8_STAGE(PG8_SA(1, 1), a1 + hstep, voffA);
            PG8_WAIT_L(8); PG8_BAR; PG8_WAIT_L(0); PG8_MMA(0, 0, At, B0); PG8_BAR; PG8_SCHED;
            PG8_LDB(B1, 0, 1); PG8_STAGE(PG8_SB(0, 0), b2, voffB);
            PG8_BAR; PG8_WAIT_L(0); PG8_MMA(0, 1, At, B1); PG8_BAR;
            PG8_LDA(At, 0, 1); PG8_STAGE(PG8_SA(0, 0), a2, voffA);
            PG8_BAR; PG8_WAIT_L(0); PG8_MMA(1, 0, At, B0); PG8_BAR; PG8_SCHED;
            PG8_STAGE(PG8_SB(0, 1), b2 + hstep, voffB);
            PG8_WAIT_V(6); PG8_BAR; PG8_MMA(1, 1, At, B1); PG8_BAR;
            PG8_LDB(B0, 1, 0); PG8_SCHED; PG8_LDA(At, 1, 0); PG8_STAGE(PG8_SA(0, 1), a2 + hstep, voffA);
            PG8_WAIT_L(8); PG8_BAR; PG8_WAIT_L(0); PG8_MMA(0, 0, At, B0); PG8_BAR; PG8_SCHED;
            PG8_LDB(B1, 1, 1); PG8_STAGE(PG8_SB(1, 0), b3, voffB);
            PG8_BAR; PG8_WAIT_L(0); PG8_MMA(0, 1, At, B1); PG8_BAR;
            PG8_LDA(At, 1, 1); PG8_STAGE(PG8_SA(1, 0), a3, voffA);
            PG8_BAR; PG8_WAIT_L(0); PG8_MMA(1, 0, At, B0); PG8_BAR; PG8_SCHED;
            PG8_STAGE(PG8_SB(1, 1), b3 + hstep, voffB);
            PG8_WAIT_V(6); PG8_BAR; PG8_MMA(1, 1, At, B1); PG8_BAR;
            }
        }
        } else {
        for (int t = 0; t < nt; t += 2) {
            const bool last = (t == nt - 2);
            const char* a1 = cA + (size_t)(t + 1) * kstep;
            const char* a2 = last ? nA : cA + (size_t)(t + 2) * kstep; const char* b2 = last ? nB : cB + (size_t)(t + 2) * kstep;
            const char* a3 = a2 + kstep; const char* b3 = b2 + kstep;
            if (last && has_next) S.a_ready(nxt);
            if constexpr (SP2) {
            PG8_LDB(B0, 0, 0); PG8_LDB(B1, 0, 1); PG8_SCHED; PG8_LDA(At, 0, 0); PG8_STAGE(PG8_SA(1, 1), a1 + hstep, voffA);
            PG8_WAIT_V(8); PG8_WAIT_L(0); PG8_BAR; PG8_MMA(0, 0, At, B0); PG8_MMA(0, 1, At, B1); PG8_BAR; PG8_SCHED;
            PG8_LDA(At, 0, 1); PG8_STAGE(PG8_SB(0, 0), b2, voffB); PG8_STAGE(PG8_SB(0, 1), b2 + hstep, voffB); PG8_STAGE(PG8_SA(0, 0), a2, voffA);
            PG8_WAIT_V(8); PG8_WAIT_L(0); PG8_BAR; PG8_MMA(1, 0, At, B0); PG8_MMA(1, 1, At, B1); PG8_BAR; PG8_SCHED;
            PG8_LDB(B0, 1, 0); PG8_LDB(B1, 1, 1); PG8_SCHED; PG8_LDA(At, 1, 0); PG8_STAGE(PG8_SA(0, 1), a2 + hstep, voffA);
            PG8_WAIT_V(8); PG8_WAIT_L(0); PG8_BAR; PG8_MMA(0, 0, At, B0); PG8_MMA(0, 1, At, B1); PG8_BAR; PG8_SCHED;
            PG8_LDA(At, 1, 1); PG8_STAGE(PG8_SB(1, 0), b3, voffB); PG8_STAGE(PG8_SB(1, 1), b3 + hstep, voffB); PG8_STAGE(PG8_SA(1, 0), a3, voffA);
            PG8_WAIT_V(8); PG8_WAIT_L(0); PG8_BAR; PG8_MMA(1, 0, At, B0); PG8_MMA(1, 1, At, B1); PG8_BAR; PG8_SCHED;
            } else {
            PG8_LDB(B0, 0, 0); PG8_SCHED; PG8_LDA(At, 0, 0); PG8_STAGE(PG8_SA(1, 1), a1 + hstep, voffA);
            PG8_WAIT_L(8); PG8_BAR; PG8_WAIT_L(0); PG8_MMA(0, 0, At, B0); PG8_BAR; PG8_SCHED;
            PG8_LDB(B1, 0, 1); PG8_STAGE(PG8_SB(0, 0), b2, voffB);
            PG8_BAR; PG8_WAIT_L(0); PG8_MMA(0, 1, At, B1); PG8_BAR;
            PG8_LDA(At, 0, 1); PG8_STAGE(PG8_SA(0, 0), a2, voffA);
            PG8_BAR; PG8_WAIT_L(0); PG8_MMA(1, 0, At, B0); PG8_BAR; PG8_SCHED;
            PG8_STAGE(PG8_SB(0, 1), b2 + hstep, voffB);
            PG8_WAIT_V(6); PG8_BAR; PG8_MMA(1, 1, At, B1); PG8_BAR;
            PG8_LDB(B0, 1, 0); PG8_SCHED; PG8_LDA(At, 1, 0); PG8_STAGE(PG8_SA(0, 1), a2 + hstep, voffA);
            PG8_WAIT_L(8); PG8_BAR; PG8_WAIT_L(0); PG8_MMA(0, 0, At, B0); PG8_BAR; PG8_SCHED;
            PG8_LDB(B1, 1, 1); PG8_STAGE(PG8_SB(1, 0), b3, voffB);
            PG8_BAR; PG8_WAIT_L(0); PG8_MMA(0, 1, At, B1); PG8_BAR;
            PG8_LDA(At, 1, 1); PG8_STAGE(PG8_SA(1, 0), a3, voffA);
            PG8_BAR; PG8_WAIT_L(0); PG8_MMA(1, 0, At, B0); PG8_BAR; PG8_SCHED;
            PG8_STAGE(PG8_SB(1, 1), b3 + hstep, voffB);
            PG8_WAIT_V(6); PG8_BAR; PG8_MMA(1, 1, At, B1); PG8_BAR;
            }
        }
        }
        if constexpr (ALIGN_EPI) { if (wr == 0) PG8_BAR; }
        if constexpr (!Epi::AFTER_DRAIN) { E(acc, cur, wr, wc, fr, fq); S.done(cur); }
        if (!has_next) break;
#pragma unroll
        for (int a = 0; a < 2; ++a)
#pragma unroll
            for (int b = 0; b < 2; ++b)
#pragma unroll
                for (int m = 0; m < 4; ++m)
#pragma unroll
                    for (int n = 0; n < 2; ++n) acc[a][b][m][n] = (f32x4){0.f, 0.f, 0.f, 0.f};
        cur = nxt; cA = nA; cB = nB; ++ui;
        if constexpr (ALIGN_EPI) { if (wr == 1) PG8_BAR; }
    }
    PG8_WAIT_V(0);
    if constexpr (!ALIGN_EPI) { if (wr == 0) PG8_BAR; }
    PG8_BAR;
    if constexpr (Epi::AFTER_DRAIN) { E.fused(acc, cur, wr, wc, fr, fq, lds, wid, lane); S.done(cur); }
#undef PG8_SA
#undef PG8_SB
#undef PG8_STAGE
#undef PG8_LDA
#undef PG8_LDB
#undef PG8_MMA
#undef PG8_WAIT_V
#undef PG8_WAIT_L
#undef PG8_BAR
#undef PG8_SCHED
}
}
#ifndef PG8_SP2
#define PG8_SP2 true
#endif
#ifndef PG8_ALIGN
#define PG8_ALIGN true
#endif
constexpr int NWAVES = 8;
#ifndef MK_N_LAUNCHES
#define MK_N_LAUNCHES 1
#endif
#ifndef SB_EARLY_EXIT
#define SB_EARLY_EXIT 1
#endif
constexpr int N_PHASES = 11;
constexpr int N_LAUNCHES = MK_N_LAUNCHES;

constexpr int BATCH = 4, SEQ = 8192, DM = 1024, M = BATCH * SEQ;
constexpr int INW = 5640, NPROJ = 5632, GATE_COL = 3584;
constexpr int NCHUNK = SEQ / 128;
constexpr int N_MLU = BATCH * 4 * NCHUNK;
constexpr float ALPHA = 1.18920711500272107f;
constexpr float LN_EPS = 1e-5f;
constexpr float LOG2E = 1.4426950408889634f;
constexpr float C2 = 0.125f * LOG2E;

constexpr size_t MiB = 1u << 20;
constexpr size_t WS_CTL = 0, CTL_ZERO_BYTES = 1 * MiB;
constexpr size_t WS_WIN_T = 1 * MiB;
constexpr size_t WS_WSB_T = 12 * MiB;
constexpr size_t WS_WOUT_T = 14 * MiB;
constexpr size_t WS_WQG_T = 16 * MiB;
constexpr size_t WS_WPLE_T = 22 * MiB;
constexpr size_t WS_STATS = 23 * MiB;
constexpr size_t WS_GI = 24 * MiB;
constexpr size_t WS_GF = 25 * MiB;
constexpr size_t WS_MLN = 26 * MiB;
constexpr size_t WS_MLS = 27 * MiB;
constexpr size_t WS_XN = 32 * MiB;
constexpr size_t WS_OCAT = 32 * MiB;
constexpr size_t WS_C = 448 * MiB;
constexpr size_t WS_UT = 32 * MiB;
constexpr size_t WS_VT = 48 * MiB;
constexpr float U_SCALE = 64.f, V_SCALE = 8.f;
constexpr size_t WS_PROJ = 96 * MiB;
constexpr size_t SLAB = (size_t)M * 512;
constexpr size_t WS_Y = 96 * MiB;
constexpr size_t WS_PLE = 160 * MiB;
constexpr size_t WS_H1B = 224 * MiB;
constexpr size_t WS_PRE1 = 320 * MiB;
constexpr size_t WS_Q = 320 * MiB;
constexpr size_t WS_IDX = 96 * MiB;
constexpr size_t WS_GATE = 112 * MiB;
constexpr size_t WS_PB = 480 * MiB;
constexpr size_t WS_END = 496 * MiB;
constexpr int CW_TMO = 0, CW_CODE = 1;
constexpr int CW_BAR = 4096;

constexpr int RING_OFF = 0, RING_BYTES = 131072;
constexpr int LDSCTL_OFF = RING_BYTES, MISC_OFF = LDSCTL_OFF + 320;
constexpr int LDS_BYTES = 147456;
#define GAS __attribute__((address_space(1)))
#define LAS __attribute__((address_space(3)))
typedef unsigned short bf16;
typedef unsigned v4u __attribute__((ext_vector_type(4)));
typedef float f32x4 __attribute__((ext_vector_type(4)));
typedef short bf16x8 __attribute__((ext_vector_type(8)));
typedef GAS unsigned gu32;
typedef GAS unsigned long long gu64;
#define RLX_AGENT __ATOMIC_RELAXED, __HIP_MEMORY_SCOPE_AGENT
#define LDS_WAIT() asm volatile("s_waitcnt lgkmcnt(0)" ::: "memory")
#define VM_WAIT() asm volatile("s_waitcnt vmcnt(0)" ::: "memory")
__device__ __forceinline__ unsigned long long rt() { return __builtin_amdgcn_s_memrealtime(); }
__device__ __forceinline__ unsigned f2bf(float f) { unsigned u = __builtin_bit_cast(unsigned, f); return (u + 0x7fffu + ((u >> 16) & 1u)) >> 16; }
__device__ __forceinline__ unsigned pk2(float lo, float hi) { return f2bf(lo) | (f2bf(hi) << 16); }

#define XB_TMO      128
#define XB_XCNT(j)  (256  + 64 * (j))
#define XB_XSUB(j)  (1280 + 64 * (j))
#define XB_XGEN(j)  (2304 + 64 * (j))
#define XB_TOP      3328
#define XB_TOPGEN   3392
#define XCD_BAR_WORDS 3456
#define XB_SPIN_CAP (1u << 18)

__device__ __forceinline__ unsigned xb_ld(unsigned* p)              { return __hip_atomic_load(p, __ATOMIC_RELAXED, __HIP_MEMORY_SCOPE_AGENT); }
__device__ __forceinline__ unsigned xb_add(unsigned* p, unsigned v) { return __hip_atomic_fetch_add(p, v, __ATOMIC_RELAXED, __HIP_MEMORY_SCOPE_AGENT); }
__device__ __forceinline__ unsigned xb_xcc_id() { return (unsigned)__builtin_amdgcn_s_getreg((3 << 11) | 20) & 0xFu; }
#define XB_SPIN(cond, bar) do { unsigned _sp = 0; while (cond) { __builtin_amdgcn_s_sleep(1); \
    if ((++_sp & 255u) == 0u) { if (xb_ld(&(bar)[XB_TMO])) break; if (_sp > XB_SPIN_CAP) { atomicAdd(&(bar)[XB_TMO], 1u); break; } } } } while (0)

struct XcdBarrier {
    unsigned* bar; unsigned x;
    volatile LAS unsigned* st;
};

__device__ __forceinline__ XcdBarrier xcd_barrier_post(unsigned* bar, volatile LAS unsigned* st) {
    XcdBarrier b; b.bar = bar; b.x = xb_xcc_id(); b.st = st;
    if (threadIdx.x == 0) (void)xb_add(&bar[XB_XCNT(b.x)], 1u);
    return b;
}
__device__ __forceinline__ void xcd_barrier_complete(unsigned* bar, unsigned x, unsigned& nloc, unsigned& nx) {
    const unsigned G = gridDim.x * gridDim.y * gridDim.z;
    unsigned sum, cnt, mine, sp = 0u;
    for (;;) {
        sum = 0u; cnt = 0u; mine = 0u;
#pragma unroll
        for (unsigned j = 0; j < 16; ++j) { const unsigned c = xb_ld(&bar[XB_XCNT(j)]); sum += c; cnt += (c > 0u) ? 1u : 0u; mine = (j == x) ? c : mine; }
        if (sum == G) break;
        __builtin_amdgcn_s_sleep(1);
        if ((++sp & 255u) == 0u) { if (xb_ld(&bar[XB_TMO])) break; if (sp > XB_SPIN_CAP) { atomicAdd(&bar[XB_TMO], 1u); break; } }
    }
    nloc = mine > 0u ? mine : 1u; nx = cnt > 0u ? cnt : 1u;
}

__device__ __forceinline__ void xcd_barrier(const XcdBarrier& b) {
    asm volatile("s_waitcnt vmcnt(0)" ::: "memory");
    __syncthreads();
    if (threadIdx.x == 0) {
        unsigned* bar = b.bar;
        __builtin_amdgcn_s_waitcnt(0);
        unsigned nloc = b.st[0], nx = b.st[1];
        if (nloc == 0u) { xcd_barrier_complete(bar, b.x, nloc, nx); b.st[0] = nloc; b.st[1] = nx; }
        const unsigned old = xb_add(&bar[XB_XSUB(b.x)], 1u);
        const unsigned gen = old / nloc;
        if (old + 1u == (gen + 1u) * nloc) {
            __builtin_amdgcn_fence(__ATOMIC_RELEASE, "agent");
            asm volatile("s_waitcnt vmcnt(0)" ::: "memory");
            const unsigned og = xb_add(&bar[XB_TOP], 1u);
            const unsigned tg = og / nx;
            if (og + 1u == (tg + 1u) * nx) xb_add(&bar[XB_TOPGEN], 1u);
            else XB_SPIN(xb_ld(&bar[XB_TOPGEN]) == tg, bar);
            __builtin_amdgcn_fence(__ATOMIC_ACQUIRE, "agent");
            xb_add(&bar[XB_XGEN(b.x)], 1u);
            asm volatile("s_waitcnt vmcnt(0)" ::: "memory");
        } else {
            XB_SPIN(xb_ld(&bar[XB_XGEN(b.x)]) == gen, bar);
            __builtin_amdgcn_fence(__ATOMIC_ACQUIRE, "agent");
            asm volatile("s_waitcnt vmcnt(0)" ::: "memory");
        }
    }
    __syncthreads();
}
typedef float f32x16 __attribute__((ext_vector_type(16)));
typedef float f32x2 __attribute__((ext_vector_type(2)));
typedef unsigned u32x2 __attribute__((ext_vector_type(2)));
typedef __bf16 bf16x2_t __attribute__((ext_vector_type(2)));

struct Frame {
    LAS unsigned char* lds;
    volatile LAS unsigned* MISC;
    gu32* ctl;
    int tid, lane, wave;
    int vcu, G;
    const float* const* in;
    float* out;
    unsigned char* ws;
};
#define WSP(T, off) ((T*)(F.ws + (off)))

#define DPP_F(v, CTRL) __uint_as_float((unsigned)__builtin_amdgcn_mov_dpp((int)__float_as_uint(v), (CTRL), 0xF, 0xF, true))
__device__ __forceinline__ float wave_sum(float v) {
    v += DPP_F(v, 0xB1); v += DPP_F(v, 0x4E); v += DPP_F(v, 0x141); v += DPP_F(v, 0x140);
    v += __uint_as_float((unsigned)__builtin_amdgcn_ds_swizzle((int)__float_as_uint(v), 0x401F));
    auto rr = __builtin_amdgcn_permlane32_swap(__float_as_uint(v), __float_as_uint(v), false, false);
    return __uint_as_float(rr[0]) + __uint_as_float(rr[1]);
}
__device__ __forceinline__ float wave_max(float v) {
    v = fmaxf(v, DPP_F(v, 0xB1)); v = fmaxf(v, DPP_F(v, 0x4E)); v = fmaxf(v, DPP_F(v, 0x141)); v = fmaxf(v, DPP_F(v, 0x140));
    v = fmaxf(v, __uint_as_float((unsigned)__builtin_amdgcn_ds_swizzle((int)__float_as_uint(v), 0x401F)));
    auto rr = __builtin_amdgcn_permlane32_swap(__float_as_uint(v), __float_as_uint(v), false, false);
    return fmaxf(__uint_as_float(rr[0]), __uint_as_float(rr[1]));
}
__device__ __forceinline__ float reduce8_transposed(const float (&d)[8], bool up16, bool up8) {
    float a_[4];
#pragma unroll
    for (int i = 0; i < 4; ++i) { auto rr = __builtin_amdgcn_permlane32_swap(__float_as_uint(d[i]), __float_as_uint(d[4 + i]), false, false); a_[i] = __uint_as_float(rr[0]) + __uint_as_float(rr[1]); }
    float b_[2];
#pragma unroll
    for (int i = 0; i < 2; ++i) { const float keep = up16 ? a_[2 + i] : a_[i], send = up16 ? a_[i] : a_[2 + i];
        b_[i] = keep + __uint_as_float((unsigned)__builtin_amdgcn_ds_swizzle((int)__float_as_uint(send), 0x401F)); }
    const float keep = up8 ? b_[1] : b_[0], send = up8 ? b_[0] : b_[1];
    float c0 = keep + DPP_F(send, 0x128);
    c0 += DPP_F(c0, 0x141); c0 += DPP_F(c0, 0x4E); c0 += DPP_F(c0, 0xB1);
    return c0;
}
__device__ __forceinline__ float bf_lo(unsigned u) { return __uint_as_float(u << 16); }
__device__ __forceinline__ float bf_hi(unsigned u) { return __uint_as_float(u & 0xffff0000u); }
__device__ __forceinline__ unsigned cvtpk(float lo, float hi) { f32x2 v = {lo, hi}; bf16x2_t b = __builtin_convertvector(v, bf16x2_t); return __builtin_bit_cast(unsigned, b); }
__device__ __forceinline__ float sigmoidf_fast(float x) { return __builtin_amdgcn_rcpf(1.0f + __builtin_amdgcn_exp2f(-x * LOG2E)); }
__device__ __forceinline__ float siluf_fast(float x) { return x * sigmoidf_fast(x); }
__device__ __forceinline__ int crow(int r, int hi) { return (r & 3) + 8 * (r >> 2) + 4 * hi; }
__device__ __forceinline__ float dot2_bf16(unsigned w, unsigned x, float acc) { return __builtin_amdgcn_fdot2_f32_bf16(__builtin_bit_cast(bf16x2_t, w), __builtin_bit_cast(bf16x2_t, x), acc, false); }
#define MFMA32(a, b, c) __builtin_amdgcn_mfma_f32_32x32x16_bf16((a), (b), (c), 0, 0, 0)

namespace pg8 {
template <bool ADD> struct EpiGate {
    static constexpr bool PERM = true, AFTER_DRAIN = false; static constexpr int MID_T = -1;
    bf16_t* Y; const bf16_t* G;
    __device__ __forceinline__ void operator()(const f32x4 (&acc)[2][2][4][2], const Unit& u, int wr, int wc, int fr, int fq) const {
        const int row0 = u.pm * BM + wr * 64 + fr, col0 = u.pn * BM + wc * 32 + 8 * fq;
#pragma unroll
        for (int ai = 0; ai < 2; ++ai)
#pragma unroll
            for (int m = 0; m < 4; ++m) { const size_t row = (size_t)(row0 + ai * HALF + m * 16);
#pragma unroll
                for (int bj = 0; bj < 2; ++bj) { const int col = col0 + bj * HALF;
                    const u32x4 g = *(const u32x4*)(G + (size_t)(col >> 9) * SLAB + row * 512 + (col & 511));
                    const f32x4 v0 = acc[ai][bj][m][0], v1 = acc[ai][bj][m][1];
                    float y[8];
                    y[0] = sigmoidf_fast(bf_lo(g.x)) * v0[0]; y[1] = sigmoidf_fast(bf_hi(g.x)) * v0[1]; y[2] = sigmoidf_fast(bf_lo(g.y)) * v0[2]; y[3] = sigmoidf_fast(bf_hi(g.y)) * v0[3];
                    y[4] = sigmoidf_fast(bf_lo(g.z)) * v1[0]; y[5] = sigmoidf_fast(bf_hi(g.z)) * v1[1]; y[6] = sigmoidf_fast(bf_lo(g.w)) * v1[2]; y[7] = sigmoidf_fast(bf_hi(g.w)) * v1[3];
                    u32x4* yp = (u32x4*)(Y + row * 1024 + col);
                    if (ADD) { const u32x4 o = *yp; y[0] += bf_lo(o.x); y[1] += bf_hi(o.x); y[2] += bf_lo(o.y); y[3] += bf_hi(o.y); y[4] += bf_lo(o.z); y[5] += bf_hi(o.z); y[6] += bf_lo(o.w); y[7] += bf_hi(o.w); }
                    u32x4 w; w.x = cvtpk(y[0], y[1]); w.y = cvtpk(y[2], y[3]); w.z = cvtpk(y[4], y[5]); w.w = cvtpk(y[6], y[7]);
                    *yp = w; } }
    }
};
__device__ __forceinline__ float sig_den(float x) { return 1.0f + __builtin_amdgcn_exp2f(fminf(-x * LOG2E, 60.0f)); }
struct EpiGate2 {
    static constexpr bool PERM = true, AFTER_DRAIN = false; static constexpr int MID_T = 8;
    bf16_t* Y; const bf16_t* Gsb; const bf16_t* Gml;
    __device__ __forceinline__ void mid(f32x4 (&acc)[2][2][4][2], const Unit& u, int wr, int wc, int fr, int fq) const {
        const int row0 = u.pm * BM + wr * 64 + fr, col0 = u.pn * BM + wc * 32 + 8 * fq;
#pragma unroll
        for (int ai = 0; ai < 2; ++ai)
#pragma unroll
            for (int m = 0; m < 4; ++m) { const size_t row = (size_t)(row0 + ai * HALF + m * 16);
#pragma unroll
                for (int bj = 0; bj < 2; ++bj) { const int col = col0 + bj * HALF; const size_t go = (size_t)(col >> 9) * SLAB + row * 512 + (col & 511);
                    const u32x4 a = *(const u32x4*)(Gsb + go), b = *(const u32x4*)(Gml + go);
                    f32x4& v0 = acc[ai][bj][m][0]; f32x4& v1 = acc[ai][bj][m][1];
                    v0[0] *= sig_den(bf_lo(b.x)) * __builtin_amdgcn_rcpf(sig_den(bf_lo(a.x))); v0[1] *= sig_den(bf_hi(b.x)) * __builtin_amdgcn_rcpf(sig_den(bf_hi(a.x)));
                    v0[2] *= sig_den(bf_lo(b.y)) * __builtin_amdgcn_rcpf(sig_den(bf_lo(a.y))); v0[3] *= sig_den(bf_hi(b.y)) * __builtin_amdgcn_rcpf(sig_den(bf_hi(a.y)));
                    v1[0] *= sig_den(bf_lo(b.z)) * __builtin_amdgcn_rcpf(sig_den(bf_lo(a.z))); v1[1] *= sig_den(bf_hi(b.z)) * __builtin_amdgcn_rcpf(sig_den(bf_hi(a.z)));
                    v1[2] *= sig_den(bf_lo(b.w)) * __builtin_amdgcn_rcpf(sig_den(bf_lo(a.w))); v1[3] *= sig_den(bf_hi(b.w)) * __builtin_amdgcn_rcpf(sig_den(bf_hi(a.w)));
                    asm volatile("" ::: "memory"); __builtin_amdgcn_sched_barrier(0); } }
    }
    __device__ __forceinline__ void operator()(const f32x4 (&acc)[2][2][4][2], const Unit& u, int wr, int wc, int fr, int fq) const {
        const int row0 = u.pm * BM + wr * 64 + fr, col0 = u.pn * BM + wc * 32 + 8 * fq;
#pragma unroll
        for (int ai = 0; ai < 2; ++ai)
#pragma unroll
            for (int m = 0; m < 4; ++m) { const size_t row = (size_t)(row0 + ai * HALF + m * 16);
#pragma unroll
                for (int bj = 0; bj < 2; ++bj) { const int col = col0 + bj * HALF;
                    const u32x4 b = *(const u32x4*)(Gml + (size_t)(col >> 9) * SLAB + row * 512 + (col & 511));
                    const f32x4 v0 = acc[ai][bj][m][0], v1 = acc[ai][bj][m][1];
                    u32x4 w;
                    w.x = cvtpk(v0[0] * __builtin_amdgcn_rcpf(sig_den(bf_lo(b.x))), v0[1] * __builtin_amdgcn_rcpf(sig_den(bf_hi(b.x)))); w.y = cvtpk(v0[2] * __builtin_amdgcn_rcpf(sig_den(bf_lo(b.y))), v0[3] * __builtin_amdgcn_rcpf(sig_den(bf_hi(b.y))));
                    w.z = cvtpk(v1[0] * __builtin_amdgcn_rcpf(sig_den(bf_lo(b.z))), v1[1] * __builtin_amdgcn_rcpf(sig_den(bf_hi(b.z)))); w.w = cvtpk(v1[2] * __builtin_amdgcn_rcpf(sig_den(bf_lo(b.w))), v1[3] * __builtin_amdgcn_rcpf(sig_den(bf_hi(b.w))));
                    *(u32x4*)(Y + row * 1024 + col) = w; } }
    }
};
struct EpiPre1 {
    static constexpr bool PERM = false, AFTER_DRAIN = false; static constexpr int MID_T = -1;
    float* P; const float* x; const float* stats; const float* g0; const float* b0;
    __device__ __forceinline__ void operator()(const f32x4 (&acc)[2][2][4][2], const Unit& u, int wr, int wc, int fr, int fq) const {
        const int row0 = u.pm * BM + wr * 64 + fr, col0 = u.pn * BM + wc * 32 + 4 * fq;
        f32x4 gv[2][2], bv[2][2];
#pragma unroll
        for (int bj = 0; bj < 2; ++bj)
#pragma unroll
            for (int n = 0; n < 2; ++n) { gv[bj][n] = *(const f32x4*)(g0 + col0 + bj * HALF + n * 16); bv[bj][n] = *(const f32x4*)(b0 + col0 + bj * HALF + n * 16); }
#pragma unroll
        for (int ai = 0; ai < 2; ++ai)
#pragma unroll
            for (int m = 0; m < 4; ++m) { const size_t row = (size_t)(row0 + ai * HALF + m * 16); const f32x2 st = *(const f32x2*)(stats + row * 2);
#pragma unroll
                for (int bj = 0; bj < 2; ++bj)
#pragma unroll
                    for (int n = 0; n < 2; ++n) { const size_t off = row * 1024 + col0 + bj * HALF + n * 16; const f32x4 xv = *(const f32x4*)(x + off);
                        const f32x4 h0 = (xv - st.x) * st.y * gv[bj][n] + bv[bj][n];
                        *(f32x4*)(P + off) = h0 * ALPHA + acc[ai][bj][m][n]; } }
    }
};
struct EpiQG {
    static constexpr bool PERM = true, AFTER_DRAIN = false; static constexpr int MID_T = -1;
    bf16_t* Q; bf16_t* PLE;
    __device__ __forceinline__ void operator()(const f32x4 (&acc)[2][2][4][2], const Unit& u, int wr, int wc, int fr, int fq) const {
        const int row0 = u.pm * BM + wr * 64 + fr, colt = u.pn * BM, col0 = colt + wc * 32 + 8 * fq;
        const bool isq = colt < 2048;
#pragma unroll
        for (int ai = 0; ai < 2; ++ai)
#pragma unroll
            for (int m = 0; m < 4; ++m) { const size_t row = (size_t)(row0 + ai * HALF + m * 16);
#pragma unroll
                for (int bj = 0; bj < 2; ++bj) { const int col = col0 + bj * HALF; const f32x4 v0 = acc[ai][bj][m][0], v1 = acc[ai][bj][m][1];
                    if (isq) { u32x4 w; w.x = cvtpk(v0[0], v0[1]); w.y = cvtpk(v0[2], v0[3]); w.z = cvtpk(v1[0], v1[1]); w.w = cvtpk(v1[2], v1[3]);
                        *(u32x4*)(Q + row * 2048 + col) = w; }
                    else { u32x4* pp = (u32x4*)(PLE + row * 1024 + (col - 2048)); const u32x4 o = *pp; u32x4 w;
                        w.x = cvtpk(sigmoidf_fast(v0[0]) * bf_lo(o.x), sigmoidf_fast(v0[1]) * bf_hi(o.x)); w.y = cvtpk(sigmoidf_fast(v0[2]) * bf_lo(o.y), sigmoidf_fast(v0[3]) * bf_hi(o.y));
                        w.z = cvtpk(sigmoidf_fast(v1[0]) * bf_lo(o.z), sigmoidf_fast(v1[1]) * bf_hi(o.z)); w.w = cvtpk(sigmoidf_fast(v1[2]) * bf_lo(o.w), sigmoidf_fast(v1[3]) * bf_hi(o.w));
                        *pp = w; } } }
    }
};
}

__device__ __forceinline__ void p0_transpose_item(const float* W, int ldw, int K, int nblk, int shift_from, int shift, bf16* WT, int row_off, LAS float* scr, int item, int lane, int ldt = 0, int kofs = 0) {
    const int kb = item / nblk, nb = item % nblk, k0 = 64 * kb, n0 = 32 * nb, sn0 = n0 + (n0 >= shift_from ? shift : 0);
#pragma unroll 8
    for (int i = 0; i < 32; ++i) { const int kk = 2 * i + (lane >> 5); scr[kk * 33 + (lane & 31)] = W[(size_t)(k0 + kk) * ldw + sn0 + (lane & 31)]; }
    LDS_WAIT(); asm volatile("" ::: "memory");
    const int c = lane & 7;
#pragma unroll
    for (int j = 0; j < 4; ++j) { const int n = (lane >> 3) + 8 * j; const LAS float* s = scr + (8 * c) * 33 + n;
        v4u o; o.x = pk2(s[0 * 33], s[1 * 33]); o.y = pk2(s[2 * 33], s[3 * 33]); o.z = pk2(s[4 * 33], s[5 * 33]); o.w = pk2(s[6 * 33], s[7 * 33]);
        *(GAS v4u*)(WT + (size_t)(row_off + n0 + n) * (ldt ? ldt : K) + kofs + k0 + 8 * c) = o; }
    LDS_WAIT(); asm volatile("" ::: "memory");
}
__device__ __forceinline__ float log_sigmoidf(float x) { return -(fmaxf(-x, 0.f) + log1pf(expf(-fabsf(x)))); }

__device__ __forceinline__ void p0_prologue(Frame& F) {
    const int gw = F.vcu * NWAVES + F.wave, NGW = F.G * NWAVES, lane = F.lane;
    {
        LAS float* scr = (LAS float*)(F.lds + RING_OFF + F.wave * 16384);
        constexpr int I_IN = 16 * (NPROJ / 32), I_SB = 8 * 32, I_ML = 8 * 32, I_OUT = 16 * 32, I_WQ = 16 * 64, I_WG = 16 * 32, I_PLE = 4 * 32;
        constexpr int NITEMS = I_IN + I_SB + I_ML + I_OUT + I_WQ + I_WG + I_PLE;
        for (int it = gw; it < NITEMS; it += NGW) {
            int r = it;
            if (r < I_IN) { p0_transpose_item(F.in[4], INW, 1024, NPROJ / 32, GATE_COL, 8, WSP(bf16, WS_WIN_T), 0, scr, r, lane); continue; } r -= I_IN;
            if (r < I_SB) { p0_transpose_item(F.in[9], 1024, 512, 32, 1 << 30, 0, WSP(bf16, WS_WSB_T), 0, scr, r, lane, 1024, 0); continue; } r -= I_SB;
            if (r < I_ML) { p0_transpose_item(F.in[10], 1024, 512, 32, 1 << 30, 0, WSP(bf16, WS_WSB_T), 0, scr, r, lane, 1024, 512); continue; } r -= I_ML;
            if (r < I_OUT) { p0_transpose_item(F.in[11], 1024, 1024, 32, 1 << 30, 0, WSP(bf16, WS_WOUT_T), 0, scr, r, lane); continue; } r -= I_OUT;
            if (r < I_WQ) { p0_transpose_item(F.in[14], 2048, 1024, 64, 1 << 30, 0, WSP(bf16, WS_WQG_T), 0, scr, r, lane); continue; } r -= I_WQ;
            if (r < I_WG) { p0_transpose_item(F.in[19], 1024, 1024, 32, 1 << 30, 0, WSP(bf16, WS_WQG_T), 2048, scr, r, lane); continue; } r -= I_WG;
            p0_transpose_item(F.in[20], 1024, 256, 32, 1 << 30, 0, WSP(bf16, WS_WPLE_T), 0, scr, r, lane);
        }
    }
    {
        const float* p = F.in[1]; bf16* PB = WSP(bf16, WS_PB);
        const size_t nchunk = (size_t)M * 256 / 8, stride = (size_t)F.G * NWAVES * 64;
        for (size_t i = (size_t)F.vcu * NWAVES * 64 + F.tid; i < nchunk; i += stride) {
            const f32x4 a = *(const GAS f32x4*)(p + i * 8), b = *(const GAS f32x4*)(p + i * 8 + 4);
            v4u o; o.x = pk2(a.x, a.y); o.y = pk2(a.z, a.w); o.z = pk2(b.x, b.y); o.w = pk2(b.z, b.w);
            *(GAS v4u*)(PB + i * 8) = o; }
    }
    __syncthreads();
    LAS float* WGt = (LAS float*)(F.lds + RING_OFF);
    for (int i = F.tid; i < 8192; i += NWAVES * 64) { const int k = i >> 3, c = i & 7; WGt[c * 1024 + k] = F.in[4][(size_t)k * INW + GATE_COL + c]; }
    __syncthreads();
    const float* x = F.in[0]; const float* g0 = F.in[2]; const float* b0 = F.in[3];
    f32x4 gv[4], bv[4];
#pragma unroll
    for (int j = 0; j < 4; ++j) { gv[j] = *(const f32x4*)(g0 + 256 * j + 4 * lane); bv[j] = *(const f32x4*)(b0 + 256 * j + 4 * lane); }
    bf16* XN = WSP(bf16, WS_XN); float* stats = WSP(float, WS_STATS); float* GI = WSP(float, WS_GI); float* GF = WSP(float, WS_GF);
    const float big = F.in[5][(lane >> 3) & 3], bfg = F.in[6][(lane >> 3) & 3];
    const bool up16 = (lane & 16) != 0, up8 = (lane & 8) != 0;
    f32x4 vn[4];
    if (gw < M) {
#pragma unroll
        for (int j = 0; j < 4; ++j) vn[j] = ((const GAS f32x4*)(x + (size_t)gw * DM) + lane)[64 * j]; }
    for (int m = gw; m < M; m += NGW) {
        f32x4 v[4]; float s = 0.f;
#pragma unroll
        for (int j = 0; j < 4; ++j) v[j] = vn[j];
        { const int mn = (m + NGW < M) ? m + NGW : m;
#pragma unroll
            for (int j = 0; j < 4; ++j) vn[j] = ((const GAS f32x4*)(x + (size_t)mn * DM) + lane)[64 * j]; }
        __builtin_amdgcn_sched_barrier(0);
#pragma unroll
        for (int j = 0; j < 4; ++j) s += (v[j].x + v[j].y) + (v[j].z + v[j].w);
        const float mean = wave_sum(s) * (1.f / DM); float s2 = 0.f;
#pragma unroll
        for (int j = 0; j < 4; ++j) { v[j] = v[j] - mean; s2 += (v[j].x * v[j].x + v[j].y * v[j].y) + (v[j].z * v[j].z + v[j].w * v[j].w); }
        const float rstd = 1.f / sqrtf(wave_sum(s2) * (1.f / DM) + LN_EPS);
        GAS unsigned long long* o8 = (GAS unsigned long long*)(XN + (size_t)m * DM) + lane;
        float part[8];
#pragma unroll
        for (int c = 0; c < 8; ++c) part[c] = 0.f;
#pragma unroll
        for (int j = 0; j < 4; ++j) { const f32x4 y = v[j] * rstd * gv[j] + bv[j];
            o8[64 * j] = (unsigned long long)pk2(y.x, y.y) | ((unsigned long long)pk2(y.z, y.w) << 32);
#pragma unroll
            for (int c = 0; c < 8; ++c) { const f32x4 w = *(const LAS f32x4*)(WGt + c * 1024 + 256 * j + 4 * lane); part[c] += (y.x * w.x + y.y * w.y) + (y.z * w.z + y.w * w.w); } }
        const float sel = reduce8_transposed(part, up16, up8);
        if (lane == 0) { stats[(size_t)m * 2] = mean; stats[(size_t)m * 2 + 1] = rstd; }
        if ((lane & 7) == 0) { const int c = lane >> 3; if (c < 4) GI[(size_t)m * 4 + c] = sel + big; else GF[(size_t)m * 4 + (c - 4)] = log_sigmoidf(sel + bfg); }
    }
}
template <bool MASK>
__device__ __forceinline__ void sb_block(const f32x16& x, float& R, int kbase, int qg, int hi, unsigned (&pw)[8]) {
    float bt[16], om[16];
#pragma unroll
    for (int r = 0; r < 16; ++r) {
        const float xv = fminf(fmaxf(x[r], -60.f), 60.f);
        const float e = __builtin_amdgcn_exp2f(-xv);
        const float be = __builtin_amdgcn_rcpf(1.0f + e);
        bt[r] = be; om[r] = e * be;
        if (MASK) { const bool c = (kbase + crow(r, hi)) < qg; om[r] = c ? om[r] : 1.f; bt[r] = c ? bt[r] : 0.f; }
    }
    float ex[16], T[4];
#pragma unroll
    for (int g = 0; g < 4; ++g) { ex[4 * g + 3] = 1.f; ex[4 * g + 2] = om[4 * g + 3]; ex[4 * g + 1] = ex[4 * g + 2] * om[4 * g + 2]; ex[4 * g] = ex[4 * g + 1] * om[4 * g + 1]; T[g] = ex[4 * g] * om[4 * g]; }
    float S[4], up[4];
#pragma unroll
    for (int g = 0; g < 4; ++g) { auto rr = __builtin_amdgcn_permlane32_swap(__float_as_uint(T[g]), __float_as_uint(T[g]), false, false);
        const float lo_v = __uint_as_float(rr[0]), up_v = __uint_as_float(rr[1]); S[g] = lo_v * up_v; up[g] = up_v; }
    float base[4];
    base[3] = R; base[2] = base[3] * S[3]; base[1] = base[2] * S[2]; base[0] = base[1] * S[1];
    R = base[0] * S[0];
    float w[16];
#pragma unroll
    for (int g = 0; g < 4; ++g) { const float off = base[g] * (hi == 0 ? up[g] : 1.f);
#pragma unroll
        for (int i = 0; i < 4; ++i) w[4 * g + i] = bt[4 * g + i] * (off * ex[4 * g + i]); }
#pragma unroll
    for (int i = 0; i < 8; ++i) pw[i] = cvtpk(w[2 * i], w[2 * i + 1]);
}

constexpr int AT_KS = 0, AT_KSB = 64 * 144, AT_VT = 2 * AT_KSB, AT_VTB = 64 * 136, AT_FL = AT_VT + 2 * AT_VTB;
__device__ __forceinline__ void attn_unit(Frame& F, int bh, int qb) {
    const int tid = F.tid, lane = F.lane, wave = F.wave, r32 = lane & 31, hi = lane >> 5;
    const int b = bh >> 3, h = bh & 7;
    const size_t rowbase = (size_t)b * SEQ;
    const int q0 = qb * 256, qw = q0 + wave * 32;
    const bf16* PROJ = WSP(bf16, WS_PROJ);
    const bf16* Qs = PROJ + (rowbase + qw) * 512 + h * 64;
    const bf16* Ks = PROJ + SLAB + rowbase * 512 + h * 64;
    const bf16* Vs = PROJ + 2 * SLAB + rowbase * 512 + h * 64;
    bf16x8 qr[4];
#pragma unroll
    for (int ks = 0; ks < 4; ++ks) qr[ks] = *(const bf16x8*)(Qs + (size_t)r32 * 512 + ks * 16 + hi * 8);
    LAS unsigned char* L = F.lds + RING_OFF;
    LAS unsigned* FL = (LAS unsigned*)(L + AT_FL);
    const int skey = tid >> 3, sch = tid & 7;
    f32x16 o0, o1;
#pragma unroll
    for (int r = 0; r < 16; ++r) { o0[r] = 0.f; o1[r] = 0.f; }
    float R = 1.f; bool wdone = false;
    const int NT = (q0 + 256) >> 6;
    v4u kreg, vreg;
#define AT_LOAD(kt) do { const size_t ro_ = (size_t)((kt) * 64 + skey) * 512 + sch * 8; kreg = *(const v4u*)(Ks + ro_); vreg = *(const v4u*)(Vs + ro_); } while (0)
#define AT_WRITE(buf) do { *(LAS v4u*)(L + AT_KS + (buf) * AT_KSB + skey * 144 + sch * 16) = kreg; \
        LAS unsigned short* vt_ = (LAS unsigned short*)(L + AT_VT + (buf) * AT_VTB) + (sch * 8) * 68 + skey; \
        vt_[0 * 68] = (unsigned short)(vreg.x & 0xffffu); vt_[1 * 68] = (unsigned short)(vreg.x >> 16); vt_[2 * 68] = (unsigned short)(vreg.y & 0xffffu); vt_[3 * 68] = (unsigned short)(vreg.y >> 16); \
        vt_[4 * 68] = (unsigned short)(vreg.z & 0xffffu); vt_[5 * 68] = (unsigned short)(vreg.z >> 16); vt_[6 * 68] = (unsigned short)(vreg.w & 0xffffu); vt_[7 * 68] = (unsigned short)(vreg.w >> 16); } while (0)
    AT_LOAD(NT - 1); AT_WRITE(0);
    __syncthreads();
    int cur = 0, par = 0;
    for (int kt = NT - 1; kt >= 0; --kt) {
        if (kt > 0) AT_LOAD(kt - 1);
        if (!wdone && 64 * kt < qw + 31) {
            const bool full = (64 * kt + 63 < qw);
#pragma unroll
            for (int kbi = 0; kbi < 2; ++kbi) { const int kb = 1 - kbi; const int kbase = 64 * kt + 32 * kb;
                if (kbase < qw + 31) {
                    f32x16 x;
#pragma unroll
                    for (int r = 0; r < 16; ++r) x[r] = 0.f;
#pragma unroll
                    for (int ks = 0; ks < 4; ++ks) { const bf16x8 a = *(const LAS bf16x8*)(L + AT_KS + cur * AT_KSB + (32 * kb + r32) * 144 + (16 * ks + 8 * hi) * 2); x = MFMA32(a, qr[ks], x); }
                    unsigned pw[8];
                    if (full) sb_block<false>(x, R, kbase, qw + r32, hi, pw); else sb_block<true>(x, R, kbase, qw + r32, hi, pw);
#pragma unroll
                    for (int s2 = 0; s2 < 2; ++s2) { v4u av; av.x = pw[4 * s2]; av.y = pw[4 * s2 + 1]; av.z = pw[4 * s2 + 2]; av.w = pw[4 * s2 + 3]; const bf16x8 a = __builtin_bit_cast(bf16x8, av);
#pragma unroll
                        for (int dt = 0; dt < 2; ++dt) { const LAS unsigned char* vp = L + AT_VT + cur * AT_VTB + (32 * dt + r32) * 136 + (32 * kb + 16 * s2 + 4 * hi) * 2;
                            const u32x2 b0 = *(const LAS u32x2*)vp, b1 = *(const LAS u32x2*)(vp + 16);
                            v4u bv; bv.x = b0.x; bv.y = b0.y; bv.z = b1.x; bv.w = b1.y; const bf16x8 bb = __builtin_bit_cast(bf16x8, bv);
                            if (dt == 0) o0 = MFMA32(a, bb, o0); else o1 = MFMA32(a, bb, o1); } }
                }
            }
#if SB_EARLY_EXIT
            wdone = __all(R == 0.f);
#endif
        }
        if (lane == 0) FL[par * 8 + wave] = wdone ? 1u : 0u;
        if (kt > 0) AT_WRITE(cur ^ 1);
        __syncthreads();
        unsigned alld = 1u;
#pragma unroll
        for (int w = 0; w < 8; ++w) alld &= FL[par * 8 + w];
        cur ^= 1; par ^= 1;
        if (alld) break;
    }
#undef AT_LOAD
#undef AT_WRITE
    bf16* Ow = WSP(bf16, WS_OCAT) + (rowbase + qw) * 1024 + h * 64 + r32;
#pragma unroll
    for (int r = 0; r < 16; ++r) { const int q = crow(r, hi); Ow[(size_t)q * 1024] = (bf16)f2bf(o0[r]); Ow[(size_t)q * 1024 + 32] = (bf16)f2bf(o1[r]); }
    __syncthreads();
}

template <bool TRANS>
__device__ __forceinline__ void ml_stage_conv(Frame& F, const bf16* raw, int t0, const float* cw, const float* cb, float scale, LAS bf16* dst) {
    const int cg = F.tid & 15, rr = F.tid >> 4;
    float w[4][8], bb[8];
#pragma unroll
    for (int j = 0; j < 4; ++j) { const f32x4 a = *(const f32x4*)(cw + j * 1024 + cg * 8), c = *(const f32x4*)(cw + j * 1024 + cg * 8 + 4);
        w[j][0] = a.x; w[j][1] = a.y; w[j][2] = a.z; w[j][3] = a.w; w[j][4] = c.x; w[j][5] = c.y; w[j][6] = c.z; w[j][7] = c.w; }
    { const f32x4 a = *(const f32x4*)(cb + cg * 8), c = *(const f32x4*)(cb + cg * 8 + 4); bb[0] = a.x; bb[1] = a.y; bb[2] = a.z; bb[3] = a.w; bb[4] = c.x; bb[5] = c.y; bb[6] = c.z; bb[7] = c.w; }
#pragma unroll
    for (int p = 0; p < 4; ++p) { const int s = p * 32 + rr;
        float y[8];
#pragma unroll
        for (int i = 0; i < 8; ++i) y[i] = bb[i];
#pragma unroll
        for (int j = 0; j < 4; ++j) { const int t = t0 + s - j;
            v4u rv = {0u, 0u, 0u, 0u};
            if (t >= 0) rv = *(const v4u*)(raw + (size_t)t * 512 + cg * 8);
            y[0] += w[j][0] * bf_lo(rv.x); y[1] += w[j][1] * bf_hi(rv.x); y[2] += w[j][2] * bf_lo(rv.y); y[3] += w[j][3] * bf_hi(rv.y);
            y[4] += w[j][4] * bf_lo(rv.z); y[5] += w[j][5] * bf_hi(rv.z); y[6] += w[j][6] * bf_lo(rv.w); y[7] += w[j][7] * bf_hi(rv.w); }
#pragma unroll
        for (int i = 0; i < 8; ++i) y[i] = siluf_fast(y[i]) * scale;
        if (!TRANS) { v4u o; o.x = cvtpk(y[0], y[1]); o.y = cvtpk(y[2], y[3]); o.z = cvtpk(y[4], y[5]); o.w = cvtpk(y[6], y[7]); *(LAS v4u*)(dst + s * 136 + cg * 8) = o; }
        else {
#pragma unroll
            for (int i = 0; i < 8; ++i) dst[(cg * 8 + i) * 136 + s] = (bf16)f2bf(y[i]); }
    }
}
__device__ __forceinline__ void scan_add128(float a0, float a1, int lane, float& o0, float& o1) {
    float v = a0 + a1;
#pragma unroll
    for (int d = 1; d < 64; d <<= 1) { const float t = __shfl_up(v, d); if (lane >= d) v += t; }
    const float exv = v - (a0 + a1); o0 = exv + a0; o1 = exv + a0 + a1;
}
__device__ __forceinline__ void scan_max128(float a0, float a1, int lane, float& o0, float& o1) {
    float v = fmaxf(a0, a1);
#pragma unroll
    for (int d = 1; d < 64; d <<= 1) { const float t = __shfl_up(v, d); if (lane >= d) v = fmaxf(v, t); }
    float pv = __shfl_up(v, 1); if (lane == 0) pv = -INFINITY;
    o0 = fmaxf(pv, a0); o1 = fmaxf(o0, a1);
}

constexpr int ML_T0 = 0, ML_T1 = 34816, ML_T2 = 69632, ML_SM = 104448;
__device__ __forceinline__ void mla_unit(Frame& F, int u) {
    const int tid = F.tid, lane = F.lane, wave = F.wave, r32 = lane & 31, hi = lane >> 5;
    const int bhd = u >> 6, ch = u & 63, b = bhd >> 2, hd = bhd & 3;
    const size_t rowbase = (size_t)b * SEQ; const int t0 = ch * 128;
    LAS unsigned char* L = F.lds + RING_OFF;
    LAS bf16* KT = (LAS bf16*)(L + ML_T0); LAS bf16* VT = (LAS bf16*)(L + ML_T1);
    LAS float* BC = (LAS float*)(L + ML_SM); LAS float* EE = BC + 128; LAS float* SC = BC + 256;
    const bf16* PROJ = WSP(bf16, WS_PROJ);
    const float* GI = WSP(float, WS_GI); const float* GF = WSP(float, WS_GF);
    if (wave == 0) {
        const size_t r0 = rowbase + t0 + 2 * lane;
        const float f0 = GF[r0 * 4 + hd], f1 = GF[(r0 + 1) * 4 + hd], i0 = GI[r0 * 4 + hd], i1 = GI[(r0 + 1) * 4 + hd];
        float c0, c1; scan_add128(f0, f1, lane, c0, c1);
        const float blast = __shfl(c1, 63);
        const float w0 = blast - c0 + i0, w1 = blast - c1 + i1;
        const float mloc = wave_max(fmaxf(w0, w1));
        EE[2 * lane] = __expf(w0 - mloc); EE[2 * lane + 1] = __expf(w1 - mloc);
        if (lane == 0) { float* S = WSP(float, WS_MLS); S[u] = mloc; S[1024 + u] = blast; }
    }
    ml_stage_conv<true>(F, PROJ + 4 * SLAB + rowbase * 512 + hd * 128, t0, F.in[7] + 512 + hd * 128, F.in[8] + 512 + hd * 128, 0.08838834764831845f, KT);
    __syncthreads();
    {
        const bf16* Vs = PROJ + 5 * SLAB + (rowbase + t0) * 512 + hd * 128;
        const int cg = tid & 15, rr = tid >> 4;
#pragma unroll
        for (int p = 0; p < 4; ++p) { const int s = p * 32 + rr; const float e = EE[s]; const v4u rv = *(const v4u*)(Vs + (size_t)s * 512 + cg * 8);
            LAS bf16* d = VT + (cg * 8) * 136 + s;
            d[0 * 136] = (bf16)f2bf(e * bf_lo(rv.x)); d[1 * 136] = (bf16)f2bf(e * bf_hi(rv.x)); d[2 * 136] = (bf16)f2bf(e * bf_lo(rv.y)); d[3 * 136] = (bf16)f2bf(e * bf_hi(rv.y));
            d[4 * 136] = (bf16)f2bf(e * bf_lo(rv.z)); d[5 * 136] = (bf16)f2bf(e * bf_hi(rv.z)); d[6 * 136] = (bf16)f2bf(e * bf_lo(rv.w)); d[7 * 136] = (bf16)f2bf(e * bf_hi(rv.w)); }
    }
    if (tid < 128) {
        float n = 0.f; const LAS bf16* kr = KT + tid * 136;
#pragma unroll 4
        for (int s8 = 0; s8 < 16; ++s8) { const v4u kv = *(const LAS v4u*)(kr + s8 * 8); const LAS float* ep = EE + s8 * 8;
            n += ep[0] * bf_lo(kv.x) + ep[1] * bf_hi(kv.x) + ep[2] * bf_lo(kv.y) + ep[3] * bf_hi(kv.y) + ep[4] * bf_lo(kv.z) + ep[5] * bf_hi(kv.z) + ep[6] * bf_lo(kv.w) + ep[7] * bf_hi(kv.w); }
        WSP(float, WS_MLN)[(size_t)u * 128 + tid] = n;
    }
    __syncthreads();
    {
        const int dvt = wave >> 1, eh = wave & 1;
        f32x16 c0, c1;
#pragma unroll
        for (int r = 0; r < 16; ++r) { c0[r] = 0.f; c1[r] = 0.f; }
#pragma unroll
        for (int ks = 0; ks < 8; ++ks) { const bf16x8 a = *(const LAS bf16x8*)(VT + (32 * dvt + r32) * 136 + 16 * ks + 8 * hi);
            const bf16x8 b0 = *(const LAS bf16x8*)(KT + (64 * eh + r32) * 136 + 16 * ks + 8 * hi), b1 = *(const LAS bf16x8*)(KT + (64 * eh + 32 + r32) * 136 + 16 * ks + 8 * hi);
            c0 = MFMA32(a, b0, c0); c1 = MFMA32(a, b1, c1); }
        bf16* Cg = WSP(bf16, WS_C) + (size_t)u * 16384 + 64 * eh + r32;
#pragma unroll
        for (int r = 0; r < 16; ++r) { const int dv = 32 * dvt + crow(r, hi); Cg[(size_t)dv * 128] = (bf16)f2bf(c0[r]); Cg[(size_t)dv * 128 + 32] = (bf16)f2bf(c1[r]); }
    }
    __syncthreads();
}

__device__ __forceinline__ void ml_scan_item(Frame& F, int item, const size_t dummy = 0) {
    const int tid = F.tid; const int bhd = item >> 4, part = item & 15;
    LAS float* SM = (LAS float*)(F.lds + RING_OFF);
    float* S = WSP(float, WS_MLS);
    if (tid < 64) SM[tid] = S[bhd * 64 + tid]; else if (tid < 128) SM[tid] = S[1024 + bhd * 64 + (tid - 64)];
    unsigned* Cw = WSP(unsigned, WS_C) + (size_t)bhd * 64 * 8192 + (size_t)(part * 8 + (tid >> 6)) * 64 + (tid & 63);
    unsigned cl[64];
#pragma unroll
    for (int j = 0; j < 64; ++j) cl[j] = Cw[(size_t)j * 8192];
    const bool do_n = (part == 0 && tid < 128);
    float* Nw = WSP(float, WS_MLN) + (size_t)bhd * 64 * 128 + (tid & 127);
    float nlv[64];
#pragma unroll
    for (int j = 0; j < 64; ++j) nlv[j] = do_n ? Nw[(size_t)j * 128] : 0.f;
    __syncthreads();
    float c0 = 0.f, c1 = 0.f, m = 0.f, n = 0.f;
#pragma unroll
    for (int j = 0; j < 64; ++j) {
        const float ml = SM[j], bl = SM[64 + j];
        (dummy ? (unsigned*)(F.ws + dummy) + (Cw - WSP(unsigned, WS_C)) : Cw)[(size_t)j * 8192] = cvtpk(c0, c1);
        const float nl = nlv[j]; if (do_n) (dummy ? (float*)(F.ws + dummy + 40 * MiB) + (Nw - WSP(float, WS_MLN)) : Nw)[(size_t)j * 128] = n;
        if (part == 0 && tid == 0) (dummy ? (float*)(F.ws + dummy + 48 * MiB) : S)[2048 + bhd * 64 + j] = m;
        const float mn = fmaxf(bl + m, ml), a = __expf(bl + m - mn), g = __expf(ml - mn);
        c0 = a * c0 + g * bf_lo(cl[j]); c1 = a * c1 + g * bf_hi(cl[j]); n = a * n + g * nl; m = mn;
    }
    __syncthreads();
}

__device__ __forceinline__ void mlc_unit(Frame& F, int u) {
    const int tid = F.tid, lane = F.lane, wave = F.wave, r32 = lane & 31, hi = lane >> 5;
    const int bhd = u >> 6, ch = u & 63, b = bhd >> 2, hd = bhd & 3;
    const size_t rowbase = (size_t)b * SEQ; const int t0 = ch * 128;
    LAS unsigned char* L = F.lds + RING_OFF;
    LAS bf16* QS = (LAS bf16*)(L + ML_T0); LAS bf16* KS = (LAS bf16*)(L + ML_T1); LAS bf16* VT = (LAS bf16*)(L + ML_T2);
    LAS float* AA = (LAS float*)(L + ML_SM); LAS float* MM = AA + 128; LAS float* AT = AA + 256; LAS float* EM = AA + 384; LAS float* NP = AA + 512; LAS float* NQ = AA + 640; LAS float* INV = AA + 768;
    const bf16* PROJ = WSP(bf16, WS_PROJ);
    const float* GI = WSP(float, WS_GI); const float* GF = WSP(float, WS_GF);
    const float mprev = WSP(float, WS_MLS)[2048 + u];
    if (wave == 0) {
        const size_t r0 = rowbase + t0 + 2 * lane;
        const float f0 = GF[r0 * 4 + hd], f1 = GF[(r0 + 1) * 4 + hd], i0 = GI[r0 * 4 + hd], i1 = GI[(r0 + 1) * 4 + hd];
        float c0, c1; scan_add128(f0, f1, lane, c0, c1);
        const float a0 = i0 - c0, a1 = i1 - c1;
        float p0, p1; scan_max128(a0, a1, lane, p0, p1);
        const float m0 = fmaxf(mprev, p0), m1 = fmaxf(mprev, p1);
        AA[2 * lane] = a0; AA[2 * lane + 1] = a1; MM[2 * lane] = m0; MM[2 * lane + 1] = m1;
        AT[2 * lane] = __expf(mprev - m0); AT[2 * lane + 1] = __expf(mprev - m1);
        EM[2 * lane] = __expf(-(c0 + m0)); EM[2 * lane + 1] = __expf(-(c1 + m1));
    } else if (wave == 1) {
        const float* Np = WSP(float, WS_MLN) + (size_t)u * 128; NP[2 * lane] = Np[2 * lane]; NP[2 * lane + 1] = Np[2 * lane + 1];
    }
    ml_stage_conv<false>(F, PROJ + 3 * SLAB + rowbase * 512 + hd * 128, t0, F.in[7] + hd * 128, F.in[8] + hd * 128, 1.0f, QS);
    ml_stage_conv<false>(F, PROJ + 4 * SLAB + rowbase * 512 + hd * 128, t0, F.in[7] + 512 + hd * 128, F.in[8] + 512 + hd * 128, 0.08838834764831845f, KS);
    {
        const bf16* Vs = PROJ + 5 * SLAB + (rowbase + t0) * 512 + hd * 128;
        const int cg = tid & 15, rr = tid >> 4;
#pragma unroll
        for (int p = 0; p < 4; ++p) { const int s = p * 32 + rr; const v4u rv = *(const v4u*)(Vs + (size_t)s * 512 + cg * 8);
            LAS bf16* d = VT + (cg * 8) * 136 + s;
            d[0 * 136] = (bf16)(rv.x & 0xffffu); d[1 * 136] = (bf16)(rv.x >> 16); d[2 * 136] = (bf16)(rv.y & 0xffffu); d[3 * 136] = (bf16)(rv.y >> 16);
            d[4 * 136] = (bf16)(rv.z & 0xffffu); d[5 * 136] = (bf16)(rv.z >> 16); d[6 * 136] = (bf16)(rv.w & 0xffffu); d[7 * 136] = (bf16)(rv.w >> 16); }
    }
    __syncthreads();
    if (tid < 128) {
        float n = 0.f; const LAS bf16* qrow = QS + tid * 136;
#pragma unroll 4
        for (int e8 = 0; e8 < 16; ++e8) { const v4u qv = *(const LAS v4u*)(qrow + e8 * 8); const LAS float* np = NP + e8 * 8;
            n += np[0] * bf_lo(qv.x) + np[1] * bf_hi(qv.x) + np[2] * bf_lo(qv.y) + np[3] * bf_hi(qv.y) + np[4] * bf_lo(qv.z) + np[5] * bf_hi(qv.z) + np[6] * bf_lo(qv.w) + np[7] * bf_hi(qv.w); }
        NQ[tid] = n;
    }
    const int tt = wave >> 1, dh = wave & 1;
    f32x16 acc0, acc1;
#pragma unroll
    for (int r = 0; r < 16; ++r) { acc0[r] = 0.f; acc1[r] = 0.f; }
    {
        const bf16* Cg = WSP(bf16, WS_C) + (size_t)u * 16384;
#pragma unroll
        for (int ks = 0; ks < 8; ++ks) { const bf16x8 a = *(const LAS bf16x8*)(QS + (32 * tt + r32) * 136 + 16 * ks + 8 * hi);
            const bf16x8 b0 = *(const bf16x8*)(Cg + (size_t)(64 * dh + r32) * 128 + 16 * ks + 8 * hi), b1 = *(const bf16x8*)(Cg + (size_t)(64 * dh + 32 + r32) * 128 + 16 * ks + 8 * hi);
            acc0 = MFMA32(a, b0, acc0); acc1 = MFMA32(a, b1, acc1); }
#pragma unroll
        for (int r = 0; r < 16; ++r) { const float at = AT[32 * tt + crow(r, hi)]; acc0[r] *= at; acc1[r] *= at; }
    }
    float den = 0.f;
    const int tg = 32 * tt + r32; const float mmt = MM[tg];
    for (int st = 0; st <= tt; ++st) {
        f32x16 sT;
#pragma unroll
        for (int r = 0; r < 16; ++r) sT[r] = 0.f;
#pragma unroll
        for (int ks = 0; ks < 8; ++ks) { const bf16x8 a = *(const LAS bf16x8*)(KS + (32 * st + r32) * 136 + 16 * ks + 8 * hi); const bf16x8 bq = *(const LAS bf16x8*)(QS + (32 * tt + r32) * 136 + 16 * ks + 8 * hi);
            sT = MFMA32(a, bq, sT); }
        float p[16];
#pragma unroll
        for (int r = 0; r < 16; ++r) { const int s = 32 * st + crow(r, hi); const float wgt = (s <= tg) ? __expf(AA[s] - mmt) : 0.f; p[r] = sT[r] * wgt; den += p[r]; }
#pragma unroll
        for (int s2 = 0; s2 < 2; ++s2) { v4u av; av.x = cvtpk(p[8 * s2], p[8 * s2 + 1]); av.y = cvtpk(p[8 * s2 + 2], p[8 * s2 + 3]); av.z = cvtpk(p[8 * s2 + 4], p[8 * s2 + 5]); av.w = cvtpk(p[8 * s2 + 6], p[8 * s2 + 7]);
            const bf16x8 a = __builtin_bit_cast(bf16x8, av);
#pragma unroll
            for (int d = 0; d < 2; ++d) { const LAS bf16* vp = VT + (64 * dh + 32 * d + r32) * 136 + 32 * st + 16 * s2 + 4 * hi;
                const u32x2 b0 = *(const LAS u32x2*)vp, b1 = *(const LAS u32x2*)(vp + 8);
                v4u bv; bv.x = b0.x; bv.y = b0.y; bv.z = b1.x; bv.w = b1.y; const bf16x8 bb = __builtin_bit_cast(bf16x8, bv);
                if (d == 0) acc0 = MFMA32(a, bb, acc0); else acc1 = MFMA32(a, bb, acc1); } }
    }
    { auto rr = __builtin_amdgcn_permlane32_swap(__float_as_uint(den), __float_as_uint(den), false, false); den = __uint_as_float(rr[0]) + __uint_as_float(rr[1]); }
    __syncthreads();
    if (dh == 0 && hi == 0) { const float dn = AT[tg] * NQ[tg] + den; INV[tg] = 1.0f / fmaxf(fabsf(dn), EM[tg]); }
    __syncthreads();
    {
        const bf16* Og = PROJ + 6 * SLAB + (rowbase + t0) * 512 + hd * 128 + 64 * dh + r32;
        bf16* Out = WSP(bf16, WS_OCAT) + (rowbase + t0) * 1024 + 512 + hd * 128 + 64 * dh + r32;
#pragma unroll
        for (int r = 0; r < 16; ++r) { const int t = 32 * tt + crow(r, hi); const float iv = INV[t];
            const float g0 = sigmoidf_fast(bf_lo((unsigned)Og[(size_t)t * 512])), g1 = sigmoidf_fast(bf_lo((unsigned)Og[(size_t)t * 512 + 32]));
            Out[(size_t)t * 1024] = (bf16)f2bf(acc0[r] * iv * g0); Out[(size_t)t * 1024 + 32] = (bf16)f2bf(acc1[r] * iv * g1); }
    }
    __syncthreads();
}
__device__ __forceinline__ void p7_ln1_tables(Frame& F) {
    const int gw = F.vcu * NWAVES + F.wave, NGW = F.G * NWAVES, lane = F.lane;
    const float* g1 = F.in[12]; const float* b1 = F.in[13];
    f32x4 gv[4], bv[4];
#pragma unroll
    for (int j = 0; j < 4; ++j) { gv[j] = *(const f32x4*)(g1 + 256 * j + 4 * lane); bv[j] = *(const f32x4*)(b1 + 256 * j + 4 * lane); }
    const bf16* MIX = WSP(bf16, WS_PRE1); bf16* H1B = WSP(bf16, WS_H1B); const float* x = F.in[0]; const float* stats = WSP(float, WS_STATS);
    f32x4 g0v[4], b0v[4];
#pragma unroll
    for (int j = 0; j < 4; ++j) { g0v[j] = *(const f32x4*)(F.in[2] + 256 * j + 4 * lane); b0v[j] = *(const f32x4*)(F.in[3] + 256 * j + 4 * lane); }
    f32x4 xn[4]; u32x2 mn4[4]; f32x2 stn = {0.f, 1.f};
    if (gw < M) { stn = *(const f32x2*)(stats + (size_t)gw * 2);
#pragma unroll
        for (int j = 0; j < 4; ++j) { xn[j] = ((const GAS f32x4*)(x + (size_t)gw * DM) + lane)[64 * j]; mn4[j] = ((const GAS u32x2*)(MIX + (size_t)gw * DM) + lane)[64 * j]; } }
    for (int m = gw; m < M; m += NGW) {
        f32x4 xc[4]; u32x2 mc[4]; const f32x2 stc = stn;
#pragma unroll
        for (int j = 0; j < 4; ++j) { xc[j] = xn[j]; mc[j] = mn4[j]; }
        { const int mnx = (m + NGW < M) ? m + NGW : m; stn = *(const f32x2*)(stats + (size_t)mnx * 2);
#pragma unroll
            for (int j = 0; j < 4; ++j) { xn[j] = ((const GAS f32x4*)(x + (size_t)mnx * DM) + lane)[64 * j]; mn4[j] = ((const GAS u32x2*)(MIX + (size_t)mnx * DM) + lane)[64 * j]; } }
        __builtin_amdgcn_sched_barrier(0);
        const float mean0 = stc.x, rstd0 = stc.y;
        f32x4 v[4]; float s = 0.f;
#pragma unroll
        for (int j = 0; j < 4; ++j) { const f32x4 xv = xc[j]; const u32x2 mv = mc[j];
            const f32x4 h0 = (xv - mean0) * rstd0 * g0v[j] + b0v[j];
            v[j].x = ALPHA * h0.x + bf_lo(mv.x); v[j].y = ALPHA * h0.y + bf_hi(mv.x); v[j].z = ALPHA * h0.z + bf_lo(mv.y); v[j].w = ALPHA * h0.w + bf_hi(mv.y);
            s += (v[j].x + v[j].y) + (v[j].z + v[j].w); }
        const float mean = wave_sum(s) * (1.f / DM); float s2 = 0.f;
#pragma unroll
        for (int j = 0; j < 4; ++j) { v[j] = v[j] - mean; s2 += (v[j].x * v[j].x + v[j].y * v[j].y) + (v[j].z * v[j].z + v[j].w * v[j].w); }
        const float rstd = 1.f / sqrtf(wave_sum(s2) * (1.f / DM) + LN_EPS);
        GAS unsigned long long* o8 = (GAS unsigned long long*)(H1B + (size_t)m * DM) + lane;
#pragma unroll
        for (int j = 0; j < 4; ++j) { const f32x4 y = v[j] * rstd * gv[j] + bv[j]; o8[64 * j] = (unsigned long long)pk2(y.x, y.y) | ((unsigned long long)pk2(y.z, y.w) << 32); }
    }
    const size_t nchunk = (size_t)16384 * 1024 / 16, stride = (size_t)F.G * NWAVES * 64;
#pragma unroll 1
    for (int tb = 0; tb < 2; ++tb) { const float* src = F.in[17 + tb]; unsigned char* dst = WSP(unsigned char, tb == 0 ? WS_UT : WS_VT); const float sc = tb == 0 ? U_SCALE : V_SCALE;
        for (size_t i = (size_t)F.vcu * NWAVES * 64 + F.tid; i < nchunk; i += stride) {
            v4u o;
#pragma unroll
            for (int w = 0; w < 4; ++w) { const f32x4 a = *(const GAS f32x4*)(src + i * 16 + w * 4); int pk = 0;
                pk = __builtin_amdgcn_cvt_pk_fp8_f32(a.x * sc, a.y * sc, pk, false); pk = __builtin_amdgcn_cvt_pk_fp8_f32(a.z * sc, a.w * sc, pk, true); o[w] = (unsigned)pk; }
            *(GAS v4u*)(dst + i * 16) = o; } }
}

constexpr int RT_K1 = 0, RT_K2 = 34816, RT_VL = 69632, RT_FL = 102400;
#define CE_DESC(a, b) do { const float hi_ = fmaxf(a, b), lo_ = fminf(a, b); a = hi_; b = lo_; } while (0)
__device__ __forceinline__ void sort16_desc(f32x16& v) {
#pragma unroll
    for (int k = 2; k <= 16; k <<= 1)
#pragma unroll
        for (int j = k >> 1; j > 0; j >>= 1)
#pragma unroll
            for (int i = 0; i < 16; ++i) { const int l = i ^ j; if (l > i) { float a = v[i], b = v[l]; if ((i & k) == 0) { CE_DESC(a, b); } else { CE_DESC(b, a); } v[i] = a; v[l] = b; } }
}
__device__ __forceinline__ void merge16_desc(f32x16& a, const f32x16& b) {
#pragma unroll
    for (int i = 0; i < 16; ++i) a[i] = fmaxf(a[i], b[15 - i]);
#pragma unroll
    for (int j = 8; j > 0; j >>= 1)
#pragma unroll
        for (int i = 0; i < 16; ++i) { const int l = i ^ j; if (l > i) { float x = a[i], y = a[l]; CE_DESC(x, y); a[i] = x; a[l] = y; } }
}
__host__ __device__ constexpr int cand_ij(int n) { int c = 0; for (int i = 0; i < 16; ++i) for (int j = 0; j < 16; ++j) if ((i + 1) * (j + 1) <= 16) { if (c == n) return i * 16 + j; ++c; } return 0; }
__device__ __forceinline__ void p9_route(Frame& F) {
    const int tid = F.tid, lane = F.lane, wave = F.wave, r32 = lane & 31, hi = lane >> 5;
    LAS unsigned char* L = F.lds + RING_OFF;
    for (int i = tid; i < 2 * 128 * 32; i += NWAVES * 64) { const int which = i >> 12, row = (i >> 5) & 127, c4 = (i & 31) * 4;
        const f32x4 a = *(const f32x4*)(F.in[15 + which] + row * 128 + c4);
        u32x2 o; o.x = pk2(a.x, a.y); o.y = pk2(a.z, a.w);
        *(LAS u32x2*)(L + (which ? RT_K2 : RT_K1) + row * 272 + c4 * 2) = o; }
    __syncthreads();
    const bf16* Q = WSP(bf16, WS_Q); int* IDX = WSP(int, WS_IDX); float* GATE = WSP(float, WS_GATE);
    LAS float* VL = (LAS float*)(L + RT_VL) + (wave * 32 + r32) * 32;
    const int gw = F.vcu * NWAVES + wave, NGW = F.G * NWAVES;
    for (int unit = gw; unit < (M / 32) * 8; unit += NGW) {
        const int tg = unit >> 3, hd = unit & 7; const size_t tok = (size_t)tg * 32 + r32;
        const bf16* qp = Q + tok * 2048 + hd * 256;
        f32x16 top[2];
#pragma unroll
        for (int half = 0; half < 2; ++half) {
            f32x16 s0, s1, s2, s3;
#pragma unroll
            for (int r = 0; r < 16; ++r) { s0[r] = 0.f; s1[r] = 0.f; s2[r] = 0.f; s3[r] = 0.f; }
            const LAS unsigned char* KB = L + (half ? RT_K2 : RT_K1);
#pragma unroll
            for (int ks = 0; ks < 8; ++ks) { const bf16x8 bq = *(const bf16x8*)(qp + half * 128 + ks * 16 + hi * 8);
                const LAS unsigned char* ka = KB + r32 * 272 + (16 * ks + 8 * hi) * 2;
                s0 = MFMA32(*(const LAS bf16x8*)(ka), bq, s0); s1 = MFMA32(*(const LAS bf16x8*)(ka + 32 * 272), bq, s1);
                s2 = MFMA32(*(const LAS bf16x8*)(ka + 64 * 272), bq, s2); s3 = MFMA32(*(const LAS bf16x8*)(ka + 96 * 272), bq, s3); }
#pragma unroll
            for (int r = 0; r < 16; ++r) { const unsigned key = (unsigned)crow(r, hi);
                s0[r] = __uint_as_float((__float_as_uint(s0[r]) & ~127u) | key); s1[r] = __uint_as_float((__float_as_uint(s1[r]) & ~127u) | (key + 32u));
                s2[r] = __uint_as_float((__float_as_uint(s2[r]) & ~127u) | (key + 64u)); s3[r] = __uint_as_float((__float_as_uint(s3[r]) & ~127u) | (key + 96u)); }
            sort16_desc(s0); sort16_desc(s1); sort16_desc(s2); sort16_desc(s3);
            merge16_desc(s0, s1); merge16_desc(s2, s3); merge16_desc(s0, s2);
            f32x16 pa, pb;
#pragma unroll
            for (int i = 0; i < 16; ++i) { auto rr = __builtin_amdgcn_permlane32_swap(__float_as_uint(s0[i]), __float_as_uint(s0[i]), false, false); pa[i] = __uint_as_float(rr[0]); pb[i] = __uint_as_float(rr[1]); }
            merge16_desc(pa, pb);
            top[half] = pa;
        }
        if (hi == 0) {
#pragma unroll
            for (int i = 0; i < 16; ++i) { VL[i] = top[0][i]; VL[16 + i] = top[1][i]; } }
        float l1[16], l2[16];
#pragma unroll
        for (int i = 0; i < 16; ++i) { l1[i] = __uint_as_float(__float_as_uint(top[0][i]) & ~127u); l2[i] = __uint_as_float(__float_as_uint(top[1][i]) & ~127u); }
        f32x16 c0, c1, c2, c3;
        {
            int n = 0;
#pragma unroll
            for (int i = 0; i < 16; ++i)
#pragma unroll
                for (int j = 0; j < 16; ++j) if ((i + 1) * (j + 1) <= 16) { const float cv = __uint_as_float((__float_as_uint(l1[i] + l2[j]) & ~255u) | (unsigned)(i * 16 + j));
                    if (n < 16) c0[n & 15] = cv; else if (n < 32) c1[n & 15] = cv; else if (n < 48) c2[n & 15] = cv; else c3[n & 15] = cv; ++n; }
        }
#pragma unroll
        for (int m = 2; m < 16; ++m) c3[m] = -INFINITY;
        sort16_desc(c0); sort16_desc(c1); sort16_desc(c2); sort16_desc(c3);
        merge16_desc(c0, c1); merge16_desc(c2, c3); merge16_desc(c0, c2);
        const f32x16 fa = c0;
        const float topv = __uint_as_float(__float_as_uint(fa[0]) & ~255u);
        float esum = 0.f, ev[8]; int ex[8];
#pragma unroll
        for (int k = 0; k < 16; ++k) { const unsigned bits = __float_as_uint(fa[k]); const float e = __expf(__uint_as_float(bits & ~255u) - topv); esum += e;
            if ((k >> 3) == hi) { ev[k & 7] = e; const int ci = (bits >> 4) & 15, cj = bits & 15;
                ex[k & 7] = (int)((__float_as_uint(VL[ci]) & 127u) * 128u + (__float_as_uint(VL[16 + cj]) & 127u)); } }
        const float inv = 1.0f / esum;
        int* ip = IDX + tok * 128 + hd * 16 + hi * 8; float* gp = GATE + tok * 128 + hd * 16 + hi * 8;
        *(int4*)ip = make_int4(ex[0], ex[1], ex[2], ex[3]); *(int4*)(ip + 4) = make_int4(ex[4], ex[5], ex[6], ex[7]);
        *(f32x4*)gp = (f32x4){ev[0] * inv, ev[1] * inv, ev[2] * inv, ev[3] * inv}; *(f32x4*)(gp + 4) = (f32x4){ev[4] * inv, ev[5] * inv, ev[6] * inv, ev[7] * inv};
    }
    __syncthreads();
}

__device__ __forceinline__ float gelu_erf(float x) { return 0.5f * x * (1.0f + erff(x * 0.70710678118654752f)); }
__device__ __forceinline__ float dot16_fp8(const v4u& u, const float (&h)[16], float acc) {
    f32x2 a2 = {acc, 0.f};
#pragma unroll
    for (int w = 0; w < 4; ++w) { const f32x2 a = __builtin_amdgcn_cvt_pk_f32_fp8((int)u[w], false), b = __builtin_amdgcn_cvt_pk_f32_fp8((int)u[w], true);
        a2 = __builtin_elementwise_fma(a, (f32x2){h[4 * w], h[4 * w + 1]}, a2); a2 = __builtin_elementwise_fma(b, (f32x2){h[4 * w + 2], h[4 * w + 3]}, a2); }
    return a2.x + a2.y;
}
__device__ __forceinline__ void axpy16_fp8(float (&acc)[16], const v4u& v, float c) {
#pragma unroll
    for (int w = 0; w < 4; ++w) { const f32x2 a = __builtin_amdgcn_cvt_pk_f32_fp8((int)v[w], false), b = __builtin_amdgcn_cvt_pk_f32_fp8((int)v[w], true);
        acc[4 * w] = fmaf(c, a.x, acc[4 * w]); acc[4 * w + 1] = fmaf(c, a.y, acc[4 * w + 1]); acc[4 * w + 2] = fmaf(c, b.x, acc[4 * w + 2]); acc[4 * w + 3] = fmaf(c, b.y, acc[4 * w + 3]); }
}
__device__ __forceinline__ void unpack16(const v4u& a, const v4u& b, float (&h)[16]) {
    h[0] = bf_lo(a.x); h[1] = bf_hi(a.x); h[2] = bf_lo(a.y); h[3] = bf_hi(a.y); h[4] = bf_lo(a.z); h[5] = bf_hi(a.z); h[6] = bf_lo(a.w); h[7] = bf_hi(a.w);
    h[8] = bf_lo(b.x); h[9] = bf_hi(b.x); h[10] = bf_lo(b.y); h[11] = bf_hi(b.y); h[12] = bf_lo(b.z); h[13] = bf_hi(b.z); h[14] = bf_lo(b.w); h[15] = bf_hi(b.w);
}
__device__ __forceinline__ float gelu_as(float v) {
    const float av = fabsf(v), t = __builtin_amdgcn_rcpf(fmaf(av, 0.2316418882f, 1.0f));
    float q = fmaf(t, 0.5307027145f, -0.7265760135f); q = fmaf(q, t, 0.7107068705f); q = fmaf(q, t, -0.142248368f); q = fmaf(q, t, 0.127414796f); q = q * t;
    const float e = __builtin_amdgcn_exp2f(v * v * -0.72134752044f), m = v * (q * e);
    return v < 0.f ? m : v - m;
}
#ifndef P10_TPW_DEF
#define P10_TPW_DEF 4
#endif
constexpr int P10_TPW = P10_TPW_DEF, P10_NS = 16, P10_SH = 10;
constexpr int P10_WB = 13056, P10_SIDX = 0, P10_SCF = 2048, P10_HB = 4096, P10_DESC = 12288;
#define P10_DECODE(D, T_, J_, N_) const int T_ = (D) & 3, J_ = ((D) >> 2) & 127, N_ = (D) >> 9
#define P10_ROWS(RS, BUF, DD, I) const int DD##n_ = __builtin_amdgcn_readfirstlane(DESC[(I)]); DD = DD##n_; P10_DECODE(DD##n_, t_, j_, n_); \
        const int ev_ = SIDX[t_ * 128 + j_ + min(lane & 7, max(n_ - 1, 0))]; \
        _Pragma("unroll") for (int k = 0; k < 8; ++k) { const int e_ = __builtin_amdgcn_readlane(ev_, k); BUF[k] = __builtin_bit_cast(v4u, __builtin_amdgcn_raw_buffer_load_b128(RS, voff, e_ * 1024, 0)); }
#define P10_ISSUE_U(BUF, DD, H0, H1, GG, I) do { P10_ROWS(rsU, BUF, DD, I) \
        { const LAS v4u* hp = (const LAS v4u*)(HB + t_ * 1024) + 2 * lane; H0 = hp[0]; H1 = hp[1]; } \
        GG = SCF[t_ * 128 + j_ + min(lane >> 3, max(n_ - 1, 0))]; } while (0)
#define P10_COMP_U(BUF, DD, H0, H1, GG) do { P10_DECODE(DD, t_, j_, n_); \
        float h[16]; unpack16(H0, H1, h); \
        float d[8]; _Pragma("unroll") for (int k = 0; k < 8; ++k) d[k] = dot16_fp8(BUF[k], h, 0.f); \
        const float c0 = reduce8_transposed(d, up16, up8); \
        const float act = gelu_as(c0 * (1.0f / U_SCALE)) * (1.0f / V_SCALE);       \
        if ((lane & 7) == 0 && (lane >> 3) < n_) SCF[t_ * 128 + j_ + (lane >> 3)] = GG * act; } while (0)
#define P10_ISSUE_V(BUF, DD, CV, I) do { P10_ROWS(rsV, BUF, DD, I) \
        CV = SCF[t_ * 128 + j_ + min(lane & 7, max(n_ - 1, 0))]; } while (0)
#define P10_AXPY8(ACC, BUF, CV) do { _Pragma("unroll") for (int k = 0; k < 8; ++k) { const float ck = (k < n_) ? __uint_as_float(__builtin_amdgcn_readlane(__float_as_uint(CV), k)) : 0.f; axpy16_fp8(ACC, BUF[k], ck); } } while (0)
#define P10_COMP_V(BUF, DD, CV) do { P10_DECODE(DD, t_, j_, n_); (void)j_; \
        if (t_ == 0) P10_AXPY8(acc[0], BUF, CV); else if (t_ == 1) P10_AXPY8(acc[1], BUF, CV); else if (t_ == 2) P10_AXPY8(acc[2], BUF, CV); else P10_AXPY8(acc[3], BUF, CV); } while (0)
#define P10_SB __builtin_amdgcn_sched_barrier(0)
template <int MODE> __device__ __forceinline__ void p10_experts(Frame& F, float* outp) {
    const int lane = F.lane;
    const bf16* H1B = WSP(bf16, WS_H1B); const bf16* PLE = WSP(bf16, WS_PLE); const int* IDX = WSP(int, WS_IDX); const float* GATE = WSP(float, WS_GATE);
    const auto rsU = __builtin_amdgcn_make_buffer_rsrc((void*)WSP(unsigned char, WS_UT), 0, 16384 * 1024, 0x00020000);
    const auto rsV = __builtin_amdgcn_make_buffer_rsrc((void*)WSP(unsigned char, WS_VT), 0, 16384 * 1024, 0x00020000);
    const int voff = lane * 16;
    const float* g2 = F.in[21]; const float* b2 = F.in[22];
    const bool up16 = (lane & 16) != 0, up8 = (lane & 8) != 0;
    LAS unsigned char* LW = F.lds + RING_OFF + F.wave * P10_WB;
    LAS int* SIDX = (LAS int*)(LW + P10_SIDX); LAS float* SCF = (LAS float*)(LW + P10_SCF); LAS bf16* HB = (LAS bf16*)(LW + P10_HB); LAS int* DESC = (LAS int*)(LW + P10_DESC);
    constexpr int TPB = NWAVES * P10_TPW;
    for (int blk = F.vcu; blk < M / TPB; blk += F.G) {
        const int tok0 = blk * TPB + F.wave * P10_TPW;
        int seg[P10_TPW][P10_NS + 1];
#pragma unroll
        for (int t = 0; t < P10_TPW; ++t) { const size_t tk = (size_t)(tok0 + t);
            const int i0 = IDX[tk * 128 + lane], i1 = IDX[tk * 128 + 64 + lane]; const float g0 = GATE[tk * 128 + lane], g1 = GATE[tk * 128 + 64 + lane];
            { const v4u* hp = (const v4u*)(H1B + tk * 1024) + 2 * lane; LAS v4u* hd = (LAS v4u*)(HB + t * 1024) + 2 * lane; hd[0] = hp[0]; hd[1] = hp[1]; }
            const int k0 = i0 >> P10_SH, k1 = i1 >> P10_SH; int r0 = 0, r1 = 0, base = 0;
#pragma unroll
            for (int k = 0; k < P10_NS; ++k) { const unsigned long long b0 = __ballot(k0 == k), b1 = __ballot(k1 == k);
                const int below0 = (int)__builtin_amdgcn_mbcnt_hi((unsigned)(b0 >> 32), __builtin_amdgcn_mbcnt_lo((unsigned)b0, 0u)), below1 = (int)__builtin_amdgcn_mbcnt_hi((unsigned)(b1 >> 32), __builtin_amdgcn_mbcnt_lo((unsigned)b1, 0u));
                const int n0 = __builtin_popcountll(b0), n1 = __builtin_popcountll(b1);
                r0 = (k0 == k) ? base + below0 : r0; r1 = (k1 == k) ? base + n0 + below1 : r1; seg[t][k] = base; base += n0 + n1; }
            seg[t][P10_NS] = base;
            SIDX[t * 128 + r0] = i0; SCF[t * 128 + r0] = g0; SIDX[t * 128 + r1] = i1; SCF[t * 128 + r1] = g1; }
        int nd = 0;
#pragma unroll
        for (int s = 0; s < P10_NS; ++s)
#pragma unroll
            for (int t = 0; t < P10_TPW; ++t) { for (int c = (seg[t][s] + 7) >> 3; c < (seg[t][s + 1] + 7) >> 3; ++c) { if (lane == 0) DESC[nd] = t | ((8 * c) << 2) | (8 << 9); ++nd; } }
        if (lane < 3) DESC[nd + lane] = 0;
        const int ndp = (nd + 1) & ~1;
        v4u BA[8], BB[8];
        {
            int dA, dB; v4u hA0, hA1, hB0, hB1; float gA, gB;
            P10_ISSUE_U(BA, dA, hA0, hA1, gA, 0); P10_SB;
#pragma unroll 1
            for (int i = 0; i < ndp; i += 2) {
                P10_ISSUE_U(BB, dB, hB0, hB1, gB, i + 1); P10_SB;
                P10_COMP_U(BA, dA, hA0, hA1, gA); P10_SB;
                P10_ISSUE_U(BA, dA, hA0, hA1, gA, i + 2); P10_SB;
                P10_COMP_U(BB, dB, hB0, hB1, gB); P10_SB;
            }
        }
        float acc[4][16];
#pragma unroll
        for (int t = 0; t < 4; ++t)
#pragma unroll
            for (int i = 0; i < 16; ++i) acc[t][i] = 0.f;
        {
            int dA, dB; float cA, cB;
            P10_ISSUE_V(BA, dA, cA, 0); P10_SB;
#pragma unroll 1
            for (int i = 0; i < ndp; i += 2) {
                P10_ISSUE_V(BB, dB, cB, i + 1); P10_SB;
                P10_COMP_V(BA, dA, cA); P10_SB;
                P10_ISSUE_V(BA, dA, cA, i + 2); P10_SB;
                P10_COMP_V(BB, dB, cB); P10_SB;
            }
        }
#pragma unroll
        for (int t = 0; t < P10_TPW; ++t) { const int tok = tok0 + t;
            float h[16], pl[16];
            { const LAS v4u* hp = (const LAS v4u*)(HB + t * 1024) + 2 * lane; const v4u x0_ = hp[0], x1_ = hp[1]; unpack16(x0_, x1_, h); }
            { const v4u* pp = (const v4u*)(PLE + (size_t)tok * 1024) + 2 * lane; unpack16(pp[0], pp[1], pl); }
            float y[16]; float sm = 0.f;
#pragma unroll
            for (int i = 0; i < 16; ++i) { y[i] = ALPHA * h[i] + acc[t][i] + pl[i]; sm += y[i]; }
            const float mean = wave_sum(sm) * (1.f / DM); float s2 = 0.f;
#pragma unroll
            for (int i = 0; i < 16; ++i) { y[i] -= mean; s2 += y[i] * y[i]; }
            const float rstd = 1.f / sqrtf(wave_sum(s2) * (1.f / DM) + LN_EPS);
            float* op = outp + (size_t)tok * 1024 + 16 * lane; const float* gp = g2 + 16 * lane; const float* bp = b2 + 16 * lane;
#pragma unroll
            for (int q = 0; q < 4; ++q) { const f32x4 ga = *(const f32x4*)(gp + 4 * q), ba = *(const f32x4*)(bp + 4 * q); f32x4 o;
                o.x = y[4 * q] * rstd * ga.x + ba.x; o.y = y[4 * q + 1] * rstd * ga.y + ba.y; o.z = y[4 * q + 2] * rstd * ga.z + ba.z; o.w = y[4 * q + 3] * rstd * ga.w + ba.w;
                *(f32x4*)(op + 4 * q) = o; }
        }
    }
}
struct Args { const float* in[23]; float* out; unsigned char* ws; int ph_lo, ph_hi, li, pad; };
__global__ void __launch_bounds__(NWAVES * 64, 2) fwd_kernel(Args args) {
    extern __shared__ __attribute__((aligned(16))) unsigned char lds[];
    Frame F;
    F.lds = (LAS unsigned char*)lds;
    F.MISC = (volatile LAS unsigned*)(F.lds + MISC_OFF);
    F.tid = threadIdx.x; F.lane = F.tid & 63; F.wave = __builtin_amdgcn_readfirstlane(F.tid >> 6);
    F.G = gridDim.x; { const int bx = blockIdx.x; F.vcu = (F.G % 8 == 0) ? (bx % 8) * (F.G / 8) + bx / 8 : bx; }
    F.ws = args.ws; F.out = args.out; F.in = args.in;
    F.ctl = (gu32*)(F.ws + WS_CTL);
    for (int u = F.tid; u < (LDS_BYTES - LDSCTL_OFF) / 4; u += NWAVES * 64) ((LAS unsigned*)(F.lds + LDSCTL_OFF))[u] = 0u;
    __syncthreads();
    XcdBarrier bar; bar.bar = (unsigned*)(F.ctl + CW_BAR); bar.x = 0; bar.st = nullptr;
    if (N_LAUNCHES == 1) bar = xcd_barrier_post((unsigned*)(F.ctl + CW_BAR), F.MISC + 8);
#ifdef PROBE_BAR2
#define GRID_BAR() do { if (N_LAUNCHES == 1) { xcd_barrier(bar); xcd_barrier(bar); } } while (0)
#else
#define GRID_BAR() do { if (N_LAUNCHES == 1) xcd_barrier(bar); } while (0)
#endif
    const int lo = args.ph_lo, hi = args.ph_hi;
#ifndef PH_MASK
#define PH_MASK 0x7ff
#endif
#define IN(k) (((PH_MASK >> (k)) & 1) && lo <= (k) && (k) < hi)
#define BOTH(k) (IN(k) && IN((k) + 1))
#ifndef REP_MASK
#define REP_MASK 0
#endif
#define REPS(k) for (int rep_ = 0; rep_ < 1 + ((REP_MASK >> (k)) & 1); ++rep_)
    const int bx = (int)blockIdx.x;

    if (IN(0)) { p0_prologue(F);
#ifdef PROBE_P0
        __syncthreads(); p0_prologue(F);
#endif
        if (BOTH(0)) GRID_BAR(); }

    if (IN(1)) {
        { pg8::Gemm g{WSP(bf16, WS_XN), WSP(bf16, WS_WIN_T), M, NPROJ, DM}; pg8::StaticOrder S; S.init(M, NPROJ, F.G, bx);
          pg8::EpiBf16<0> E{WSP(bf16, WS_PROJ), 512, nullptr, 512, SLAB, C2};
          pg8::gemm_phase<pg8::EpiBf16<0>, pg8::StaticOrder, PG8_ALIGN, PG8_SP2>(F.lds + RING_OFF, g, S, E); }
#ifdef PROBE_P1
        { pg8::Gemm g{WSP(bf16, WS_XN), WSP(bf16, WS_WIN_T), M, NPROJ, DM}; pg8::StaticOrder S; S.init(M, NPROJ, F.G, bx);
          pg8::EpiBf16<PROBE_P1> E{WSP(bf16, WS_PROJ), 512, nullptr, 512, SLAB, C2};
          pg8::gemm_phase<pg8::EpiBf16<PROBE_P1>, pg8::StaticOrder, PG8_ALIGN, PG8_SP2>(F.lds + RING_OFF, g, S, E); }
#endif
        if (BOTH(1)) GRID_BAR();
    }

    if (IN(2)) {
#define P2_ATTN() do { if (F.G == 256) { const int bh = F.vcu >> 3, s = F.vcu & 7; \
            for (int i = 0; i < 4; ++i) { const int qb = (i == 0) ? s : (i == 1) ? 15 - s : (i == 2) ? 16 + s : 31 - s; attn_unit(F, bh, qb); } } \
        else { for (int u = F.vcu; u < 1024; u += F.G) attn_unit(F, u >> 5, u & 31); } } while (0)
#define P2_MLA() do { for (int u = F.vcu; u < N_MLU; u += F.G) mla_unit(F, u); } while (0)
        P2_ATTN();
#ifdef PROBE_P2A
        P2_ATTN();
#endif
        P2_MLA();
#ifdef PROBE_P2B
        P2_MLA();
#endif
        if (BOTH(2)) GRID_BAR();
    }

    if (IN(3)) { for (int it = F.vcu; it < 256; it += F.G) ml_scan_item(F, it);
#ifdef PROBE_P3
        for (int it = F.vcu; it < 256; it += F.G) ml_scan_item(F, it, WS_Y);
#endif
        if (BOTH(3)) GRID_BAR(); }

    if (IN(4)) { REPS(4) for (int u = F.vcu; u < N_MLU; u += F.G) mlc_unit(F, u); if (BOTH(4)) GRID_BAR(); }

    if (IN(5)) {
        pg8::Gemm g{WSP(bf16, WS_OCAT), WSP(bf16, WS_WSB_T), M, DM, DM}; pg8::StaticOrder S; S.init(M, DM, F.G, bx);
        pg8::EpiGate2 E{WSP(bf16, WS_Y), WSP(bf16, WS_PROJ) + 7 * SLAB, WSP(bf16, WS_PROJ) + 9 * SLAB};
        pg8::gemm_phase<pg8::EpiGate2, pg8::StaticOrder, PG8_ALIGN, PG8_SP2>(F.lds + RING_OFF, g, S, E);
        if (BOTH(5)) GRID_BAR();
    }

    if (IN(6)) {
#define P6_OUTPROJ() do { pg8::Gemm g{WSP(bf16, WS_Y), WSP(bf16, WS_WOUT_T), M, DM, DM}; pg8::StaticOrder S; S.init(M, DM, F.G, bx); \
          pg8::EpiBf16<0> E{WSP(bf16, WS_PRE1), DM, nullptr, 0, 0, 1.f}; \
          pg8::gemm_phase<pg8::EpiBf16<0>, pg8::StaticOrder, PG8_ALIGN, PG8_SP2>(F.lds + RING_OFF, g, S, E); } while (0)
#define P6_PLE() do { pg8::Gemm g{WSP(bf16, WS_PB), WSP(bf16, WS_WPLE_T), M, DM, 256}; pg8::StaticOrder S; S.init(M, DM, F.G, bx); \
          pg8::EpiBf16<0> E{WSP(bf16, WS_PLE), DM, nullptr, 0, 0, 1.f}; \
          pg8::gemm_phase<pg8::EpiBf16<0>, pg8::StaticOrder, PG8_ALIGN, PG8_SP2>(F.lds + RING_OFF, g, S, E); } while (0)
        P6_OUTPROJ(); P6_PLE();
#ifdef PROBE_P6A
        P6_OUTPROJ();
#endif
#ifdef PROBE_P6B
        P6_PLE();
#endif
        if (BOTH(6)) GRID_BAR();
    }

    if (IN(7)) { REPS(7) p7_ln1_tables(F); if (BOTH(7)) GRID_BAR(); }

    if (IN(8)) {
        pg8::Gemm g{WSP(bf16, WS_H1B), WSP(bf16, WS_WQG_T), M, 3072, DM}; pg8::StaticOrder S; S.init(M, 3072, F.G, bx);
        pg8::EpiQG E{WSP(bf16, WS_Q), WSP(bf16, WS_PLE)};
        pg8::gemm_phase<pg8::EpiQG, pg8::StaticOrder, PG8_ALIGN, PG8_SP2>(F.lds + RING_OFF, g, S, E);
        if (BOTH(8)) GRID_BAR();
    }

    if (IN(9)) { REPS(9) p9_route(F); if (BOTH(9)) GRID_BAR(); }

    if (IN(10)) { p10_experts<0>(F, F.out);
#ifdef PROBE_P10
        p10_experts<PROBE_P10>(F, WSP(float, WS_PRE1));
#endif
    }
#undef IN
#undef BOTH
#undef GRID_BAR
}

extern "C" void kernel_launch(void* const* d_in, const int* in_sizes, int n_in, void* d_out, int out_size, void* d_ws, size_t ws_size, hipStream_t stream) {
    static int grid = 0;
    if (grid == 0) {
        if (n_in != 23 || in_sizes[0] != M * DM || out_size != M * DM || ws_size < WS_END) {
            fprintf(stderr, "kernel_launch: built for 23 inputs, x/out of %d floats, >= %zu bytes of workspace; got n_in %d, in0 %d, out %d, ws %zu; nothing launched\n", M * DM, (size_t)WS_END, n_in, n_in > 0 ? in_sizes[0] : -1, out_size, ws_size);
            grid = -1; return; }
        int dev = 0, cus = 0;
        if (hipGetDevice(&dev) != hipSuccess || hipDeviceGetAttribute(&cus, hipDeviceAttributeMultiprocessorCount, dev) != hipSuccess) { fprintf(stderr, "kernel_launch: device query failed\n"); grid = -1; return; }
        if (hipFuncSetAttribute((const void*)fwd_kernel, hipFuncAttributeMaxDynamicSharedMemorySize, LDS_BYTES) != hipSuccess) { fprintf(stderr, "kernel_launch: hipFuncSetAttribute failed\n"); grid = -1; return; }
        int per_cu = 0;
        if (hipOccupancyMaxActiveBlocksPerMultiprocessor(&per_cu, (const void*)fwd_kernel, NWAVES * 64, LDS_BYTES) != hipSuccess || per_cu < 1)
            fprintf(stderr, "kernel_launch: note: occupancy query reports %d workgroups per CU\n", per_cu);
        (void)hipGetLastError();
        grid = cus;
    }
    if (grid < 0) return;
    if (hipMemsetAsync((char*)d_ws + WS_CTL, 0, CTL_ZERO_BYTES, stream) != hipSuccess) { fprintf(stderr, "kernel_launch: hipMemsetAsync failed\n"); return; }
    Args a{};
    for (int i = 0; i < 23; ++i) a.in[i] = (const float*)d_in[i];
    a.out = (float*)d_out; a.ws = (unsigned char*)d_ws;
    for (int li = 0; li < N_LAUNCHES; ++li) {
        if (N_LAUNCHES == 1) { a.ph_lo = 0; a.ph_hi = N_PHASES; } else { a.ph_lo = li; a.ph_hi = li + 1; }
        a.li = li;
        hipLaunchKernelGGL(fwd_kernel, dim3(grid), dim3(NWAVES * 64), LDS_BYTES, stream, a);
        const hipError_t le = hipPeekAtLastError();
        if (le != hipSuccess) { fprintf(stderr, "kernel_launch: launch %d failed: %s\n", li, hipGetErrorName(le)); break; }
    }
}
```

```cpp
#include <hip/hip_runtime.h>
#include <cstdio>
#include <cstdint>
#include <cmath>
namespace pg8 {
#define PG8_LAS __attribute__((address_space(3)))
typedef unsigned short bf16_t;
typedef short bf16x8 __attribute__((ext_vector_type(8)));
typedef float f32x4 __attribute__((ext_vector_type(4)));
typedef unsigned u32x4 __attribute__((ext_vector_type(4)));
constexpr int BM = 256, BK = 64, HALF = 128, HTB = HALF * BK * 2  , STAGE_BYTES = 8 * HTB, NXCD = 8, WGM = 8;

__host__ __device__ __forceinline__ int lds_byte(int r, int c) { const int st = (r >> 4) * 2 + (c >> 5), rr = r & 15, cc = c & 31, ob = rr * 64 + cc * 2; return st * 1024 + (ob ^ (((ob >> 9) & 1) << 5)); }
__host__ __device__ __forceinline__ void stage_rc(int b, int& R, int& C) { const int st = b / 1024, sb = b % 1024, swz = sb ^ (((sb >> 9) & 1) << 5); R = (st >> 1) * 16 + swz / 64; C = (st & 1) * 32 + (swz % 64) / 2; }
__host__ __device__ __forceinline__ int perm32(int rho) { const int n = rho >> 4, i = rho & 15; return 8 * (i >> 2) + 4 * n + (i & 3); }

struct Unit { int pm, pn; };
struct Gemm { const bf16_t* A; const bf16_t* Bt; int M, N, K; };

struct StaticOrder {
    int nM, nN, nwg, G, c;
    __host__ __device__ void init(int M, int N, int G_, int c_) { nM = M / BM; nN = N / BM; nwg = nM * nN; G = G_; c = c_; }
    __host__ __device__ bool next(int i, Unit& u) const {
        const long L = (long)i * G + c; if (L >= nwg) return false;
        int wgid = (int)L; { const int q = nwg / NXCD, r = nwg % NXCD, xcd = wgid % NXCD, off = wgid / NXCD; wgid = (xcd < r ? xcd * (q + 1) : r * (q + 1) + (xcd - r) * q) + off; }
        const int nig = WGM * nN, gid = wgid / nig, fm = gid * WGM, gsz = (nM - fm) < WGM ? (nM - fm) : WGM;
        u.pm = fm + ((wgid % nig) % gsz); u.pn = (wgid % nig) / gsz; return true;
    }
    __device__ __forceinline__ void a_ready(const Unit&) const {}
    __device__ __forceinline__ void done(const Unit&) const {}
};

__device__ __forceinline__ unsigned cvt_pk_bf16(float lo, float hi) { unsigned r; asm volatile("v_cvt_pk_bf16_f32 %0, %1, %2" : "=v"(r) : "v"(lo), "v"(hi)); return r; }
typedef float f32x2 __attribute__((ext_vector_type(2)));
__device__ __forceinline__ f32x2 gelu_pk(f32x2 v) {
    const f32x2 av = __builtin_elementwise_abs(v), d = av * 0.2316418882f + 1.0f;
    f32x2 t; t.x = __builtin_amdgcn_rcpf(d.x); t.y = __builtin_amdgcn_rcpf(d.y);
    f32x2 q = t * 0.5307027145f + (-0.7265760135f); q = q * t + 0.7107068705f; q = q * t + (-0.142248368f); q = q * t + 0.127414796f; q = q * t;
    const f32x2 s = (v * v) * (-0.72134752044f);
    f32x2 e; e.x = __builtin_amdgcn_exp2f(s.x); e.y = __builtin_amdgcn_exp2f(s.y);
    const f32x2 m = v * (q * e), r = v - m;
    f32x2 o; o.x = v.x < 0.f ? m.x : r.x; o.y = v.y < 0.f ? m.y : r.y; return o;
}

template <int ACT  > struct EpiBf16 {
    static constexpr bool PERM = true, AFTER_DRAIN = false; static constexpr int MID_T = -1; static_assert(ACT == 0 || ACT == 1 || ACT == 7, "EpiBf16: ACT is 0 (none) or 1 (gelu_pk); 7 = timing probe without stores");
    bf16_t* O; int ldc; const float* bias; int split_cols; size_t split_stride; float scale0;
    __device__ __forceinline__ void operator()(const f32x4 (&acc)[2][2][4][2], const Unit& u, int wr, int wc, int fr, int fq) const {
        const int row0 = u.pm * BM + wr * 64 + fr; int colt = u.pn * BM; bf16_t* base = O;
        float sc = 1.f; if (split_cols) { const int t = colt / split_cols; base += (size_t)t * split_stride; colt -= t * split_cols; if (t == 0) sc = scale0; }
        const int col0 = colt + wc * 32 + 8 * fq, bcol0 = u.pn * BM + wc * 32 + 8 * fq;
        f32x4 bv[2][2];
#pragma unroll
        for (int bj = 0; bj < 2; ++bj)
#pragma unroll
            for (int n = 0; n < 2; ++n) bv[bj][n] = bias ? *(const f32x4*)(bias + bcol0 + bj * HALF + 4 * n) : (f32x4){0.f, 0.f, 0.f, 0.f};
#pragma unroll
        for (int ai = 0; ai < 2; ++ai)
#pragma unroll
            for (int m = 0; m < 4; ++m) { bf16_t* rowp = base + (size_t)(row0 + ai * HALF + m * 16) * ldc + col0;
#pragma unroll
                for (int bj = 0; bj < 2; ++bj) { f32x4 v0 = acc[ai][bj][m][0] + bv[bj][0], v1 = acc[ai][bj][m][1] + bv[bj][1];
                    if (ACT == 1) { f32x2 a = gelu_pk((f32x2){v0[0], v0[1]}), b = gelu_pk((f32x2){v0[2], v0[3]}), c = gelu_pk((f32x2){v1[0], v1[1]}), d = gelu_pk((f32x2){v1[2], v1[3]});
                        v0 = (f32x4){a.x, a.y, b.x, b.y}; v1 = (f32x4){c.x, c.y, d.x, d.y}; }
                    v0 = v0 * sc; v1 = v1 * sc; u32x4 w; w.x = cvt_pk_bf16(v0[0], v0[1]); w.y = cvt_pk_bf16(v0[2], v0[3]); w.z = cvt_pk_bf16(v1[0], v1[1]); w.w = cvt_pk_bf16(v1[2], v1[3]);
                    if (ACT != 7 || u.pm < 0) *(u32x4*)(rowp + bj * HALF) = w; } }
    }
};

struct PanelStats {
    unsigned* xbuf;
    unsigned* cnt;
    unsigned* tmo;
    int ntn; float eps;
    unsigned code;
    __device__ __forceinline__ bool run(const f32x4 (&v)[2][2][4][2], const Unit& u, int wr, int wc, int fr, int fq, PG8_LAS unsigned char* lds, int wid, int lane) const {
        typedef float f32x2v __attribute__((ext_vector_type(2)));
        PG8_LAS f32x2v* P = (PG8_LAS f32x2v*)lds;
        PG8_LAS f32x2v* S = (PG8_LAS f32x2v*)(lds + 8192);
        PG8_LAS unsigned* flag = (PG8_LAS unsigned*)(lds + 8192 + 2048);
#pragma unroll
        for (int ai = 0; ai < 2; ++ai)
#pragma unroll
            for (int m = 0; m < 4; ++m) {
                float s = 0.f;
#pragma unroll
                for (int bj = 0; bj < 2; ++bj)
#pragma unroll
                    for (int n = 0; n < 2; ++n) { const f32x4 x = v[ai][bj][m][n]; s += (x[0] + x[1]) + (x[2] + x[3]); }
                s += __shfl_xor(s, 16); s += __shfl_xor(s, 32);
                const float mw = s * (1.0f / 64.0f); float q = 0.f;
#pragma unroll
                for (int bj = 0; bj < 2; ++bj)
#pragma unroll
                    for (int n = 0; n < 2; ++n) { const f32x4 d = v[ai][bj][m][n] - mw; q += (d[0] * d[0] + d[1] * d[1]) + (d[2] * d[2] + d[3] * d[3]); }
                q += __shfl_xor(q, 16); q += __shfl_xor(q, 32);
                if (fq == 0) P[(ai * HALF + wr * 64 + m * 16 + fr) * 4 + wc] = (f32x2v){mw, q};
            }
        asm volatile("s_waitcnt lgkmcnt(0)" ::: "memory"); __builtin_amdgcn_s_barrier(); asm volatile("" ::: "memory");
#if defined(BROKEN_EXCHANGE_NO_WAIT)
#warning BROKEN CONTROL BUILD: the row-statistics exchange does not wait; results are wrong by design
        if (blockIdx.x >= 64) { const long long t0_ = clock64(); while (clock64() - t0_ < 60000) __builtin_amdgcn_s_sleep(8); }
#endif
        const int row = wid * 32 + (lane & 31);
        if (lane < 32) {
            const f32x2v a = P[row * 4 + 0], b = P[row * 4 + 1], c = P[row * 4 + 2], d = P[row * 4 + 3];
            const float mt = (a.x + b.x + c.x + d.x) * 0.25f;
            const float da = a.x - mt, db = b.x - mt, dc = c.x - mt, dd = d.x - mt;
            const float m2 = (a.y + b.y) + (c.y + d.y) + 64.0f * ((da * da + db * db) + (dc * dc + dd * dd));
            unsigned long long* slot = (unsigned long long*)xbuf + ((size_t)(u.pm * BM + row) * 4 + u.pn);
            __hip_atomic_store(slot, ((unsigned long long)__float_as_uint(m2) << 32) | __float_as_uint(mt), __ATOMIC_RELAXED, __HIP_MEMORY_SCOPE_AGENT);
        }
        asm volatile("s_waitcnt vmcnt(0)" ::: "memory");
        if (lane == 0) __hip_atomic_fetch_add(cnt + 64 * u.pm, 1u, __ATOMIC_RELAXED, __HIP_MEMORY_SCOPE_AGENT);
        if (wid == 0) {
            bool dead = false; const unsigned long long t0 = __builtin_amdgcn_s_memrealtime(); const unsigned want = 8u * (unsigned)ntn;
            for (;;) {
#if defined(BROKEN_EXCHANGE_NO_WAIT)
                break;
#endif
                if ((unsigned)__builtin_amdgcn_readfirstlane(__hip_atomic_load(cnt + 64 * u.pm, __ATOMIC_RELAXED, __HIP_MEMORY_SCOPE_AGENT)) >= want) break;
                if (__builtin_amdgcn_s_memrealtime() - t0 > 2000000ull) {
                    if (lane == 0) { unsigned expect = 0u; __hip_atomic_compare_exchange_strong(tmo + 1, &expect, code | (unsigned)(u.pm & 0xff), __ATOMIC_RELAXED, __ATOMIC_RELAXED, __HIP_MEMORY_SCOPE_AGENT);
                                     __hip_atomic_store(tmo, 1u, __ATOMIC_RELAXED, __HIP_MEMORY_SCOPE_AGENT); }
                    dead = true; break; }
                __builtin_amdgcn_s_sleep(2);
            }
            __builtin_amdgcn_fence(__ATOMIC_ACQUIRE, "agent");
            if (lane == 0) flag[0] = dead ? 1u : 0u;
        }
        asm volatile("s_waitcnt vmcnt(0) lgkmcnt(0)" ::: "memory"); __builtin_amdgcn_s_barrier(); asm volatile("" ::: "memory");
        const bool bad = flag[0] != 0u;
        if (lane < 32) {
            const unsigned long long* slot = (const unsigned long long*)xbuf + (size_t)(u.pm * BM + row) * 4; float mt[4], m2[4]; float ms = 0.f;
#pragma unroll
            for (int t = 0; t < 4; ++t) { if (t < ntn) { const unsigned long long w = __hip_atomic_load(slot + t, __ATOMIC_RELAXED, __HIP_MEMORY_SCOPE_AGENT); mt[t] = __uint_as_float((unsigned)w); m2[t] = __uint_as_float((unsigned)(w >> 32)); } else { mt[t] = 0.f; m2[t] = 0.f; } ms += mt[t]; }
            const float mean = ms / (float)ntn; float q = 0.f;
#pragma unroll
            for (int t = 0; t < 4; ++t) if (t < ntn) { const float dm = mt[t] - mean; q += m2[t] + 256.0f * dm * dm; }
            S[row] = (f32x2v){mean, 1.0f / sqrtf(q / (256.0f * (float)ntn) + eps)};
        }
        asm volatile("s_waitcnt lgkmcnt(0)" ::: "memory"); __builtin_amdgcn_s_barrier(); asm volatile("" ::: "memory");
        return bad;
    }
};
struct EpiLnRes {
    static constexpr bool PERM = false, AFTER_DRAIN = true; static constexpr int MID_T = -1;
    const float* base; float* out; int ldc; const float* bias; PanelStats st; unsigned poison;
    __device__ __forceinline__ void fused(f32x4 (&acc)[2][2][4][2], const Unit& u, int wr, int wc, int fr, int fq, PG8_LAS unsigned char* lds, int wid, int lane) const {
        typedef float f32x2v __attribute__((ext_vector_type(2)));
        const PG8_LAS f32x2v* S = (const PG8_LAS f32x2v*)(lds + 8192);
        const int col0 = u.pn * BM + wc * 32 + 4 * fq;
#pragma unroll
        for (int bj = 0; bj < 2; ++bj)
#pragma unroll
            for (int n = 0; n < 2; ++n) { const f32x4 bv = bias ? *(const f32x4*)(bias + col0 + bj * HALF + n * 16) : (f32x4){0.f, 0.f, 0.f, 0.f};
#pragma unroll
                for (int ai = 0; ai < 2; ++ai)
#pragma unroll
                    for (int m = 0; m < 4; ++m) acc[ai][bj][m][n] += bv; }
        f32x4 pre[4][2][2];
#pragma unroll
        for (int m = 0; m < 4; ++m) { const size_t off = (size_t)(u.pm * BM + wr * 64 + m * 16 + fr) * ldc + col0;
#pragma unroll
            for (int bj = 0; bj < 2; ++bj)
#pragma unroll
                for (int n = 0; n < 2; ++n) pre[m][bj][n] = *(const f32x4*)(base + off + bj * HALF + n * 16); }
        const bool bad = st.run(acc, u, wr, wc, fr, fq, lds, wid, lane) || poison != 0u;
        const float qnan = __builtin_nanf("");
#pragma unroll
        for (int ai = 0; ai < 2; ++ai)
#pragma unroll
            for (int m = 0; m < 4; ++m) { const int r = ai * HALF + wr * 64 + m * 16 + fr; const f32x2v sr = S[r]; const size_t off = (size_t)(u.pm * BM + r) * ldc + col0;
#pragma unroll
                for (int bj = 0; bj < 2; ++bj)
#pragma unroll
                    for (int n = 0; n < 2; ++n) { const f32x4 bs = ai == 0 ? pre[m][bj][n] : *(const f32x4*)(base + off + bj * HALF + n * 16); f32x4 o = bs + (acc[ai][bj][m][n] - sr.x) * sr.y;
                        if (bad) o = (f32x4){qnan, qnan, qnan, qnan}; *(f32x4*)(out + off + bj * HALF + n * 16) = o; }
                if (m & 1) asm volatile("" ::: "memory"); }
    }
};
struct EpiLnResLn {
    static constexpr bool PERM = false, AFTER_DRAIN = true; static constexpr int MID_T = -1;
    const float* base; float* out; bf16_t* xn; int ldc; const float* bias; PanelStats st1, st2; unsigned poison;
    __device__ __forceinline__ void fused(f32x4 (&acc)[2][2][4][2], const Unit& u, int wr, int wc, int fr, int fq, PG8_LAS unsigned char* lds, int wid, int lane) const {
        typedef float f32x2v __attribute__((ext_vector_type(2))); typedef unsigned u32x2v __attribute__((ext_vector_type(2)));
        const PG8_LAS f32x2v* S = (const PG8_LAS f32x2v*)(lds + 8192);
        const int col0 = u.pn * BM + wc * 32 + 4 * fq;
#pragma unroll
        for (int bj = 0; bj < 2; ++bj)
#pragma unroll
            for (int n = 0; n < 2; ++n) { const f32x4 bv = bias ? *(const f32x4*)(bias + col0 + bj * HALF + n * 16) : (f32x4){0.f, 0.f, 0.f, 0.f};
#pragma unroll
                for (int ai = 0; ai < 2; ++ai)
#pragma unroll
                    for (int m = 0; m < 4; ++m) acc[ai][bj][m][n] += bv; }
        bool bad = st1.run(acc, u, wr, wc, fr, fq, lds, wid, lane) || poison != 0u;
        const float qnan = __builtin_nanf("");
#pragma unroll
        for (int ai = 0; ai < 2; ++ai)
#pragma unroll
            for (int m = 0; m < 4; ++m) { const int r = ai * HALF + wr * 64 + m * 16 + fr; const f32x2v sr = S[r]; const size_t off = (size_t)(u.pm * BM + r) * ldc + col0;
#pragma unroll
                for (int bj = 0; bj < 2; ++bj)
#pragma unroll
                    for (int n = 0; n < 2; ++n) { const f32x4 bs = *(const f32x4*)(base + off + bj * HALF + n * 16); acc[ai][bj][m][n] = bs + (acc[ai][bj][m][n] - sr.x) * sr.y; }
                asm volatile("" : "+v"(acc[ai][0][m][0]), "+v"(acc[ai][0][m][1]), "+v"(acc[ai][1][m][0]), "+v"(acc[ai][1][m][1]));
                if (m & 1) asm volatile("" ::: "memory"); }
        const bool bad1 = bad;
        bad = st2.run(acc, u, wr, wc, fr, fq, lds, wid, lane) || bad;
#pragma unroll
        for (int ai = 0; ai < 2; ++ai)
#pragma unroll
            for (int m = 0; m < 4; ++m) { const int r = ai * HALF + wr * 64 + m * 16 + fr; const f32x2v sr = S[r]; const size_t off = (size_t)(u.pm * BM + r) * ldc + col0;
#pragma unroll
                for (int bj = 0; bj < 2; ++bj)
#pragma unroll
                    for (int n = 0; n < 2; ++n) { const f32x4 x1 = acc[ai][bj][m][n]; *(f32x4*)(out + off + bj * HALF + n * 16) = bad1 ? (f32x4){qnan, qnan, qnan, qnan} : x1;
                        const f32x4 o = (x1 - sr.x) * sr.y; u32x2v w; w.x = cvt_pk_bf16(o[0], o[1]); w.y = cvt_pk_bf16(o[2], o[3]);
                        if (bad) { w.x = 0x7fc07fc0u; w.y = 0x7fc07fc0u; } *(u32x2v*)(xn + off + bj * HALF + n * 16) = w; }
                asm volatile("" ::: "memory"); }
    }
};

template <class Epi, class Sched, bool ALIGN_EPI = false, bool SP2 = false>
__device__ __forceinline__ void gemm_phase(PG8_LAS unsigned char* lds, const Gemm g, const Sched& S, const Epi& E) {
    const int tid = threadIdx.x, wid = __builtin_amdgcn_readfirstlane(tid >> 6), lane = tid & 63, wr = wid >> 2, wc = wid & 3, fr = lane & 15, fq = lane >> 4;
    const int K = g.K, nt = K / BK;
    unsigned voffA[2], voffB[2];
#pragma unroll
    for (int i = 0; i < 2; ++i) { int R, C; stage_rc(tid * 16 + i * 8192, R, C); const int Rb = Epi::PERM ? ((R & ~31) + perm32(R & 31)) : R;
        voffA[i] = (unsigned)(R * K + C) * 2u; voffB[i] = (unsigned)(Rb * K + C) * 2u; }
    const size_t kstep = (size_t)(BK * 2);
    const size_t hstep = (size_t)HALF * K * 2;
    const size_t tstep = 2 * hstep;
    const unsigned ldsw = (unsigned)wid * 1024u;
    const int aoff = lds_byte(wr * 64 + fr, fq * 8), boff = lds_byte(wc * 32 + fr, fq * 8);
#define PG8_SA(b, h) (((b) * 2 + (h)) * HTB)
#define PG8_SB(b, h) ((4 + (b) * 2 + (h)) * HTB)
#define PG8_STAGE(bufoff, gbase, voff) do { _Pragma("unroll") for (int _i = 0; _i < 2; ++_i) \
        __builtin_amdgcn_global_load_lds((const unsigned*)((const char*)(gbase) + (voff)[_i]), (PG8_LAS unsigned*)(lds + (bufoff) + ldsw + _i * 8192), 16, 0, 0); } while (0)
#define PG8_LDA(dst, b, h) do { _Pragma("unroll") for (int m = 0; m < 4; ++m) _Pragma("unroll") for (int k = 0; k < 2; ++k) dst[m][k] = *(const PG8_LAS bf16x8*)(lds + PG8_SA(b, h) + aoff + m * 2048 + k * 1024); } while (0)
#define PG8_LDB(dst, b, h) do { _Pragma("unroll") for (int n = 0; n < 2; ++n) _Pragma("unroll") for (int k = 0; k < 2; ++k) dst[n][k] = *(const PG8_LAS bf16x8*)(lds + PG8_SB(b, h) + boff + n * 2048 + k * 1024); } while (0)
#define PG8_MMA(ai, bj, At, Bt) do { __builtin_amdgcn_s_setprio(1); _Pragma("unroll") for (int m = 0; m < 4; ++m) _Pragma("unroll") for (int n = 0; n < 2; ++n) _Pragma("unroll") for (int k = 0; k < 2; ++k) \
        acc[ai][bj][m][n] = __builtin_amdgcn_mfma_f32_16x16x32_bf16(Bt[n][k], At[m][k], acc[ai][bj][m][n], 0, 0, 0); __builtin_amdgcn_s_setprio(0); } while (0)
#define PG8_WAIT_V(n) asm volatile("s_waitcnt vmcnt(" #n ")" ::: "memory")
#define PG8_WAIT_L(n) asm volatile("s_waitcnt lgkmcnt(" #n ")" ::: "memory")
#define PG8_BAR __builtin_amdgcn_s_barrier()
#define PG8_SCHED __builtin_amdgcn_sched_barrier(0)
    Unit cur, nxt; int ui = 0;
    if (!S.next(0, cur)) return;
    f32x4 acc[2][2][4][2];
#pragma unroll
    for (int a = 0; a < 2; ++a)
#pragma unroll
        for (int b = 0; b < 2; ++b)
#pragma unroll
            for (int m = 0; m < 4; ++m)
#pragma unroll
                for (int n = 0; n < 2; ++n) acc[a][b][m][n] = (f32x4){0.f, 0.f, 0.f, 0.f};
    bf16x8 At[4][2], B0[2][2], B1[2][2];
    const char* cA = (const char*)g.A + (size_t)cur.pm * tstep; const char* cB = (const char*)g.Bt + (size_t)cur.pn * tstep;
    S.a_ready(cur);
    if constexpr (SP2) {
        PG8_STAGE(PG8_SB(0, 0), cB, voffB); PG8_STAGE(PG8_SB(0, 1), cB + hstep, voffB); PG8_STAGE(PG8_SA(0, 0), cA, voffA); PG8_STAGE(PG8_SA(0, 1), cA + hstep, voffA);
        if (wr == 1) PG8_BAR;
        PG8_WAIT_V(2); PG8_BAR;
        PG8_STAGE(PG8_SB(1, 0), cB + kstep, voffB); PG8_STAGE(PG8_SA(1, 0), cA + kstep, voffA); PG8_STAGE(PG8_SB(1, 1), cB + hstep + kstep, voffB);
        PG8_WAIT_V(6); PG8_BAR;
    } else {
        PG8_STAGE(PG8_SB(0, 0), cB, voffB); PG8_STAGE(PG8_SA(0, 0), cA, voffA); PG8_STAGE(PG8_SB(0, 1), cB + hstep, voffB); PG8_STAGE(PG8_SA(0, 1), cA + hstep, voffA);
        if (wr == 1) PG8_BAR;
        PG8_WAIT_V(4); PG8_BAR;
        PG8_STAGE(PG8_SB(1, 0), cB + kstep, voffB); PG8_STAGE(PG8_SA(1, 0), cA + kstep, voffA); PG8_STAGE(PG8_SB(1, 1), cB + hstep + kstep, voffB);
        PG8_WAIT_V(6); PG8_BAR;
    }
    for (;;) {
        const bool has_next = S.next(ui + 1, nxt);
        const char* nA = has_next ? (const char*)g.A + (size_t)nxt.pm * tstep : cA; const char* nB = has_next ? (const char*)g.Bt + (size_t)nxt.pn * tstep : cB;
        if constexpr (Epi::MID_T >= 0) {
        for (int t = 0; t < Epi::MID_T; t += 2) {
            const bool last = (t == nt - 2);
            const char* a1 = cA + (size_t)(t + 1) * kstep;
            const char* a2 = last ? nA : cA + (size_t)(t + 2) * kstep; const char* b2 = last ? nB : cB + (size_t)(t + 2) * kstep;
            const char* a3 = a2 + kstep; const char* b3 = b2 + kstep;
            if (last && has_next) S.a_ready(nxt);
            if constexpr (SP2) {
            PG8_LDB(B0, 0, 0); PG8_LDB(B1, 0, 1); PG8_SCHED; PG8_LDA(At, 0, 0); PG8_STAGE(PG8_SA(1, 1), a1 + hstep, voffA);
            PG8_WAIT_V(8); PG8_WAIT_L(0); PG8_BAR; PG8_MMA(0, 0, At, B0); PG8_MMA(0, 1, At, B1); PG8_BAR; PG8_SCHED;
            PG8_LDA(At, 0, 1); PG8_STAGE(PG8_SB(0, 0), b2, voffB); PG8_STAGE(PG8_SB(0, 1), b2 + hstep, voffB); PG8_STAGE(PG8_SA(0, 0), a2, voffA);
            PG8_WAIT_V(8); PG8_WAIT_L(0); PG8_BAR; PG8_MMA(1, 0, At, B0); PG8_MMA(1, 1, At, B1); PG8_BAR; PG8_SCHED;
            PG8_LDB(B0, 1, 0); PG8_LDB(B1, 1, 1); PG8_SCHED; PG8_LDA(At, 1, 0); PG8_STAGE(PG8_SA(0, 1), a2 + hstep, voffA);
            PG8_WAIT_V(8); PG8_WAIT_L(0); PG8_BAR; PG8_MMA(0, 0, At, B0); PG8_MMA(0, 1, At, B1); PG8_BAR; PG8_SCHED;
            PG8_LDA(At, 1, 1); PG8_STAGE(PG8_SB(1, 0), b3, voffB); PG8_STAGE(PG8_SB(1, 1), b3 + hstep, voffB); PG8_STAGE(PG8_SA(1, 0), a3, voffA);
            PG8_WAIT_V(8); PG8_WAIT_L(0); PG8_BAR; PG8_MMA(1, 0, At, B0); PG8_MMA(1, 1, At, B1); PG8_BAR; PG8_SCHED;
            } else {
            PG8_LDB(B0, 0, 0); PG8_SCHED; PG8_LDA(At, 0, 0); PG8_STAGE(PG8_SA(1, 1), a1 + hstep, voffA);
            PG8_WAIT_L(8); PG8_BAR; PG8_WAIT_L(0); PG8_MMA(0, 0, At, B0); PG8_BAR; PG8_SCHED;
            PG8_LDB(B1, 0, 1); PG8_STAGE(PG8_SB(0, 0), b2, voffB);
            PG8_BAR; PG8_WAIT_L(0); PG8_MMA(0, 1, At, B1); PG8_BAR;
            PG8_LDA(At, 0, 1); PG8_STAGE(PG8_SA(0, 0), a2, voffA);
            PG8_BAR; PG8_WAIT_L(0); PG8_MMA(1, 0, At, B0); PG8_BAR; PG8_SCHED;
            PG8_STAGE(PG8_SB(0, 1), b2 + hstep, voffB);
            PG8_WAIT_V(6); PG8_BAR; PG8_MMA(1, 1, At, B1); PG8_BAR;
            PG8_LDB(B0, 1, 0); PG8_SCHED; PG8_LDA(At, 1, 0); PG8_STAGE(PG8_SA(0, 1), a2 + hstep, voffA);
            PG8_WAIT_L(8); PG8_BAR; PG8_WAIT_L(0); PG8_MMA(0, 0, At, B0); PG8_BAR; PG8_SCHED;
            PG8_LDB(B1, 1, 1); PG8_STAGE(PG8_SB(1, 0), b3, voffB);
            PG8_BAR; PG8_WAIT_L(0); PG8_MMA(0, 1, At, B1); PG8_BAR;
            PG8_LDA(At, 1, 1); PG8_STAGE(PG8_SA(1, 0), a3, voffA);
            PG8_BAR; PG8_WAIT_L(0); PG8_MMA(1, 0, At, B0); PG8_BAR; PG8_SCHED;
            PG8_STAGE(PG8_SB(1, 1), b3 + hstep, voffB);
            PG8_WAIT_V(6); PG8_BAR; PG8_MMA(1, 1, At, B1); PG8_BAR;
            }
        }
        E.mid(acc, cur, wr, wc, fr, fq);
        for (int t = Epi::MID_T; t < nt; t += 2) {
            const bool last = (t == nt - 2);
            const char* a1 = cA + (size_t)(t + 1) * kstep;
            const char* a2 = last ? nA : cA + (size_t)(t + 2) * kstep; const char* b2 = last ? nB : cB + (size_t)(t + 2) * kstep;
            const char* a3 = a2 + kstep; const char* b3 = b2 + kstep;
            if (last && has_next) S.a_ready(nxt);
            if constexpr (SP2) {
            PG8_LDB(B0, 0, 0); PG8_LDB(B1, 0, 1); PG8_SCHED; PG8_LDA(At, 0, 0); PG8_STAGE(PG8_SA(1, 1), a1 + hstep, voffA);
            PG8_WAIT_V(8); PG8_WAIT_L(0); PG8_BAR; PG8_MMA(0, 0, At, B0); PG8_MMA(0, 1, At, B1); PG8_BAR; PG8_SCHED;
            PG8_LDA(At, 0, 1); PG8_STAGE(PG8_SB(0, 0), b2, voffB); PG8_STAGE(PG8_SB(0, 1), b2 + hstep, voffB); PG8_STAGE(PG8_SA(0, 0), a2, voffA);
            PG8_WAIT_V(8); PG8_WAIT_L(0); PG8_BAR; PG8_MMA(1, 0, At, B0); PG8_MMA(1, 1, At, B1); PG8_BAR; PG8_SCHED;
            PG8_LDB(B0, 1, 0); PG8_LDB(B1, 1, 1); PG8_SCHED; PG8_LDA(At, 1, 0); PG8_STAGE(PG8_SA(0, 1), a2 + hstep, voffA);
            PG8_WAIT_V(8); PG8_WAIT_L(0); PG8_BAR; PG8_MMA(0, 0, At, B0); PG8_MMA(0, 1, At, B1); PG8_BAR; PG8_SCHED;
            PG8_LDA(At, 1, 1); PG8_STAGE(PG8_SB(1, 0), b3, voffB); PG8_STAGE(PG8_SB(1, 1), b3 + hstep, voffB); PG8_STAGE(PG8_SA(1, 0), a3, voffA);
            PG8_WAIT_V(8); PG8_WAIT_L(0); PG8_BAR; PG8_MMA(1, 0, At, B0); PG8_MMA(1, 1, At, B1); PG8_BAR; PG8_SCHED;
            } else {
            PG8_LDB(B0, 0, 0); PG8_SCHED; PG8_LDA(At, 0, 0); PG8_STAGE(PG8_SA(1, 1), a1 + hstep, voffA);
            PG8_WAIT_L(8); PG8_BAR; PG8_WAIT_L(0); PG8_MMA(0, 0, At, B0); PG8_BAR; PG8_SCHED;
            PG8_LDB(B1, 0, 1); PG8_STAGE(PG8_SB(0, 0), b2, voffB);
            PG8_BAR; PG8_WAIT_L(0); PG8_MMA(0, 1, At, B1); PG8_BAR;
            PG8_LDA(At, 0, 1); PG8_STAGE(PG8_SA(0, 0), a2, voffA);
            PG8_BAR; PG8_WAIT_L(0); PG8_MMA(1, 0, At, B0); PG8_BAR; PG8_SCHED;
            PG8_STAGE(PG8_SB(0, 1), b2 + hstep, voffB);
            PG8_WAIT_V(6); PG8_BAR; PG8_MMA(1, 1, At, B1); PG8_BAR;
            PG8_LDB(B0, 1, 0); PG8_SCHED; PG8_LDA(At, 1, 0); PG8_STAGE(PG8_SA(0, 1), a2 + hstep, voffA);
            PG8_WAIT_L(8); PG8_BAR; PG8_WAIT_L(0); PG8_MMA(0, 0, At, B0); PG8_BAR; PG8_SCHED;
            PG8_LDB(B1, 1, 1); PG8_STAGE(PG8_SB(1, 0), b3, voffB);
            PG8_BAR; PG8_WAIT_L(0); PG8_MMA(0, 1, At, B1); PG8_BAR;
            PG8_LDA(At, 1, 1); PG8_STAGE(PG8_SA(1, 0), a3, voffA);
            PG8_BAR; PG8_WAIT_L(0); PG8_MMA(1, 0, At, B0); PG8_BAR; PG8_SCHED;
            PG8_STAGE(PG8_SB(1, 1), b3 + hstep, voffB);
            PG8_WAIT_V(6); PG8_BAR; PG8_MMA(1, 1, At, B1); PG8_BAR;
            }
        }
        } else {
        for (int t = 0; t < nt; t += 2) {
            const bool last = (t == nt - 2);
            const char* a1 = cA + (size_t)(t + 1) * kstep;
            const char* a2 = last ? nA : cA + (size_t)(t + 2) * kstep; const char* b2 = last ? nB : cB + (size_t)(t + 2) * kstep;
            const char* a3 = a2 + kstep; const char* b3 = b2 + kstep;
            if (last && has_next) S.a_ready(nxt);
            if constexpr (SP2) {
            PG8_LDB(B0, 0, 0); PG8_LDB(B1, 0, 1); PG8_SCHED; PG8_LDA(At, 0, 0); PG8_STAGE(PG8_SA(1, 1), a1 + hstep, voffA);
            PG8_WAIT_V(8); PG8_WAIT_L(0); PG8_BAR; PG8_MMA(0, 0, At, B0); PG8_MMA(0, 1, At, B1); PG8_BAR; PG8_SCHED;
            PG8_LDA(At, 0, 1); PG8_STAGE(PG8_SB(0, 0), b2, voffB); PG8_STAGE(PG8_SB(0, 1), b2 + hstep, voffB); PG8_STAGE(PG8_SA(0, 0), a2, voffA);
            PG8_WAIT_V(8); PG8_WAIT_L(0); PG8_BAR; PG8_MMA(1, 0, At, B0); PG8_MMA(1, 1, At, B1); PG8_BAR; PG8_SCHED;
            PG8_LDB(B0, 1, 0); PG8_LDB(B1, 1, 1); PG8_SCHED; PG8_LDA(At, 1, 0); PG8_STAGE(PG8_SA(0, 1), a2 + hstep, voffA);
            PG8_WAIT_V(8); PG8_WAIT_L(0); PG8_BAR; PG8_MMA(0, 0, At, B0); PG8_MMA(0, 1, At, B1); PG8_BAR; PG8_SCHED;
            PG8_LDA(At, 1, 1); PG8_STAGE(PG8_SB(1, 0), b3, voffB); PG8_STAGE(PG8_SB(1, 1), b3 + hstep, voffB); PG8_STAGE(PG8_SA(1, 0), a3, voffA);
            PG8_WAIT_V(8); PG8_WAIT_L(0); PG8_BAR; PG8_MMA(1, 0, At, B0); PG8_MMA(1, 1, At, B1); PG8_BAR; PG8_SCHED;
            } else {
            PG8_LDB(B0, 0, 0); PG8_SCHED; PG8_LDA(At, 0, 0); PG8_STAGE(PG8_SA(1, 1), a1 + hstep, voffA);
            PG8_WAIT_L(8); PG8_BAR; PG8_WAIT_L(0); PG8_MMA(0, 0, At, B0); PG8_BAR; PG8_SCHED;
            PG8_LDB(B1, 0, 1); PG8_STAGE(PG8_SB(0, 0), b2, voffB);
            PG8_BAR; PG8_WAIT_L(0); PG8_MMA(0, 1, At, B1); PG8_BAR;
            PG8_LDA(At, 0, 1); PG8_STAGE(PG8_SA(0, 0), a2, voffA);
            PG8_BAR; PG8_WAIT_L(0); PG8_MMA(1, 0, At, B0); PG8_BAR; PG8_SCHED;
            PG8_STAGE(PG8_SB(0, 1), b2 + hstep, voffB);
            PG8_WAIT_V(6); PG8_BAR; PG8_MMA(1, 1, At, B1); PG8_BAR;
            PG8_LDB(B0, 1, 0); PG8_SCHED; PG8_LDA(At, 1, 0); PG8_STAGE(PG8_SA(0, 1), a2 + hstep, voffA);
            PG8_WAIT_L(8); PG8_BAR; PG8_WAIT_L(0); PG8_MMA(0, 0, At, B0); PG8_BAR; PG8_SCHED;
            PG8_LDB(B1, 1, 1); PG8_STAGE(PG8_SB(1, 0), b3, voffB);
            PG8_BAR; PG8_WAIT_L(0); PG8_MMA(0, 1, At, B1); PG8_BAR;
            PG8_LDA(At, 1, 1); PG8_STAGE(PG8_SA(1, 0), a3, voffA);
            PG8_BAR; PG8_WAIT_L(0); PG8_MMA(1, 0, At, B0); PG8_BAR; PG8_SCHED;
            PG8_STAGE(PG8_SB(1, 1), b3 + hstep, voffB);
            PG8_WAIT_V(6); PG8_BAR; PG8_MMA(1, 1, At, B1); PG8_BAR;
            }
        }
        }
        if constexpr (ALIGN_EPI) { if (wr == 0) PG8_BAR; }
        if constexpr (!Epi::AFTER_DRAIN) { E(acc, cur, wr, wc, fr, fq); S.done(cur); }
        if (!has_next) break;
#pragma unroll
        for (int a = 0; a < 2; ++a)
#pragma unroll
            for (int b = 0; b < 2; ++b)
#pragma unroll
                for (int m = 0; m < 4; ++m)
#pragma unroll
                    for (int n = 0; n < 2; ++n) acc[a][b][m][n] = (f32x4){0.f, 0.f, 0.f, 0.f};
        cur = nxt; cA = nA; cB = nB; ++ui;
        if constexpr (ALIGN_EPI) { if (wr == 1) PG8_BAR; }
    }
    PG8_WAIT_V(0);
    if constexpr (!ALIGN_EPI) { if (wr == 0) PG8_BAR; }
    PG8_BAR;
    if constexpr (Epi::AFTER_DRAIN) { E.fused(acc, cur, wr, wc, fr, fq, lds, wid, lane); S.done(cur); }
#undef PG8_SA
#undef PG8_SB
#undef PG8_STAGE
#undef PG8_LDA
#undef PG8_LDB
#undef PG8_MMA
#undef PG8_WAIT_V
#undef PG8_WAIT_L
#undef PG8_BAR
#undef PG8_SCHED
}
}
#ifndef PG8_SP2
#define PG8_SP2 true
#endif
#ifndef PG8_ALIGN
#define PG8_ALIGN true
#endif
constexpr int NWAVES = 8;
#ifndef MK_N_LAUNCHES
#define MK_N_LAUNCHES 1
#endif
#ifndef SB_EARLY_EXIT
#define SB_EARLY_EXIT 1
#endif
constexpr int N_PHASES = 11;
constexpr int N_LAUNCHES = MK_N_LAUNCHES;

constexpr int BATCH = 4, SEQ = 8192, DM = 1024, M = BATCH * SEQ;
constexpr int INW = 5640, NPROJ = 5632, GATE_COL = 3584;
constexpr int NCHUNK = SEQ / 128;
constexpr int N_MLU = BATCH * 4 * NCHUNK;
constexpr float ALPHA = 1.18920711500272107f;
constexpr float LN_EPS = 1e-5f;
constexpr float LOG2E = 1.4426950408889634f;
constexpr float C2 = 0.125f * LOG2E;

constexpr size_t MiB = 1u << 20;
constexpr size_t WS_CTL = 0, CTL_ZERO_BYTES = 1 * MiB;
constexpr size_t WS_WIN_T = 1 * MiB;
constexpr size_t WS_WSB_T = 12 * MiB;
constexpr size_t WS_WOUT_T = 14 * MiB;
constexpr size_t WS_WQG_T = 16 * MiB;
constexpr size_t WS_WPLE_T = 22 * MiB;
constexpr size_t WS_STATS = 23 * MiB;
constexpr size_t WS_GI = 24 * MiB;
constexpr size_t WS_GF = 25 * MiB;
constexpr size_t WS_MLN = 26 * MiB;
constexpr size_t WS_MLS = 27 * MiB;
constexpr size_t WS_XN = 32 * MiB;
constexpr size_t WS_OCAT = 32 * MiB;
constexpr size_t WS_C = 448 * MiB;
constexpr size_t WS_UT = 32 * MiB;
constexpr size_t WS_VT = 48 * MiB;
constexpr float U_SCALE = 64.f, V_SCALE = 8.f;
constexpr size_t WS_PROJ = 96 * MiB;
constexpr size_t SLAB = (size_t)M * 512;
constexpr size_t WS_Y = 96 * MiB;
constexpr size_t WS_PLE = 160 * MiB;
constexpr size_t WS_H1B = 224 * MiB;
constexpr size_t WS_PRE1 = 320 * MiB;
constexpr size_t WS_Q = 320 * MiB;
constexpr size_t WS_IDX = 96 * MiB;
constexpr size_t WS_GATE = 112 * MiB;
constexpr size_t WS_PB = 480 * MiB;
constexpr size_t WS_END = 496 * MiB;
constexpr int CW_TMO = 0, CW_CODE = 1;
constexpr int CW_BAR = 4096;

constexpr int RING_OFF = 0, RING_BYTES = 131072;
constexpr int LDSCTL_OFF = RING_BYTES, MISC_OFF = LDSCTL_OFF + 320;
constexpr int LDS_BYTES = 147456;
#define GAS __attribute__((address_space(1)))
#define LAS __attribute__((address_space(3)))
typedef unsigned short bf16;
typedef unsigned v4u __attribute__((ext_vector_type(4)));
typedef float f32x4 __attribute__((ext_vector_type(4)));
typedef short bf16x8 __attribute__((ext_vector_type(8)));
typedef GAS unsigned gu32;
typedef GAS unsigned long long gu64;
#define RLX_AGENT __ATOMIC_RELAXED, __HIP_MEMORY_SCOPE_AGENT
#define LDS_WAIT() asm volatile("s_waitcnt lgkmcnt(0)" ::: "memory")
#define VM_WAIT() asm volatile("s_waitcnt vmcnt(0)" ::: "memory")
__device__ __forceinline__ unsigned long long rt() { return __builtin_amdgcn_s_memrealtime(); }
__device__ __forceinline__ unsigned f2bf(float f) { unsigned u = __builtin_bit_cast(unsigned, f); return (u + 0x7fffu + ((u >> 16) & 1u)) >> 16; }
__device__ __forceinline__ unsigned pk2(float lo, float hi) { return f2bf(lo) | (f2bf(hi) << 16); }

#define XB_TMO      128
#define XB_XCNT(j)  (256  + 64 * (j))
#define XB_XSUB(j)  (1280 + 64 * (j))
#define XB_XGEN(j)  (2304 + 64 * (j))
#define XB_TOP      3328
#define XB_TOPGEN   3392
#define XCD_BAR_WORDS 3456
#define XB_SPIN_CAP (1u << 18)

__device__ __forceinline__ unsigned xb_ld(unsigned* p)              { return __hip_atomic_load(p, __ATOMIC_RELAXED, __HIP_MEMORY_SCOPE_AGENT); }
__device__ __forceinline__ unsigned xb_add(unsigned* p, unsigned v) { return __hip_atomic_fetch_add(p, v, __ATOMIC_RELAXED, __HIP_MEMORY_SCOPE_AGENT); }
__device__ __forceinline__ unsigned xb_xcc_id() { return (unsigned)__builtin_amdgcn_s_getreg((3 << 11) | 20) & 0xFu; }
#define XB_SPIN(cond, bar) do { unsigned _sp = 0; while (cond) { __builtin_amdgcn_s_sleep(1); \
    if ((++_sp & 255u) == 0u) { if (xb_ld(&(bar)[XB_TMO])) break; if (_sp > XB_SPIN_CAP) { atomicAdd(&(bar)[XB_TMO], 1u); break; } } } } while (0)

struct XcdBarrier {
    unsigned* bar; unsigned x;
    volatile LAS unsigned* st;
};

__device__ __forceinline__ XcdBarrier xcd_barrier_post(unsigned* bar, volatile LAS unsigned* st) {
    XcdBarrier b; b.bar = bar; b.x = xb_xcc_id(); b.st = st;
    if (threadIdx.x == 0) (void)xb_add(&bar[XB_XCNT(b.x)], 1u);
    return b;
}
__device__ __forceinline__ void xcd_barrier_complete(unsigned* bar, unsigned x, unsigned& nloc, unsigned& nx) {
    const unsigned G = gridDim.x * gridDim.y * gridDim.z;
    unsigned sum, cnt, mine, sp = 0u;
    for (;;) {
        sum = 0u; cnt = 0u; mine = 0u;
#pragma unroll
        for (unsigned j = 0; j < 16; ++j) { const unsigned c = xb_ld(&bar[XB_XCNT(j)]); sum += c; cnt += (c > 0u) ? 1u : 0u; mine = (j == x) ? c : mine; }
        if (sum == G) break;
        __builtin_amdgcn_s_sleep(1);
        if ((++sp & 255u) == 0u) { if (xb_ld(&bar[XB_TMO])) break; if (sp > XB_SPIN_CAP) { atomicAdd(&bar[XB_TMO], 1u); break; } }
    }
    nloc = mine > 0u ? mine : 1u; nx = cnt > 0u ? cnt : 1u;
}

__device__ __forceinline__ void xcd_barrier(const XcdBarrier& b) {
    asm volatile("s_waitcnt vmcnt(0)" ::: "memory");
    __syncthreads();
    if (threadIdx.x == 0) {
        unsigned* bar = b.bar;
        __builtin_amdgcn_s_waitcnt(0);
        unsigned nloc = b.st[0], nx = b.st[1];
        if (nloc == 0u) { xcd_barrier_complete(bar, b.x, nloc, nx); b.st[0] = nloc; b.st[1] = nx; }
        const unsigned old = xb_add(&bar[XB_XSUB(b.x)], 1u);
        const unsigned gen = old / nloc;
        if (old + 1u == (gen + 1u) * nloc) {
            __builtin_amdgcn_fence(__ATOMIC_RELEASE, "agent");
            asm volatile("s_waitcnt vmcnt(0)" ::: "memory");
            const unsigned og = xb_add(&bar[XB_TOP], 1u);
            const unsigned tg = og / nx;
            if (og + 1u == (tg + 1u) * nx) xb_add(&bar[XB_TOPGEN], 1u);
            else XB_SPIN(xb_ld(&bar[XB_TOPGEN]) == tg, bar);
            __builtin_amdgcn_fence(__ATOMIC_ACQUIRE, "agent");
            xb_add(&bar[XB_XGEN(b.x)], 1u);
            asm volatile("s_waitcnt vmcnt(0)" ::: "memory");
        } else {
            XB_SPIN(xb_ld(&bar[XB_XGEN(b.x)]) == gen, bar);
            __builtin_amdgcn_fence(__ATOMIC_ACQUIRE, "agent");
            asm volatile("s_waitcnt vmcnt(0)" ::: "memory");
        }
    }
    __syncthreads();
}
typedef float f32x16 __attribute__((ext_vector_type(16)));
typedef float f32x2 __attribute__((ext_vector_type(2)));
typedef unsigned u32x2 __attribute__((ext_vector_type(2)));
typedef __bf16 bf16x2_t __attribute__((ext_vector_type(2)));

struct Frame {
    LAS unsigned char* lds;
    volatile LAS unsigned* MISC;
    gu32* ctl;
    int tid, lane, wave;
    int vcu, G;
    const float* const* in;
    float* out;
    unsigned char* ws;
};
#define WSP(T, off) ((T*)(F.ws + (off)))

#define DPP_F(v, CTRL) __uint_as_float((unsigned)__builtin_amdgcn_mov_dpp((int)__float_as_uint(v), (CTRL), 0xF, 0xF, true))
__device__ __forceinline__ float wave_sum(float v) {
    v += DPP_F(v, 0xB1); v += DPP_F(v, 0x4E); v += DPP_F(v, 0x141); v += DPP_F(v, 0x140);
    v += __uint_as_float((unsigned)__builtin_amdgcn_ds_swizzle((int)__float_as_uint(v), 0x401F));
    auto rr = __builtin_amdgcn_permlane32_swap(__float_as_uint(v), __float_as_uint(v), false, false);
    return __uint_as_float(rr[0]) + __uint_as_float(rr[1]);
}
__device__ __forceinline__ float wave_max(float v) {
    v = fmaxf(v, DPP_F(v, 0xB1)); v = fmaxf(v, DPP_F(v, 0x4E)); v = fmaxf(v, DPP_F(v, 0x141)); v = fmaxf(v, DPP_F(v, 0x140));
    v = fmaxf(v, __uint_as_float((unsigned)__builtin_amdgcn_ds_swizzle((int)__float_as_uint(v), 0x401F)));
    auto rr = __builtin_amdgcn_permlane32_swap(__float_as_uint(v), __float_as_uint(v), false, false);
    return fmaxf(__uint_as_float(rr[0]), __uint_as_float(rr[1]));
}
__device__ __forceinline__ float reduce8_transposed(const float (&d)[8], bool up16, bool up8) {
    float a_[4];
#pragma unroll
    for (int i = 0; i < 4; ++i) { auto rr = __builtin_amdgcn_permlane32_swap(__float_as_uint(d[i]), __float_as_uint(d[4 + i]), false, false); a_[i] = __uint_as_float(rr[0]) + __uint_as_float(rr[1]); }
    float b_[2];
#pragma unroll
    for (int i = 0; i < 2; ++i) { const float keep = up16 ? a_[2 + i] : a_[i], send = up16 ? a_[i] : a_[2 + i];
        b_[i] = keep + __uint_as_float((unsigned)__builtin_amdgcn_ds_swizzle((int)__float_as_uint(send), 0x401F)); }
    const float keep = up8 ? b_[1] : b_[0], send = up8 ? b_[0] : b_[1];
    float c0 = keep + DPP_F(send, 0x128);
    c0 += DPP_F(c0, 0x141); c0 += DPP_F(c0, 0x4E); c0 += DPP_F(c0, 0xB1);
    return c0;
}
__device__ __forceinline__ float bf_lo(unsigned u) { return __uint_as_float(u << 16); }
__device__ __forceinline__ float bf_hi(unsigned u) { return __uint_as_float(u & 0xffff0000u); }
__device__ __forceinline__ unsigned cvtpk(float lo, float hi) { f32x2 v = {lo, hi}; bf16x2_t b = __builtin_convertvector(v, bf16x2_t); return __builtin_bit_cast(unsigned, b); }
__device__ __forceinline__ float sigmoidf_fast(float x) { return __builtin_amdgcn_rcpf(1.0f + __builtin_amdgcn_exp2f(-x * LOG2E)); }
__device__ __forceinline__ float siluf_fast(float x) { return x * sigmoidf_fast(x); }
__device__ __forceinline__ int crow(int r, int hi) { return (r & 3) + 8 * (r >> 2) + 4 * hi; }
__device__ __forceinline__ float dot2_bf16(unsigned w, unsigned x, float acc) { return __builtin_amdgcn_fdot2_f32_bf16(__builtin_bit_cast(bf16x2_t, w), __builtin_bit_cast(bf16x2_t, x), acc, false); }
#define MFMA32(a, b, c) __builtin_amdgcn_mfma_f32_32x32x16_bf16((a), (b), (c), 0, 0, 0)

namespace pg8 {
template <bool ADD> struct EpiGate {
    static constexpr bool PERM = true, AFTER_DRAIN = false; static constexpr int MID_T = -1;
    bf16_t* Y; const bf16_t* G;
    __device__ __forceinline__ void operator()(const f32x4 (&acc)[2][2][4][2], const Unit& u, int wr, int wc, int fr, int fq) const {
        const int row0 = u.pm * BM + wr * 64 + fr, col0 = u.pn * BM + wc * 32 + 8 * fq;
#pragma unroll
        for (int ai = 0; ai < 2; ++ai)
#pragma unroll
            for (int m = 0; m < 4; ++m) { const size_t row = (size_t)(row0 + ai * HALF + m * 16);
#pragma unroll
                for (int bj = 0; bj < 2; ++bj) { const int col = col0 + bj * HALF;
                    const u32x4 g = *(const u32x4*)(G + (size_t)(col >> 9) * SLAB + row * 512 + (col & 511));
                    const f32x4 v0 = acc[ai][bj][m][0], v1 = acc[ai][bj][m][1];
                    float y[8];
                    y[0] = sigmoidf_fast(bf_lo(g.x)) * v0[0]; y[1] = sigmoidf_fast(bf_hi(g.x)) * v0[1]; y[2] = sigmoidf_fast(bf_lo(g.y)) * v0[2]; y[3] = sigmoidf_fast(bf_hi(g.y)) * v0[3];
                    y[4] = sigmoidf_fast(bf_lo(g.z)) * v1[0]; y[5] = sigmoidf_fast(bf_hi(g.z)) * v1[1]; y[6] = sigmoidf_fast(bf_lo(g.w)) * v1[2]; y[7] = sigmoidf_fast(bf_hi(g.w)) * v1[3];
                    u32x4* yp = (u32x4*)(Y + row * 1024 + col);
                    if (ADD) { const u32x4 o = *yp; y[0] += bf_lo(o.x); y[1] += bf_hi(o.x); y[2] += bf_lo(o.y); y[3] += bf_hi(o.y); y[4] += bf_lo(o.z); y[5] += bf_hi(o.z); y[6] += bf_lo(o.w); y[7] += bf_hi(o.w); }
                    u32x4 w; w.x = cvtpk(y[0], y[1]); w.y = cvtpk(y[2], y[3]); w.z = cvtpk(y[4], y[5]); w.w = cvtpk(y[6], y[7]);
                    *yp = w; } }
    }
};
__device__ __forceinline__ float sig_den(float x) { return 1.0f + __builtin_amdgcn_exp2f(fminf(-x * LOG2E, 60.0f)); }
struct EpiGate2 {
    static constexpr bool PERM = true, AFTER_DRAIN = false; static constexpr int MID_T = 8;
    bf16_t* Y; const bf16_t* Gsb; const bf16_t* Gml;
    __device__ __forceinline__ void mid(f32x4 (&acc)[2][2][4][2], const Unit& u, int wr, int wc, int fr, int fq) const {
        const int row0 = u.pm * BM + wr * 64 + fr, col0 = u.pn * BM + wc * 32 + 8 * fq;
#pragma unroll
        for (int ai = 0; ai < 2; ++ai)
#pragma unroll
            for (int m = 0; m < 4; ++m) { const size_t row = (size_t)(row0 + ai * HALF + m * 16);
#pragma unroll
                for (int bj = 0; bj < 2; ++bj) { const int col = col0 + bj * HALF; const size_t go = (size_t)(col >> 9) * SLAB + row * 512 + (col & 511);
                    const u32x4 a = *(const u32x4*)(Gsb + go), b = *(const u32x4*)(Gml + go);
                    f32x4& v0 = acc[ai][bj][m][0]; f32x4& v1 = acc[ai][bj][m][1];
                    v0[0] *= sig_den(bf_lo(b.x)) * __builtin_amdgcn_rcpf(sig_den(bf_lo(a.x))); v0[1] *= sig_den(bf_hi(b.x)) * __builtin_amdgcn_rcpf(sig_den(bf_hi(a.x)));
                    v0[2] *= sig_den(bf_lo(b.y)) * __builtin_amdgcn_rcpf(sig_den(bf_lo(a.y))); v0[3] *= sig_den(bf_hi(b.y)) * __builtin_amdgcn_rcpf(sig_den(bf_hi(a.y)));
                    v1[0] *= sig_den(bf_lo(b.z)) * __builtin_amdgcn_rcpf(sig_den(bf_lo(a.z))); v1[1] *= sig_den(bf_hi(b.z)) * __builtin_amdgcn_rcpf(sig_den(bf_hi(a.z)));
                    v1[2] *= sig_den(bf_lo(b.w)) * __builtin_amdgcn_rcpf(sig_den(bf_lo(a.w))); v1[3] *= sig_den(bf_hi(b.w)) * __builtin_amdgcn_rcpf(sig_den(bf_hi(a.w)));
                    asm volatile("" ::: "memory"); __builtin_amdgcn_sched_barrier(0); } }
    }
    __device__ __forceinline__ void operator()(const f32x4 (&acc)[2][2][4][2], const Unit& u, int wr, int wc, int fr, int fq) const {
        const int row0 = u.pm * BM + wr * 64 + fr, col0 = u.pn * BM + wc * 32 + 8 * fq;
#pragma unroll
        for (int ai = 0; ai < 2; ++ai)
#pragma unroll
            for (int m = 0; m < 4; ++m) { const size_t row = (size_t)(row0 + ai * HALF + m * 16);
#pragma unroll
                for (int bj = 0; bj < 2; ++bj) { const int col = col0 + bj * HALF;
                    const u32x4 b = *(const u32x4*)(Gml + (size_t)(col >> 9) * SLAB + row * 512 + (col & 511));
                    const f32x4 v0 = acc[ai][bj][m][0], v1 = acc[ai][bj][m][1];
                    u32x4 w;
                    w.x = cvtpk(v0[0] * __builtin_amdgcn_rcpf(sig_den(bf_lo(b.x))), v0[1] * __builtin_amdgcn_rcpf(sig_den(bf_hi(b.x)))); w.y = cvtpk(v0[2] * __builtin_amdgcn_rcpf(sig_den(bf_lo(b.y))), v0[3] * __builtin_amdgcn_rcpf(sig_den(bf_hi(b.y))));
                    w.z = cvtpk(v1[0] * __builtin_amdgcn_rcpf(sig_den(bf_lo(b.z))), v1[1] * __builtin_amdgcn_rcpf(sig_den(bf_hi(b.z)))); w.w = cvtpk(v1[2] * __builtin_amdgcn_rcpf(sig_den(bf_lo(b.w))), v1[3] * __builtin_amdgcn_rcpf(sig_den(bf_hi(b.w))));
                    *(u32x4*)(Y + row * 1024 + col) = w; } }
    }
};
struct EpiPre1 {
    static constexpr bool PERM = false, AFTER_DRAIN = false; static constexpr int MID_T = -1;
    float* P; const float* x; const float* stats; const float* g0; const float* b0;
    __device__ __forceinline__ void operator()(const f32x4 (&acc)[2][2][4][2], const Unit& u, int wr, int wc, int fr, int fq) const {
        const int row0 = u.pm * BM + wr * 64 + fr, col0 = u.pn * BM + wc * 32 + 4 * fq;
        f32x4 gv[2][2], bv[2][2];
#pragma unroll
        for (int bj = 0; bj < 2; ++bj)
#pragma unroll
            for (int n = 0; n < 2; ++n) { gv[bj][n] = *(const f32x4*)(g0 + col0 + bj * HALF + n * 16); bv[bj][n] = *(const f32x4*)(b0 + col0 + bj * HALF + n * 16); }
#pragma unroll
        for (int ai = 0; ai < 2; ++ai)
#pragma unroll
            for (int m = 0; m < 4; ++m) { const size_t row = (size_t)(row0 + ai * HALF + m * 16); const f32x2 st = *(const f32x2*)(stats + row * 2);
#pragma unroll
                for (int bj = 0; bj < 2; ++bj)
#pragma unroll
                    for (int n = 0; n < 2; ++n) { const size_t off = row * 1024 + col0 + bj * HALF + n * 16; const f32x4 xv = *(const f32x4*)(x + off);
                        const f32x4 h0 = (xv - st.x) * st.y * gv[bj][n] + bv[bj][n];
                        *(f32x4*)(P + off) = h0 * ALPHA + acc[ai][bj][m][n]; } }
    }
};
struct EpiQG {
    static constexpr bool PERM = true, AFTER_DRAIN = false; static constexpr int MID_T = -1;
    bf16_t* Q; bf16_t* PLE;
    __device__ __forceinline__ void operator()(const f32x4 (&acc)[2][2][4][2], const Unit& u, int wr, int wc, int fr, int fq) const {
        const int row0 = u.pm * BM + wr * 64 + fr, colt = u.pn * BM, col0 = colt + wc * 32 + 8 * fq;
        const bool isq = colt < 2048;
#pragma unroll
        for (int ai = 0; ai < 2; ++ai)
#pragma unroll
            for (int m = 0; m < 4; ++m) { const size_t row = (size_t)(row0 + ai * HALF + m * 16);
#pragma unroll
                for (int bj = 0; bj < 2; ++bj) { const int col = col0 + bj * HALF; const f32x4 v0 = acc[ai][bj][m][0], v1 = acc[ai][bj][m][1];
                    if (isq) { u32x4 w; w.x = cvtpk(v0[0], v0[1]); w.y = cvtpk(v0[2], v0[3]); w.z = cvtpk(v1[0], v1[1]); w.w = cvtpk(v1[2], v1[3]);
                        *(u32x4*)(Q + row * 2048 + col) = w; }
                    else { u32x4* pp = (u32x4*)(PLE + row * 1024 + (col - 2048)); const u32x4 o = *pp; u32x4 w;
                        w.x = cvtpk(sigmoidf_fast(v0[0]) * bf_lo(o.x), sigmoidf_fast(v0[1]) * bf_hi(o.x)); w.y = cvtpk(sigmoidf_fast(v0[2]) * bf_lo(o.y), sigmoidf_fast(v0[3]) * bf_hi(o.y));
                        w.z = cvtpk(sigmoidf_fast(v1[0]) * bf_lo(o.z), sigmoidf_fast(v1[1]) * bf_hi(o.z)); w.w = cvtpk(sigmoidf_fast(v1[2]) * bf_lo(o.w), sigmoidf_fast(v1[3]) * bf_hi(o.w));
                        *pp = w; } } }
    }
};
}

__device__ __forceinline__ void p0_transpose_item(const float* W, int ldw, int K, int nblk, int shift_from, int shift, bf16* WT, int row_off, LAS float* scr, int item, int lane, int ldt = 0, int kofs = 0) {
    const int kb = item / nblk, nb = item % nblk, k0 = 64 * kb, n0 = 32 * nb, sn0 = n0 + (n0 >= shift_from ? shift : 0);
#pragma unroll 8
    for (int i = 0; i < 32; ++i) { const int kk = 2 * i + (lane >> 5); scr[kk * 33 + (lane & 31)] = W[(size_t)(k0 + kk) * ldw + sn0 + (lane & 31)]; }
    LDS_WAIT(); asm volatile("" ::: "memory");
    const int c = lane & 7;
#pragma unroll
    for (int j = 0; j < 4; ++j) { const int n = (lane >> 3) + 8 * j; const LAS float* s = scr + (8 * c) * 33 + n;
        v4u o; o.x = pk2(s[0 * 33], s[1 * 33]); o.y = pk2(s[2 * 33], s[3 * 33]); o.z = pk2(s[4 * 33], s[5 * 33]); o.w = pk2(s[6 * 33], s[7 * 33]);
        *(GAS v4u*)(WT + (size_t)(row_off + n0 + n) * (ldt ? ldt : K) + kofs + k0 + 8 * c) = o; }
    LDS_WAIT(); asm volatile("" ::: "memory");
}
__device__ __forceinline__ float log_sigmoidf(float x) { return -(fmaxf(-x, 0.f) + log1pf(expf(-fabsf(x)))); }

__device__ __forceinline__ void p0_prologue(Frame& F) {
    const int gw = F.vcu * NWAVES + F.wave, NGW = F.G * NWAVES, lane = F.lane;
    {
        LAS float* scr = (LAS float*)(F.lds + RING_OFF + F.wave * 16384);
        constexpr int I_IN = 16 * (NPROJ / 32), I_SB = 8 * 32, I_ML = 8 * 32, I_OUT = 16 * 32, I_WQ = 16 * 64, I_WG = 16 * 32, I_PLE = 4 * 32;
        constexpr int NITEMS = I_IN + I_SB + I_ML + I_OUT + I_WQ + I_WG + I_PLE;
        for (int it = gw; it < NITEMS; it += NGW) {
            int r = it;
            if (r < I_IN) { p0_transpose_item(F.in[4], INW, 1024, NPROJ / 32, GATE_COL, 8, WSP(bf16, WS_WIN_T), 0, scr, r, lane); continue; } r -= I_IN;
            if (r < I_SB) { p0_transpose_item(F.in[9], 1024, 512, 32, 1 << 30, 0, WSP(bf16, WS_WSB_T), 0, scr, r, lane, 1024, 0); continue; } r -= I_SB;
            if (r < I_ML) { p0_transpose_item(F.in[10], 1024, 512, 32, 1 << 30, 0, WSP(bf16, WS_WSB_T), 0, scr, r, lane, 1024, 512); continue; } r -= I_ML;
            if (r < I_OUT) { p0_transpose_item(F.in[11], 1024, 1024, 32, 1 << 30, 0, WSP(bf16, WS_WOUT_T), 0, scr, r, lane); continue; } r -= I_OUT;
            if (r < I_WQ) { p0_transpose_item(F.in[14], 2048, 1024, 64, 1 << 30, 0, WSP(bf16, WS_WQG_T), 0, scr, r, lane); continue; } r -= I_WQ;
            if (r < I_WG) { p0_transpose_item(F.in[19], 1024, 1024, 32, 1 << 30, 0, WSP(bf16, WS_WQG_T), 2048, scr, r, lane); continue; } r -= I_WG;
            p0_transpose_item(F.in[20], 1024, 256, 32, 1 << 30, 0, WSP(bf16, WS_WPLE_T), 0, scr, r, lane);
        }
    }
    {
        const float* p = F.in[1]; bf16* PB = WSP(bf16, WS_PB);
        const size_t nchunk = (size_t)M * 256 / 8, stride = (size_t)F.G * NWAVES * 64;
        for (size_t i = (size_t)F.vcu * NWAVES * 64 + F.tid; i < nchunk; i += stride) {
            const f32x4 a = *(const GAS f32x4*)(p + i * 8), b = *(const GAS f32x4*)(p + i * 8 + 4);
            v4u o; o.x = pk2(a.x, a.y); o.y = pk2(a.z, a.w); o.z = pk2(b.x, b.y); o.w = pk2(b.z, b.w);
            *(GAS v4u*)(PB + i * 8) = o; }
    }
    __syncthreads();
    LAS float* WGt = (LAS float*)(F.lds + RING_OFF);
    for (int i = F.tid; i < 8192; i += NWAVES * 64) { const int k = i >> 3, c = i & 7; WGt[c * 1024 + k] = F.in[4][(size_t)k * INW + GATE_COL + c]; }
    __syncthreads();
    const float* x = F.in[0]; const float* g0 = F.in[2]; const float* b0 = F.in[3];
    f32x4 gv[4], bv[4];
#pragma unroll
    for (int j = 0; j < 4; ++j) { gv[j] = *(const f32x4*)(g0 + 256 * j + 4 * lane); bv[j] = *(const f32x4*)(b0 + 256 * j + 4 * lane); }
    bf16* XN = WSP(bf16, WS_XN); float* stats = WSP(float, WS_STATS); float* GI = WSP(float, WS_GI); float* GF = WSP(float, WS_GF);
    const float big = F.in[5][(lane >> 3) & 3], bfg = F.in[6][(lane >> 3) & 3];
    const bool up16 = (lane & 16) != 0, up8 = (lane & 8) != 0;
    f32x4 vn[4];
    if (gw < M) {
#pragma unroll
        for (int j = 0; j < 4; ++j) vn[j] = ((const GAS f32x4*)(x + (size_t)gw * DM) + lane)[64 * j]; }
    for (int m = gw; m < M; m += NGW) {
        f32x4 v[4]; float s = 0.f;
#pragma unroll
        for (int j = 0; j < 4; ++j) v[j] = vn[j];
        { const int mn = (m + NGW < M) ? m + NGW : m;
#pragma unroll
            for (int j = 0; j < 4; ++j) vn[j] = ((const GAS f32x4*)(x + (size_t)mn * DM) + lane)[64 * j]; }
        __builtin_amdgcn_sched_barrier(0);
#pragma unroll
        for (int j = 0; j < 4; ++j) s += (v[j].x + v[j].y) + (v[j].z + v[j].w);
        const float mean = wave_sum(s) * (1.f / DM); float s2 = 0.f;
#pragma unroll
        for (int j = 0; j < 4; ++j) { v[j] = v[j] - mean; s2 += (v[j].x * v[j].x + v[j].y * v[j].y) + (v[j].z * v[j].z + v[j].w * v[j].w); }
        const float rstd = 1.f / sqrtf(wave_sum(s2) * (1.f / DM) + LN_EPS);
        GAS unsigned long long* o8 = (GAS unsigned long long*)(XN + (size_t)m * DM) + lane;
        float part[8];
#pragma unroll
        for (int c = 0; c < 8; ++c) part[c] = 0.f;
#pragma unroll
        for (int j = 0; j < 4; ++j) { const f32x4 y = v[j] * rstd * gv[j] + bv[j];
            o8[64 * j] = (unsigned long long)pk2(y.x, y.y) | ((unsigned long long)pk2(y.z, y.w) << 32);
#pragma unroll
            for (int c = 0; c < 8; ++c) { const f32x4 w = *(const LAS f32x4*)(WGt + c * 1024 + 256 * j + 4 * lane); part[c] += (y.x * w.x + y.y * w.y) + (y.z * w.z + y.w * w.w); } }
        const float sel = reduce8_transposed(part, up16, up8);
        if (lane == 0) { stats[(size_t)m * 2] = mean; stats[(size_t)m * 2 + 1] = rstd; }
        if ((lane & 7) == 0) { const int c = lane >> 3; if (c < 4) GI[(size_t)m * 4 + c] = sel + big; else GF[(size_t)m * 4 + (c - 4)] = log_sigmoidf(sel + bfg); }
    }
}
template <bool MASK>
__device__ __forceinline__ void sb_block(const f32x16& x, float& R, int kbase, int qg, int hi, unsigned (&pw)[8]) {
    float bt[16], om[16];
#pragma unroll
    for (int r = 0; r < 16; ++r) {
        const float xv = fminf(fmaxf(x[r], -60.f), 60.f);
        const float e = __builtin_amdgcn_exp2f(-xv);
        const float be = __builtin_amdgcn_rcpf(1.0f + e);
        bt[r] = be; om[r] = e * be;
        if (MASK) { const bool c = (kbase + crow(r, hi)) < qg; om[r] = c ? om[r] : 1.f; bt[r] = c ? bt[r] : 0.f; }
    }
    float ex[16], T[4];
#pragma unroll
    for (int g = 0; g < 4; ++g) { ex[4 * g + 3] = 1.f; ex[4 * g + 2] = om[4 * g + 3]; ex[4 * g + 1] = ex[4 * g + 2] * om[4 * g + 2]; ex[4 * g] = ex[4 * g + 1] * om[4 * g + 1]; T[g] = ex[4 * g] * om[4 * g]; }
    float S[4], up[4];
#pragma unroll
    for (int g = 0; g < 4; ++g) { auto rr = __builtin_amdgcn_permlane32_swap(__float_as_uint(T[g]), __float_as_uint(T[g]), false, false);
        const float lo_v = __uint_as_float(rr[0]), up_v = __uint_as_float(rr[1]); S[g] = lo_v * up_v; up[g] = up_v; }
    float base[4];
    base[3] = R; base[2] = base[3] * S[3]; base[1] = base[2] * S[2]; base[0] = base[1] * S[1];
    R = base[0] * S[0];
    float w[16];
#pragma unroll
    for (int g = 0; g < 4; ++g) { const float off = base[g] * (hi == 0 ? up[g] : 1.f);
#pragma unroll
        for (int i = 0; i < 4; ++i) w[4 * g + i] = bt[4 * g + i] * (off * ex[4 * g + i]); }
#pragma unroll
    for (int i = 0; i < 8; ++i) pw[i] = cvtpk(w[2 * i], w[2 * i + 1]);
}

constexpr int AT_TK = 128;
constexpr int AT_KS = 0, AT_KSB = AT_TK * 144, AT_VT = 2 * AT_KSB, AT_VTB = 64 * 264, AT_FL = AT_VT + 2 * AT_VTB;
__device__ __forceinline__ void attn_unit(Frame& F, int bh, int qb) {
    const int tid = F.tid, lane = F.lane, wave = F.wave, r32 = lane & 31, hi = lane >> 5;
    const int b = bh >> 3, h = bh & 7;
    const size_t rowbase = (size_t)b * SEQ;
    const int q0 = qb * 256, qw = q0 + wave * 32;
    const bf16* PROJ = WSP(bf16, WS_PROJ);
    const bf16* Qs = PROJ + (rowbase + qw) * 512 + h * 64;
    const bf16* Ks = PROJ + SLAB + rowbase * 512 + h * 64;
    const bf16* Vs = PROJ + 2 * SLAB + rowbase * 512 + h * 64;
    bf16x8 qr[4];
#pragma unroll
    for (int ks = 0; ks < 4; ++ks) qr[ks] = *(const bf16x8*)(Qs + (size_t)r32 * 512 + ks * 16 + hi * 8);
    LAS unsigned char* L = F.lds + RING_OFF;
    LAS unsigned* FL = (LAS unsigned*)(L + AT_FL);
    const int skey = tid >> 3, sch = tid & 7;
    f32x16 o0, o1;
#pragma unroll
    for (int r = 0; r < 16; ++r) { o0[r] = 0.f; o1[r] = 0.f; }
    float R = 1.f; bool wdone = false;
    const int NT = (q0 + 256) / AT_TK;
    v4u kreg[2], vreg[2];
#define AT_LOAD(kt) do { _Pragma("unroll") for (int hh_ = 0; hh_ < 2; ++hh_) { const size_t ro_ = (size_t)((kt) * AT_TK + 64 * hh_ + skey) * 512 + sch * 8; kreg[hh_] = *(const v4u*)(Ks + ro_); vreg[hh_] = *(const v4u*)(Vs + ro_); } } while (0)
#define AT_WRITE(buf) do { _Pragma("unroll") for (int hh_ = 0; hh_ < 2; ++hh_) { const int key_ = 64 * hh_ + skey; *(LAS v4u*)(L + AT_KS + (buf) * AT_KSB + key_ * 144 + sch * 16) = kreg[hh_]; \
        LAS unsigned short* vt_ = (LAS unsigned short*)(L + AT_VT + (buf) * AT_VTB) + (sch * 8) * 132 + key_; const v4u w_ = vreg[hh_]; \
        vt_[0 * 132] = (unsigned short)(w_.x & 0xffffu); vt_[1 * 132] = (unsigned short)(w_.x >> 16); vt_[2 * 132] = (unsigned short)(w_.y & 0xffffu); vt_[3 * 132] = (unsigned short)(w_.y >> 16); \
        vt_[4 * 132] = (unsigned short)(w_.z & 0xffffu); vt_[5 * 132] = (unsigned short)(w_.z >> 16); vt_[6 * 132] = (unsigned short)(w_.w & 0xffffu); vt_[7 * 132] = (unsigned short)(w_.w >> 16); } } while (0)
    AT_LOAD(NT - 1); AT_WRITE(0);
    __syncthreads();
    int cur = 0, par = 0;
    for (int kt = NT - 1; kt >= 0; --kt) {
        if (kt > 0) AT_LOAD(kt - 1);
        if (!wdone && AT_TK * kt < qw + 31) {
#pragma unroll
            for (int kbi = 0; kbi < 4; ++kbi) { const int kb = 3 - kbi; const int kbase = AT_TK * kt + 32 * kb;
                if (!wdone && kbase < qw + 31) {
                    f32x16 x;
#pragma unroll
                    for (int r = 0; r < 16; ++r) x[r] = 0.f;
#pragma unroll
                    for (int ks = 0; ks < 4; ++ks) { const bf16x8 a = *(const LAS bf16x8*)(L + AT_KS + cur * AT_KSB + (32 * kb + r32) * 144 + (16 * ks + 8 * hi) * 2); x = MFMA32(a, qr[ks], x); }
                    unsigned pw[8];
                    if (kbase + 31 < qw) sb_block<false>(x, R, kbase, qw + r32, hi, pw); else sb_block<true>(x, R, kbase, qw + r32, hi, pw);
#pragma unroll
                    for (int s2 = 0; s2 < 2; ++s2) { v4u av; av.x = pw[4 * s2]; av.y = pw[4 * s2 + 1]; av.z = pw[4 * s2 + 2]; av.w = pw[4 * s2 + 3]; const bf16x8 a = __builtin_bit_cast(bf16x8, av);
#pragma unroll
                        for (int dt = 0; dt < 2; ++dt) { const LAS unsigned char* vp = L + AT_VT + cur * AT_VTB + (32 * dt + r32) * 264 + (32 * kb + 16 * s2 + 4 * hi) * 2;
                            const u32x2 b0 = *(const LAS u32x2*)vp, b1 = *(const LAS u32x2*)(vp + 16);
                            v4u bv; bv.x = b0.x; bv.y = b0.y; bv.z = b1.x; bv.w = b1.y; const bf16x8 bb = __builtin_bit_cast(bf16x8, bv);
                            if (dt == 0) o0 = MFMA32(a, bb, o0); else o1 = MFMA32(a, bb, o1); } }
#if SB_EARLY_EXIT
                    wdone = __all(R == 0.f);
#endif
                }
            }
        }
        if (lane == 0) FL[par * 8 + wave] = wdone ? 1u : 0u;
        if (kt > 0) AT_WRITE(cur ^ 1);
        __syncthreads();
        unsigned alld = 1u;
#pragma unroll
        for (int w = 0; w < 8; ++w) alld &= FL[par * 8 + w];
        cur ^= 1; par ^= 1;
        if (alld) break;
    }
#undef AT_LOAD
#undef AT_WRITE
    bf16* Ow = WSP(bf16, WS_OCAT) + (rowbase + qw) * 1024 + h * 64 + r32;
#pragma unroll
    for (int r = 0; r < 16; ++r) { const int q = crow(r, hi); Ow[(size_t)q * 1024] = (bf16)f2bf(o0[r]); Ow[(size_t)q * 1024 + 32] = (bf16)f2bf(o1[r]); }
    __syncthreads();
}

template <bool TRANS>
__device__ __forceinline__ void ml_stage_conv(Frame& F, const bf16* raw, int t0, const float* cw, const float* cb, float scale, LAS bf16* dst) {
    const int cg = F.tid & 15, rr = F.tid >> 4;
    float w[4][8], bb[8];
#pragma unroll
    for (int j = 0; j < 4; ++j) { const f32x4 a = *(const f32x4*)(cw + j * 1024 + cg * 8), c = *(const f32x4*)(cw + j * 1024 + cg * 8 + 4);
        w[j][0] = a.x; w[j][1] = a.y; w[j][2] = a.z; w[j][3] = a.w; w[j][4] = c.x; w[j][5] = c.y; w[j][6] = c.z; w[j][7] = c.w; }
    { const f32x4 a = *(const f32x4*)(cb + cg * 8), c = *(const f32x4*)(cb + cg * 8 + 4); bb[0] = a.x; bb[1] = a.y; bb[2] = a.z; bb[3] = a.w; bb[4] = c.x; bb[5] = c.y; bb[6] = c.z; bb[7] = c.w; }
#pragma unroll
    for (int p = 0; p < 4; ++p) { const int s = p * 32 + rr;
        float y[8];
#pragma unroll
        for (int i = 0; i < 8; ++i) y[i] = bb[i];
#pragma unroll
        for (int j = 0; j < 4; ++j) { const int t = t0 + s - j;
            v4u rv = {0u, 0u, 0u, 0u};
            if (t >= 0) rv = *(const v4u*)(raw + (size_t)t * 512 + cg * 8);
            y[0] += w[j][0] * bf_lo(rv.x); y[1] += w[j][1] * bf_hi(rv.x); y[2] += w[j][2] * bf_lo(rv.y); y[3] += w[j][3] * bf_hi(rv.y);
            y[4] += w[j][4] * bf_lo(rv.z); y[5] += w[j][5] * bf_hi(rv.z); y[6] += w[j][6] * bf_lo(rv.w); y[7] += w[j][7] * bf_hi(rv.w); }
#pragma unroll
        for (int i = 0; i < 8; ++i) y[i] = siluf_fast(y[i]) * scale;
        if (!TRANS) { v4u o; o.x = cvtpk(y[0], y[1]); o.y = cvtpk(y[2], y[3]); o.z = cvtpk(y[4], y[5]); o.w = cvtpk(y[6], y[7]); *(LAS v4u*)(dst + s * 136 + cg * 8) = o; }
        else {
#pragma unroll
            for (int i = 0; i < 8; ++i) dst[(cg * 8 + i) * 136 + s] = (bf16)f2bf(y[i]); }
    }
}
__device__ __forceinline__ void scan_add128(float a0, float a1, int lane, float& o0, float& o1) {
    float v = a0 + a1;
#pragma unroll
    for (int d = 1; d < 64; d <<= 1) { const float t = __shfl_up(v, d); if (lane >= d) v += t; }
    const float exv = v - (a0 + a1); o0 = exv + a0; o1 = exv + a0 + a1;
}
__device__ __forceinline__ void scan_max128(float a0, float a1, int lane, float& o0, float& o1) {
    float v = fmaxf(a0, a1);
#pragma unroll
    for (int d = 1; d < 64; d <<= 1) { const float t = __shfl_up(v, d); if (lane >= d) v = fmaxf(v, t); }
    float pv = __shfl_up(v, 1); if (lane == 0) pv = -INFINITY;
    o0 = fmaxf(pv, a0); o1 = fmaxf(o0, a1);
}

constexpr int ML_T0 = 0, ML_T1 = 34816, ML_T2 = 69632, ML_SM = 104448;
__device__ __forceinline__ void mla_unit(Frame& F, int u) {
    const int tid = F.tid, lane = F.lane, wave = F.wave, r32 = lane & 31, hi = lane >> 5;
    const int bhd = u >> 6, ch = u & 63, b = bhd >> 2, hd = bhd & 3;
    const size_t rowbase = (size_t)b * SEQ; const int t0 = ch * 128;
    LAS unsigned char* L = F.lds + RING_OFF;
    LAS bf16* KT = (LAS bf16*)(L + ML_T0); LAS bf16* VT = (LAS bf16*)(L + ML_T1);
    LAS float* BC = (LAS float*)(L + ML_SM); LAS float* EE = BC + 128; LAS float* SC = BC + 256;
    const bf16* PROJ = WSP(bf16, WS_PROJ);
    const float* GI = WSP(float, WS_GI); const float* GF = WSP(float, WS_GF);
    if (wave == 0) {
        const size_t r0 = rowbase + t0 + 2 * lane;
        const float f0 = GF[r0 * 4 + hd], f1 = GF[(r0 + 1) * 4 + hd], i0 = GI[r0 * 4 + hd], i1 = GI[(r0 + 1) * 4 + hd];
        float c0, c1; scan_add128(f0, f1, lane, c0, c1);
        const float blast = __shfl(c1, 63);
        const float w0 = blast - c0 + i0, w1 = blast - c1 + i1;
        const float mloc = wave_max(fmaxf(w0, w1));
        EE[2 * lane] = __expf(w0 - mloc); EE[2 * lane + 1] = __expf(w1 - mloc);
        if (lane == 0) { float* S = WSP(float, WS_MLS); S[u] = mloc; S[1024 + u] = blast; }
    }
    ml_stage_conv<true>(F, PROJ + 4 * SLAB + rowbase * 512 + hd * 128, t0, F.in[7] + 512 + hd * 128, F.in[8] + 512 + hd * 128, 0.08838834764831845f, KT);
    __syncthreads();
    {
        const bf16* Vs = PROJ + 5 * SLAB + (rowbase + t0) * 512 + hd * 128;
        const int cg = tid & 15, rr = tid >> 4;
#pragma unroll
        for (int p = 0; p < 4; ++p) { const int s = p * 32 + rr; const float e = EE[s]; const v4u rv = *(const v4u*)(Vs + (size_t)s * 512 + cg * 8);
            LAS bf16* d = VT + (cg * 8) * 136 + s;
            d[0 * 136] = (bf16)f2bf(e * bf_lo(rv.x)); d[1 * 136] = (bf16)f2bf(e * bf_hi(rv.x)); d[2 * 136] = (bf16)f2bf(e * bf_lo(rv.y)); d[3 * 136] = (bf16)f2bf(e * bf_hi(rv.y));
            d[4 * 136] = (bf16)f2bf(e * bf_lo(rv.z)); d[5 * 136] = (bf16)f2bf(e * bf_hi(rv.z)); d[6 * 136] = (bf16)f2bf(e * bf_lo(rv.w)); d[7 * 136] = (bf16)f2bf(e * bf_hi(rv.w)); }
    }
    if (tid < 128) {
        float n = 0.f; const LAS bf16* kr = KT + tid * 136;
#pragma unroll 4
        for (int s8 = 0; s8 < 16; ++s8) { const v4u kv = *(const LAS v4u*)(kr + s8 * 8); const LAS float* ep = EE + s8 * 8;
            n += ep[0] * bf_lo(kv.x) + ep[1] * bf_hi(kv.x) + ep[2] * bf_lo(kv.y) + ep[3] * bf_hi(kv.y) + ep[4] * bf_lo(kv.z) + ep[5] * bf_hi(kv.z) + ep[6] * bf_lo(kv.w) + ep[7] * bf_hi(kv.w); }
        WSP(float, WS_MLN)[(size_t)u * 128 + tid] = n;
    }
    __syncthreads();
    {
        const int dvt = wave >> 1, eh = wave & 1;
        f32x16 c0, c1;
#pragma unroll
        for (int r = 0; r < 16; ++r) { c0[r] = 0.f; c1[r] = 0.f; }
#pragma unroll
        for (int ks = 0; ks < 8; ++ks) { const bf16x8 a = *(const LAS bf16x8*)(VT + (32 * dvt + r32) * 136 + 16 * ks + 8 * hi);
            const bf16x8 b0 = *(const LAS bf16x8*)(KT + (64 * eh + r32) * 136 + 16 * ks + 8 * hi), b1 = *(const LAS bf16x8*)(KT + (64 * eh + 32 + r32) * 136 + 16 * ks + 8 * hi);
            c0 = MFMA32(a, b0, c0); c1 = MFMA32(a, b1, c1); }
        bf16* Cg = WSP(bf16, WS_C) + (size_t)u * 16384 + 64 * eh + r32;
#pragma unroll
        for (int r = 0; r < 16; ++r) { const int dv = 32 * dvt + crow(r, hi); Cg[(size_t)dv * 128] = (bf16)f2bf(c0[r]); Cg[(size_t)dv * 128 + 32] = (bf16)f2bf(c1[r]); }
    }
    __syncthreads();
}

__device__ __forceinline__ void ml_scan_item(Frame& F, int item, const size_t dummy = 0) {
    const int tid = F.tid; const int bhd = item >> 4, part = item & 15;
    LAS float* SM = (LAS float*)(F.lds + RING_OFF);
    float* S = WSP(float, WS_MLS);
    if (tid < 64) SM[tid] = S[bhd * 64 + tid]; else if (tid < 128) SM[tid] = S[1024 + bhd * 64 + (tid - 64)];
    unsigned* Cw = WSP(unsigned, WS_C) + (size_t)bhd * 64 * 8192 + (size_t)(part * 8 + (tid >> 6)) * 64 + (tid & 63);
    unsigned cl[64];
#pragma unroll
    for (int j = 0; j < 64; ++j) cl[j] = Cw[(size_t)j * 8192];
    const bool do_n = (part == 0 && tid < 128);
    float* Nw = WSP(float, WS_MLN) + (size_t)bhd * 64 * 128 + (tid & 127);
    float nlv[64];
#pragma unroll
    for (int j = 0; j < 64; ++j) nlv[j] = do_n ? Nw[(size_t)j * 128] : 0.f;
    __syncthreads();
    float c0 = 0.f, c1 = 0.f, m = 0.f, n = 0.f;
#pragma unroll
    for (int j = 0; j < 64; ++j) {
        const float ml = SM[j], bl = SM[64 + j];
        (dummy ? (unsigned*)(F.ws + dummy) + (Cw - WSP(unsigned, WS_C)) : Cw)[(size_t)j * 8192] = cvtpk(c0, c1);
        const float nl = nlv[j]; if (do_n) (dummy ? (float*)(F.ws + dummy + 40 * MiB) + (Nw - WSP(float, WS_MLN)) : Nw)[(size_t)j * 128] = n;
        if (part == 0 && tid == 0) (dummy ? (float*)(F.ws + dummy + 48 * MiB) : S)[2048 + bhd * 64 + j] = m;
        const float mn = fmaxf(bl + m, ml), a = __expf(bl + m - mn), g = __expf(ml - mn);
        c0 = a * c0 + g * bf_lo(cl[j]); c1 = a * c1 + g * bf_hi(cl[j]); n = a * n + g * nl; m = mn;
    }
    __syncthreads();
}

__device__ __forceinline__ void mlc_unit(Frame& F, int u) {
    const int tid = F.tid, lane = F.lane, wave = F.wave, r32 = lane & 31, hi = lane >> 5;
    const int bhd = u >> 6, ch = u & 63, b = bhd >> 2, hd = bhd & 3;
    const size_t rowbase = (size_t)b * SEQ; const int t0 = ch * 128;
    LAS unsigned char* L = F.lds + RING_OFF;
    LAS bf16* QS = (LAS bf16*)(L + ML_T0); LAS bf16* KS = (LAS bf16*)(L + ML_T1); LAS bf16* VT = (LAS bf16*)(L + ML_T2);
    LAS float* AA = (LAS float*)(L + ML_SM); LAS float* MM = AA + 128; LAS float* AT = AA + 256; LAS float* EM = AA + 384; LAS float* NP = AA + 512; LAS float* NQ = AA + 640; LAS float* INV = AA + 768;
    const bf16* PROJ = WSP(bf16, WS_PROJ);
    const float* GI = WSP(float, WS_GI); const float* GF = WSP(float, WS_GF);
    const float mprev = WSP(float, WS_MLS)[2048 + u];
    if (wave == 0) {
        const size_t r0 = rowbase + t0 + 2 * lane;
        const float f0 = GF[r0 * 4 + hd], f1 = GF[(r0 + 1) * 4 + hd], i0 = GI[r0 * 4 + hd], i1 = GI[(r0 + 1) * 4 + hd];
        float c0, c1; scan_add128(f0, f1, lane, c0, c1);
        const float a0 = i0 - c0, a1 = i1 - c1;
        float p0, p1; scan_max128(a0, a1, lane, p0, p1);
        const float m0 = fmaxf(mprev, p0), m1 = fmaxf(mprev, p1);
        AA[2 * lane] = a0; AA[2 * lane + 1] = a1; MM[2 * lane] = m0; MM[2 * lane + 1] = m1;
        AT[2 * lane] = __expf(mprev - m0); AT[2 * lane + 1] = __expf(mprev - m1);
        EM[2 * lane] = __expf(-(c0 + m0)); EM[2 * lane + 1] = __expf(-(c1 + m1));
    } else if (wave == 1) {
        const float* Np = WSP(float, WS_MLN) + (size_t)u * 128; NP[2 * lane] = Np[2 * lane]; NP[2 * lane + 1] = Np[2 * lane + 1];
    }
    ml_stage_conv<false>(F, PROJ + 3 * SLAB + rowbase * 512 + hd * 128, t0, F.in[7] + hd * 128, F.in[8] + hd * 128, 1.0f, QS);
    ml_stage_conv<false>(F, PROJ + 4 * SLAB + rowbase * 512 + hd * 128, t0, F.in[7] + 512 + hd * 128, F.in[8] + 512 + hd * 128, 0.08838834764831845f, KS);
    {
        const bf16* Vs = PROJ + 5 * SLAB + (rowbase + t0) * 512 + hd * 128;
        const int cg = tid & 15, rr = tid >> 4;
#pragma unroll
        for (int p = 0; p < 4; ++p) { const int s = p * 32 + rr; const v4u rv = *(const v4u*)(Vs + (size_t)s * 512 + cg * 8);
            LAS bf16* d = VT + (cg * 8) * 136 + s;
            d[0 * 136] = (bf16)(rv.x & 0xffffu); d[1 * 136] = (bf16)(rv.x >> 16); d[2 * 136] = (bf16)(rv.y & 0xffffu); d[3 * 136] = (bf16)(rv.y >> 16);
            d[4 * 136] = (bf16)(rv.z & 0xffffu); d[5 * 136] = (bf16)(rv.z >> 16); d[6 * 136] = (bf16)(rv.w & 0xffffu); d[7 * 136] = (bf16)(rv.w >> 16); }
    }
    __syncthreads();
    if (tid < 128) {
        float n = 0.f; const LAS bf16* qrow = QS + tid * 136;
#pragma unroll 4
        for (int e8 = 0; e8 < 16; ++e8) { const v4u qv = *(const LAS v4u*)(qrow + e8 * 8); const LAS float* np = NP + e8 * 8;
            n += np[0] * bf_lo(qv.x) + np[1] * bf_hi(qv.x) + np[2] * bf_lo(qv.y) + np[3] * bf_hi(qv.y) + np[4] * bf_lo(qv.z) + np[5] * bf_hi(qv.z) + np[6] * bf_lo(qv.w) + np[7] * bf_hi(qv.w); }
        NQ[tid] = n;
    }
    const int tt = wave >> 1, dh = wave & 1;
    f32x16 acc0, acc1;
#pragma unroll
    for (int r = 0; r < 16; ++r) { acc0[r] = 0.f; acc1[r] = 0.f; }
    {
        const bf16* Cg = WSP(bf16, WS_C) + (size_t)u * 16384;
#pragma unroll
        for (int ks = 0; ks < 8; ++ks) { const bf16x8 a = *(const LAS bf16x8*)(QS + (32 * tt + r32) * 136 + 16 * ks + 8 * hi);
            const bf16x8 b0 = *(const bf16x8*)(Cg + (size_t)(64 * dh + r32) * 128 + 16 * ks + 8 * hi), b1 = *(const bf16x8*)(Cg + (size_t)(64 * dh + 32 + r32) * 128 + 16 * ks + 8 * hi);
            acc0 = MFMA32(a, b0, acc0); acc1 = MFMA32(a, b1, acc1); }
#pragma unroll
        for (int r = 0; r < 16; ++r) { const float at = AT[32 * tt + crow(r, hi)]; acc0[r] *= at; acc1[r] *= at; }
    }
    float den = 0.f;
    const int tg = 32 * tt + r32; const float mmt = MM[tg];
    for (int st = 0; st <= tt; ++st) {
        f32x16 sT;
#pragma unroll
        for (int r = 0; r < 16; ++r) sT[r] = 0.f;
#pragma unroll
        for (int ks = 0; ks < 8; ++ks) { const bf16x8 a = *(const LAS bf16x8*)(KS + (32 * st + r32) * 136 + 16 * ks + 8 * hi); const bf16x8 bq = *(const LAS bf16x8*)(QS + (32 * tt + r32) * 136 + 16 * ks + 8 * hi);
            sT = MFMA32(a, bq, sT); }
        float p[16];
#pragma unroll
        for (int r = 0; r < 16; ++r) { const int s = 32 * st + crow(r, hi); const float wgt = (s <= tg) ? __expf(AA[s] - mmt) : 0.f; p[r] = sT[r] * wgt; den += p[r]; }
#pragma unroll
        for (int s2 = 0; s2 < 2; ++s2) { v4u av; av.x = cvtpk(p[8 * s2], p[8 * s2 + 1]); av.y = cvtpk(p[8 * s2 + 2], p[8 * s2 + 3]); av.z = cvtpk(p[8 * s2 + 4], p[8 * s2 + 5]); av.w = cvtpk(p[8 * s2 + 6], p[8 * s2 + 7]);
            const bf16x8 a = __builtin_bit_cast(bf16x8, av);
#pragma unroll
            for (int d = 0; d < 2; ++d) { const LAS bf16* vp = VT + (64 * dh + 32 * d + r32) * 136 + 32 * st + 16 * s2 + 4 * hi;
                const u32x2 b0 = *(const LAS u32x2*)vp, b1 = *(const LAS u32x2*)(vp + 8);
                v4u bv; bv.x = b0.x; bv.y = b0.y; bv.z = b1.x; bv.w = b1.y; const bf16x8 bb = __builtin_bit_cast(bf16x8, bv);
                if (d == 0) acc0 = MFMA32(a, bb, acc0); else acc1 = MFMA32(a, bb, acc1); } }
    }
    { auto rr = __builtin_amdgcn_permlane32_swap(__float_as_uint(den), __float_as_uint(den), false, false); den = __uint_as_float(rr[0]) + __uint_as_float(rr[1]); }
    __syncthreads();
    if (dh == 0 && hi == 0) { const float dn = AT[tg] * NQ[tg] + den; INV[tg] = 1.0f / fmaxf(fabsf(dn), EM[tg]); }
    __syncthreads();
    {
        const bf16* Og = PROJ + 6 * SLAB + (rowbase + t0) * 512 + hd * 128 + 64 * dh + r32;
        bf16* Out = WSP(bf16, WS_OCAT) + (rowbase + t0) * 1024 + 512 + hd * 128 + 64 * dh + r32;
#pragma unroll
        for (int r = 0; r < 16; ++r) { const int t = 32 * tt + crow(r, hi); const float iv = INV[t];
            const float g0 = sigmoidf_fast(bf_lo((unsigned)Og[(size_t)t * 512])), g1 = sigmoidf_fast(bf_lo((unsigned)Og[(size_t)t * 512 + 32]));
            Out[(size_t)t * 1024] = (bf16)f2bf(acc0[r] * iv * g0); Out[(size_t)t * 1024 + 32] = (bf16)f2bf(acc1[r] * iv * g1); }
    }
    __syncthreads();
}
__device__ __forceinline__ void p7_ln1_tables(Frame& F) {
    const int gw = F.vcu * NWAVES + F.wave, NGW = F.G * NWAVES, lane = F.lane;
    const float* g1 = F.in[12]; const float* b1 = F.in[13];
    f32x4 gv[4], bv[4];
#pragma unroll
    for (int j = 0; j < 4; ++j) { gv[j] = *(const f32x4*)(g1 + 256 * j + 4 * lane); bv[j] = *(const f32x4*)(b1 + 256 * j + 4 * lane); }
    const bf16* MIX = WSP(bf16, WS_PRE1); bf16* H1B = WSP(bf16, WS_H1B); const float* x = F.in[0]; const float* stats = WSP(float, WS_STATS);
    f32x4 g0v[4], b0v[4];
#pragma unroll
    for (int j = 0; j < 4; ++j) { g0v[j] = *(const f32x4*)(F.in[2] + 256 * j + 4 * lane); b0v[j] = *(const f32x4*)(F.in[3] + 256 * j + 4 * lane); }
    f32x4 xn[4]; u32x2 mn4[4]; f32x2 stn = {0.f, 1.f};
    if (gw < M) { stn = *(const f32x2*)(stats + (size_t)gw * 2);
#pragma unroll
        for (int j = 0; j < 4; ++j) { xn[j] = ((const GAS f32x4*)(x + (size_t)gw * DM) + lane)[64 * j]; mn4[j] = ((const GAS u32x2*)(MIX + (size_t)gw * DM) + lane)[64 * j]; } }
    for (int m = gw; m < M; m += NGW) {
        f32x4 xc[4]; u32x2 mc[4]; const f32x2 stc = stn;
#pragma unroll
        for (int j = 0; j < 4; ++j) { xc[j] = xn[j]; mc[j] = mn4[j]; }
        { const int mnx = (m + NGW < M) ? m + NGW : m; stn = *(const f32x2*)(stats + (size_t)mnx * 2);
#pragma unroll
            for (int j = 0; j < 4; ++j) { xn[j] = ((const GAS f32x4*)(x + (size_t)mnx * DM) + lane)[64 * j]; mn4[j] = ((const GAS u32x2*)(MIX + (size_t)mnx * DM) + lane)[64 * j]; } }
        __builtin_amdgcn_sched_barrier(0);
        const float mean0 = stc.x, rstd0 = stc.y;
        f32x4 v[4]; float s = 0.f;
#pragma unroll
        for (int j = 0; j < 4; ++j) { const f32x4 xv = xc[j]; const u32x2 mv = mc[j];
            const f32x4 h0 = (xv - mean0) * rstd0 * g0v[j] + b0v[j];
            v[j].x = ALPHA * h0.x + bf_lo(mv.x); v[j].y = ALPHA * h0.y + bf_hi(mv.x); v[j].z = ALPHA * h0.z + bf_lo(mv.y); v[j].w = ALPHA * h0.w + bf_hi(mv.y);
            s += (v[j].x + v[j].y) + (v[j].z + v[j].w); }
        const float mean = wave_sum(s) * (1.f / DM); float s2 = 0.f;
#pragma unroll
        for (int j = 0; j < 4; ++j) { v[j] = v[j] - mean; s2 += (v[j].x * v[j].x + v[j].y * v[j].y) + (v[j].z * v[j].z + v[j].w * v[j].w); }
        const float rstd = 1.f / sqrtf(wave_sum(s2) * (1.f / DM) + LN_EPS);
        GAS unsigned long long* o8 = (GAS unsigned long long*)(H1B + (size_t)m * DM) + lane;
#pragma unroll
        for (int j = 0; j < 4; ++j) { const f32x4 y = v[j] * rstd * gv[j] + bv[j]; o8[64 * j] = (unsigned long long)pk2(y.x, y.y) | ((unsigned long long)pk2(y.z, y.w) << 32); }
    }
    const size_t nchunk = (size_t)16384 * 1024 / 16, stride = (size_t)F.G * NWAVES * 64;
#pragma unroll 1
    for (int tb = 0; tb < 2; ++tb) { const float* src = F.in[17 + tb]; unsigned char* dst = WSP(unsigned char, tb == 0 ? WS_UT : WS_VT); const float sc = tb == 0 ? U_SCALE : V_SCALE;
        for (size_t i = (size_t)F.vcu * NWAVES * 64 + F.tid; i < nchunk; i += stride) {
            v4u o;
#pragma unroll
            for (int w = 0; w < 4; ++w) { const f32x4 a = *(const GAS f32x4*)(src + i * 16 + w * 4); int pk = 0;
                pk = __builtin_amdgcn_cvt_pk_fp8_f32(a.x * sc, a.y * sc, pk, false); pk = __builtin_amdgcn_cvt_pk_fp8_f32(a.z * sc, a.w * sc, pk, true); o[w] = (unsigned)pk; }
            *(GAS v4u*)(dst + i * 16) = o; } }
}

constexpr int RT_K1 = 0, RT_K2 = 34816, RT_VL = 69632, RT_FL = 102400;
#define CE_DESC(a, b) do { const float hi_ = fmaxf(a, b), lo_ = fminf(a, b); a = hi_; b = lo_; } while (0)
__device__ __forceinline__ void sort16_desc(f32x16& v) {
#pragma unroll
    for (int k = 2; k <= 16; k <<= 1)
#pragma unroll
        for (int j = k >> 1; j > 0; j >>= 1)
#pragma unroll
            for (int i = 0; i < 16; ++i) { const int l = i ^ j; if (l > i) { float a = v[i], b = v[l]; if ((i & k) == 0) { CE_DESC(a, b); } else { CE_DESC(b, a); } v[i] = a; v[l] = b; } }
}
__device__ __forceinline__ void merge16_desc(f32x16& a, const f32x16& b) {
#pragma unroll
    for (int i = 0; i < 16; ++i) a[i] = fmaxf(a[i], b[15 - i]);
#pragma unroll
    for (int j = 8; j > 0; j >>= 1)
#pragma unroll
        for (int i = 0; i < 16; ++i) { const int l = i ^ j; if (l > i) { float x = a[i], y = a[l]; CE_DESC(x, y); a[i] = x; a[l] = y; } }
}
__host__ __device__ constexpr int cand_ij(int n) { int c = 0; for (int i = 0; i < 16; ++i) for (int j = 0; j < 16; ++j) if ((i + 1) * (j + 1) <= 16) { if (c == n) return i * 16 + j; ++c; } return 0; }
__device__ __forceinline__ void p9_route(Frame& F) {
    const int tid = F.tid, lane = F.lane, wave = F.wave, r32 = lane & 31, hi = lane >> 5;
    LAS unsigned char* L = F.lds + RING_OFF;
    for (int i = tid; i < 2 * 128 * 32; i += NWAVES * 64) { const int which = i >> 12, row = (i >> 5) & 127, c4 = (i & 31) * 4;
        const f32x4 a = *(const f32x4*)(F.in[15 + which] + row * 128 + c4);
        u32x2 o; o.x = pk2(a.x, a.y); o.y = pk2(a.z, a.w);
        *(LAS u32x2*)(L + (which ? RT_K2 : RT_K1) + row * 272 + c4 * 2) = o; }
    __syncthreads();
    const bf16* Q = WSP(bf16, WS_Q); int* IDX = WSP(int, WS_IDX); float* GATE = WSP(float, WS_GATE);
    LAS float* VL = (LAS float*)(L + RT_VL) + (wave * 32 + r32) * 32;
    const int gw = F.vcu * NWAVES + wave, NGW = F.G * NWAVES;
    for (int unit = gw; unit < (M / 32) * 8; unit += NGW) {
        const int tg = unit >> 3, hd = unit & 7; const size_t tok = (size_t)tg * 32 + r32;
        const bf16* qp = Q + tok * 2048 + hd * 256;
        f32x16 top[2];
#pragma unroll
        for (int half = 0; half < 2; ++half) {
            f32x16 s0, s1, s2, s3;
#pragma unroll
            for (int r = 0; r < 16; ++r) { s0[r] = 0.f; s1[r] = 0.f; s2[r] = 0.f; s3[r] = 0.f; }
            const LAS unsigned char* KB = L + (half ? RT_K2 : RT_K1);
#pragma unroll
            for (int ks = 0; ks < 8; ++ks) { const bf16x8 bq = *(const bf16x8*)(qp + half * 128 + ks * 16 + hi * 8);
                const LAS unsigned char* ka = KB + r32 * 272 + (16 * ks + 8 * hi) * 2;
                s0 = MFMA32(*(const LAS bf16x8*)(ka), bq, s0); s1 = MFMA32(*(const LAS bf16x8*)(ka + 32 * 272), bq, s1);
                s2 = MFMA32(*(const LAS bf16x8*)(ka + 64 * 272), bq, s2); s3 = MFMA32(*(const LAS bf16x8*)(ka + 96 * 272), bq, s3); }
#pragma unroll
            for (int r = 0; r < 16; ++r) { const unsigned key = (unsigned)crow(r, hi);
                s0[r] = __uint_as_float((__float_as_uint(s0[r]) & ~127u) | key); s1[r] = __uint_as_float((__float_as_uint(s1[r]) & ~127u) | (key + 32u));
                s2[r] = __uint_as_float((__float_as_uint(s2[r]) & ~127u) | (key + 64u)); s3[r] = __uint_as_float((__float_as_uint(s3[r]) & ~127u) | (key + 96u)); }
            sort16_desc(s0); sort16_desc(s1); sort16_desc(s2); sort16_desc(s3);
            merge16_desc(s0, s1); merge16_desc(s2, s3); merge16_desc(s0, s2);
            f32x16 pa, pb;
#pragma unroll
            for (int i = 0; i < 16; ++i) { auto rr = __builtin_amdgcn_permlane32_swap(__float_as_uint(s0[i]), __float_as_uint(s0[i]), false, false); pa[i] = __uint_as_float(rr[0]); pb[i] = __uint_as_float(rr[1]); }
            merge16_desc(pa, pb);
            top[half] = pa;
        }
        if (hi == 0) {
#pragma unroll
            for (int i = 0; i < 16; ++i) { VL[i] = top[0][i]; VL[16 + i] = top[1][i]; } }
        float l1[16], l2[16];
#pragma unroll
        for (int i = 0; i < 16; ++i) { l1[i] = __uint_as_float(__float_as_uint(top[0][i]) & ~127u); l2[i] = __uint_as_float(__float_as_uint(top[1][i]) & ~127u); }
        f32x16 c0, c1, c2, c3;
        {
            int n = 0;
#pragma unroll
            for (int i = 0; i < 16; ++i)
#pragma unroll
                for (int j = 0; j < 16; ++j) if ((i + 1) * (j + 1) <= 16) { const float cv = __uint_as_float((__float_as_uint(l1[i] + l2[j]) & ~255u) | (unsigned)(i * 16 + j));
                    if (n < 16) c0[n & 15] = cv; else if (n < 32) c1[n & 15] = cv; else if (n < 48) c2[n & 15] = cv; else c3[n & 15] = cv; ++n; }
        }
#pragma unroll
        for (int m = 2; m < 16; ++m) c3[m] = -INFINITY;
        sort16_desc(c0); sort16_desc(c1); sort16_desc(c2); sort16_desc(c3);
        merge16_desc(c0, c1); merge16_desc(c2, c3); merge16_desc(c0, c2);
        const f32x16 fa = c0;
        const float topv = __uint_as_float(__float_as_uint(fa[0]) & ~255u);
        float esum = 0.f, ev[8]; int ex[8];
#pragma unroll
        for (int k = 0; k < 16; ++k) { const unsigned bits = __float_as_uint(fa[k]); const float e = __expf(__uint_as_float(bits & ~255u) - topv); esum += e;
            if ((k >> 3) == hi) { ev[k & 7] = e; const int ci = (bits >> 4) & 15, cj = bits & 15;
                ex[k & 7] = (int)((__float_as_uint(VL[ci]) & 127u) * 128u + (__float_as_uint(VL[16 + cj]) & 127u)); } }
        const float inv = 1.0f / esum;
        int* ip = IDX + tok * 128 + hd * 16 + hi * 8; float* gp = GATE + tok * 128 + hd * 16 + hi * 8;
        *(int4*)ip = make_int4(ex[0], ex[1], ex[2], ex[3]); *(int4*)(ip + 4) = make_int4(ex[4], ex[5], ex[6], ex[7]);
        *(f32x4*)gp = (f32x4){ev[0] * inv, ev[1] * inv, ev[2] * inv, ev[3] * inv}; *(f32x4*)(gp + 4) = (f32x4){ev[4] * inv, ev[5] * inv, ev[6] * inv, ev[7] * inv};
    }
    __syncthreads();
}

__device__ __forceinline__ float gelu_erf(float x) { return 0.5f * x * (1.0f + erff(x * 0.70710678118654752f)); }
__device__ __forceinline__ float dot16_fp8(const v4u& u, const float (&h)[16], float acc) {
    f32x2 a2 = {acc, 0.f};
#pragma unroll
    for (int w = 0; w < 4; ++w) { const f32x2 a = __builtin_amdgcn_cvt_pk_f32_fp8((int)u[w], false), b = __builtin_amdgcn_cvt_pk_f32_fp8((int)u[w], true);
        a2 = __builtin_elementwise_fma(a, (f32x2){h[4 * w], h[4 * w + 1]}, a2); a2 = __builtin_elementwise_fma(b, (f32x2){h[4 * w + 2], h[4 * w + 3]}, a2); }
    return a2.x + a2.y;
}
__device__ __forceinline__ void axpy16_fp8(float (&acc)[16], const v4u& v, float c) {
#pragma unroll
    for (int w = 0; w < 4; ++w) { const f32x2 a = __builtin_amdgcn_cvt_pk_f32_fp8((int)v[w], false), b = __builtin_amdgcn_cvt_pk_f32_fp8((int)v[w], true);
        acc[4 * w] = fmaf(c, a.x, acc[4 * w]); acc[4 * w + 1] = fmaf(c, a.y, acc[4 * w + 1]); acc[4 * w + 2] = fmaf(c, b.x, acc[4 * w + 2]); acc[4 * w + 3] = fmaf(c, b.y, acc[4 * w + 3]); }
}
__device__ __forceinline__ void unpack16(const v4u& a, const v4u& b, float (&h)[16]) {
    h[0] = bf_lo(a.x); h[1] = bf_hi(a.x); h[2] = bf_lo(a.y); h[3] = bf_hi(a.y); h[4] = bf_lo(a.z); h[5] = bf_hi(a.z); h[6] = bf_lo(a.w); h[7] = bf_hi(a.w);
    h[8] = bf_lo(b.x); h[9] = bf_hi(b.x); h[10] = bf_lo(b.y); h[11] = bf_hi(b.y); h[12] = bf_lo(b.z); h[13] = bf_hi(b.z); h[14] = bf_lo(b.w); h[15] = bf_hi(b.w);
}
__device__ __forceinline__ float gelu_as(float v) {
    const float av = fabsf(v), t = __builtin_amdgcn_rcpf(fmaf(av, 0.2316418882f, 1.0f));
    float q = fmaf(t, 0.5307027145f, -0.7265760135f); q = fmaf(q, t, 0.7107068705f); q = fmaf(q, t, -0.142248368f); q = fmaf(q, t, 0.127414796f); q = q * t;
    const float e = __builtin_amdgcn_exp2f(v * v * -0.72134752044f), m = v * (q * e);
    return v < 0.f ? m : v - m;
}
#ifndef P10_TPW_DEF
#define P10_TPW_DEF 4
#endif
constexpr int P10_TPW = P10_TPW_DEF, P10_NS = 16, P10_SH = 10;
constexpr int P10_WB = 13056, P10_SIDX = 0, P10_SCF = 2048, P10_HB = 4096, P10_DESC = 12288;
#define P10_DECODE(D, T_, J_, N_) const int T_ = (D) & 3, J_ = ((D) >> 2) & 127, N_ = (D) >> 9
#define P10_ROWS(RS, BUF, DD, I) const int DD##n_ = __builtin_amdgcn_readfirstlane(DESC[(I)]); DD = DD##n_; P10_DECODE(DD##n_, t_, j_, n_); \
        const int ev_ = SIDX[t_ * 128 + j_ + min(lane & 7, max(n_ - 1, 0))]; \
        _Pragma("unroll") for (int k = 0; k < 8; ++k) { const int e_ = __builtin_amdgcn_readlane(ev_, k); BUF[k] = __builtin_bit_cast(v4u, __builtin_amdgcn_raw_buffer_load_b128(RS, voff, e_ * 1024, 0)); }
#define P10_ISSUE_U(BUF, DD, H0, H1, GG, I) do { P10_ROWS(rsU, BUF, DD, I) \
        { const LAS v4u* hp = (const LAS v4u*)(HB + t_ * 1024) + 2 * lane; H0 = hp[0]; H1 = hp[1]; } \
        GG = SCF[t_ * 128 + j_ + min(lane >> 3, max(n_ - 1, 0))]; } while (0)
#define P10_COMP_U(BUF, DD, H0, H1, GG) do { P10_DECODE(DD, t_, j_, n_); \
        float h[16]; unpack16(H0, H1, h); \
        float d[8]; _Pragma("unroll") for (int k = 0; k < 8; ++k) d[k] = dot16_fp8(BUF[k], h, 0.f); \
        const float c0 = reduce8_transposed(d, up16, up8); \
        const float act = gelu_as(c0 * (1.0f / U_SCALE)) * (1.0f / V_SCALE);       \
        if ((lane & 7) == 0 && (lane >> 3) < n_) SCF[t_ * 128 + j_ + (lane >> 3)] = GG * act; } while (0)
#define P10_ISSUE_V(BUF, DD, CV, I) do { P10_ROWS(rsV, BUF, DD, I) \
        CV = SCF[t_ * 128 + j_ + min(lane & 7, max(n_ - 1, 0))]; } while (0)
#define P10_AXPY8(ACC, BUF, CV) do { _Pragma("unroll") for (int k = 0; k < 8; ++k) { const float ck = (k < n_) ? __uint_as_float(__builtin_amdgcn_readlane(__float_as_uint(CV), k)) : 0.f; axpy16_fp8(ACC, BUF[k], ck); } } while (0)
#define P10_COMP_V(BUF, DD, CV) do { P10_DECODE(DD, t_, j_, n_); (void)j_; \
        if (t_ == 0) P10_AXPY8(acc[0], BUF, CV); else if (t_ == 1) P10_AXPY8(acc[1], BUF, CV); else if (t_ == 2) P10_AXPY8(acc[2], BUF, CV); else P10_AXPY8(acc[3], BUF, CV); } while (0)
#define P10_SB __builtin_amdgcn_sched_barrier(0)
template <int MODE> __device__ __forceinline__ void p10_experts(Frame& F, float* outp) {
    const int lane = F.lane;
    const bf16* H1B = WSP(bf16, WS_H1B); const bf16* PLE = WSP(bf16, WS_PLE); const int* IDX = WSP(int, WS_IDX); const float* GATE = WSP(float, WS_GATE);
    const auto rsU = __builtin_amdgcn_make_buffer_rsrc((void*)WSP(unsigned char, WS_UT), 0, 16384 * 1024, 0x00020000);
    const auto rsV = __builtin_amdgcn_make_buffer_rsrc((void*)WSP(unsigned char, WS_VT), 0, 16384 * 1024, 0x00020000);
    const int voff = lane * 16;
    const float* g2 = F.in[21]; const float* b2 = F.in[22];
    const bool up16 = (lane & 16) != 0, up8 = (lane & 8) != 0;
    LAS unsigned char* LW = F.lds + RING_OFF + F.wave * P10_WB;
    LAS int* SIDX = (LAS int*)(LW + P10_SIDX); LAS float* SCF = (LAS float*)(LW + P10_SCF); LAS bf16* HB = (LAS bf16*)(LW + P10_HB); LAS int* DESC = (LAS int*)(LW + P10_DESC);
    constexpr int TPB = NWAVES * P10_TPW;
    for (int blk = F.vcu; blk < M / TPB; blk += F.G) {
        const int tok0 = blk * TPB + F.wave * P10_TPW;
        int seg[P10_TPW][P10_NS + 1];
#pragma unroll
        for (int t = 0; t < P10_TPW; ++t) { const size_t tk = (size_t)(tok0 + t);
            const int i0 = IDX[tk * 128 + lane], i1 = IDX[tk * 128 + 64 + lane]; const float g0 = GATE[tk * 128 + lane], g1 = GATE[tk * 128 + 64 + lane];
            { const v4u* hp = (const v4u*)(H1B + tk * 1024) + 2 * lane; LAS v4u* hd = (LAS v4u*)(HB + t * 1024) + 2 * lane; hd[0] = hp[0]; hd[1] = hp[1]; }
            const int k0 = i0 >> P10_SH, k1 = i1 >> P10_SH; int r0 = 0, r1 = 0, base = 0;
#pragma unroll
            for (int k = 0; k < P10_NS; ++k) { const unsigned long long b0 = __ballot(k0 == k), b1 = __ballot(k1 == k);
                const int below0 = (int)__builtin_amdgcn_mbcnt_hi((unsigned)(b0 >> 32), __builtin_amdgcn_mbcnt_lo((unsigned)b0, 0u)), below1 = (int)__builtin_amdgcn_mbcnt_hi((unsigned)(b1 >> 32), __builtin_amdgcn_mbcnt_lo((unsigned)b1, 0u));
                const int n0 = __builtin_popcountll(b0), n1 = __builtin_popcountll(b1);
                r0 = (k0 == k) ? base + below0 : r0; r1 = (k1 == k) ? base + n0 + below1 : r1; seg[t][k] = base; base += n0 + n1; }
            seg[t][P10_NS] = base;
            SIDX[t * 128 + r0] = i0; SCF[t * 128 + r0] = g0; SIDX[t * 128 + r1] = i1; SCF[t * 128 + r1] = g1; }
        int nd = 0;
#pragma unroll
        for (int s = 0; s < P10_NS; ++s)
#pragma unroll
            for (int t = 0; t < P10_TPW; ++t) { for (int c = (seg[t][s] + 7) >> 3; c < (seg[t][s + 1] + 7) >> 3; ++c) { if (lane == 0) DESC[nd] = t | ((8 * c) << 2) | (8 << 9); ++nd; } }
        if (lane < 3) DESC[nd + lane] = 0;
        const int ndp = (nd + 1) & ~1;
        v4u BA[8], BB[8];
        {
            int dA, dB; v4u hA0, hA1, hB0, hB1; float gA, gB;
            P10_ISSUE_U(BA, dA, hA0, hA1, gA, 0); P10_SB;
#pragma unroll 1
            for (int i = 0; i < ndp; i += 2) {
                P10_ISSUE_U(BB, dB, hB0, hB1, gB, i + 1); P10_SB;
                P10_COMP_U(BA, dA, hA0, hA1, gA); P10_SB;
                P10_ISSUE_U(BA, dA, hA0, hA1, gA, i + 2); P10_SB;
                P10_COMP_U(BB, dB, hB0, hB1, gB); P10_SB;
            }
        }
        float acc[4][16];
#pragma unroll
        for (int t = 0; t < 4; ++t)
#pragma unroll
            for (int i = 0; i < 16; ++i) acc[t][i] = 0.f;
        {
            int dA, dB; float cA, cB;
            P10_ISSUE_V(BA, dA, cA, 0); P10_SB;
#pragma unroll 1
            for (int i = 0; i < ndp; i += 2) {
                P10_ISSUE_V(BB, dB, cB, i + 1); P10_SB;
                P10_COMP_V(BA, dA, cA); P10_SB;
                P10_ISSUE_V(BA, dA, cA, i + 2); P10_SB;
                P10_COMP_V(BB, dB, cB); P10_SB;
            }
        }
#pragma unroll
        for (int t = 0; t < P10_TPW; ++t) { const int tok = tok0 + t;
            float h[16], pl[16];
            { const LAS v4u* hp = (const LAS v4u*)(HB + t * 1024) + 2 * lane; const v4u x0_ = hp[0], x1_ = hp[1]; unpack16(x0_, x1_, h); }
            { const v4u* pp = (const v4u*)(PLE + (size_t)tok * 1024) + 2 * lane; unpack16(pp[0], pp[1], pl); }
            float y[16]; float sm = 0.f;
#pragma unroll
            for (int i = 0; i < 16; ++i) { y[i] = ALPHA * h[i] + acc[t][i] + pl[i]; sm += y[i]; }
            const float mean = wave_sum(sm) * (1.f / DM); float s2 = 0.f;
#pragma unroll
            for (int i = 0; i < 16; ++i) { y[i] -= mean; s2 += y[i] * y[i]; }
            const float rstd = 1.f / sqrtf(wave_sum(s2) * (1.f / DM) + LN_EPS);
            float* op = outp + (size_t)tok * 1024 + 16 * lane; const float* gp = g2 + 16 * lane; const float* bp = b2 + 16 * lane;
#pragma unroll
            for (int q = 0; q < 4; ++q) { const f32x4 ga = *(const f32x4*)(gp + 4 * q), ba = *(const f32x4*)(bp + 4 * q); f32x4 o;
                o.x = y[4 * q] * rstd * ga.x + ba.x; o.y = y[4 * q + 1] * rstd * ga.y + ba.y; o.z = y[4 * q + 2] * rstd * ga.z + ba.z; o.w = y[4 * q + 3] * rstd * ga.w + ba.w;
                *(f32x4*)(op + 4 * q) = o; }
        }
    }
}
struct Args { const float* in[23]; float* out; unsigned char* ws; int ph_lo, ph_hi, li, pad; };
__global__ void __launch_bounds__(NWAVES * 64, 2) fwd_kernel(Args args) {
    extern __shared__ __attribute__((aligned(16))) unsigned char lds[];
    Frame F;
    F.lds = (LAS unsigned char*)lds;
    F.MISC = (volatile LAS unsigned*)(F.lds + MISC_OFF);
    F.tid = threadIdx.x; F.lane = F.tid & 63; F.wave = __builtin_amdgcn_readfirstlane(F.tid >> 6);
    F.G = gridDim.x; { const int bx = blockIdx.x; F.vcu = (F.G % 8 == 0) ? (bx % 8) * (F.G / 8) + bx / 8 : bx; }
    F.ws = args.ws; F.out = args.out; F.in = args.in;
    F.ctl = (gu32*)(F.ws + WS_CTL);
    for (int u = F.tid; u < (LDS_BYTES - LDSCTL_OFF) / 4; u += NWAVES * 64) ((LAS unsigned*)(F.lds + LDSCTL_OFF))[u] = 0u;
    __syncthreads();
    XcdBarrier bar; bar.bar = (unsigned*)(F.ctl + CW_BAR); bar.x = 0; bar.st = nullptr;
    if (N_LAUNCHES == 1) bar = xcd_barrier_post((unsigned*)(F.ctl + CW_BAR), F.MISC + 8);
#ifdef PROBE_BAR2
#define GRID_BAR() do { if (N_LAUNCHES == 1) { xcd_barrier(bar); xcd_barrier(bar); } } while (0)
#else
#define GRID_BAR() do { if (N_LAUNCHES == 1) xcd_barrier(bar); } while (0)
#endif
    const int lo = args.ph_lo, hi = args.ph_hi;
#ifndef PH_MASK
#define PH_MASK 0x7ff
#endif
#define IN(k) (((PH_MASK >> (k)) & 1) && lo <= (k) && (k) < hi)
#define BOTH(k) (IN(k) && IN((k) + 1))
#ifndef REP_MASK
#define REP_MASK 0
#endif
#define REPS(k) for (int rep_ = 0; rep_ < 1 + ((REP_MASK >> (k)) & 1); ++rep_)
    const int bx = (int)blockIdx.x;

    if (IN(0)) { p0_prologue(F);
#ifdef PROBE_P0
        __syncthreads(); p0_prologue(F);
#endif
        if (BOTH(0)) GRID_BAR(); }

    if (IN(1)) {
        { pg8::Gemm g{WSP(bf16, WS_XN), WSP(bf16, WS_WIN_T), M, NPROJ, DM}; pg8::StaticOrder S; S.init(M, NPROJ, F.G, bx);
          pg8::EpiBf16<0> E{WSP(bf16, WS_PROJ), 512, nullptr, 512, SLAB, C2};
          pg8::gemm_phase<pg8::EpiBf16<0>, pg8::StaticOrder, PG8_ALIGN, PG8_SP2>(F.lds + RING_OFF, g, S, E); }
#ifdef PROBE_P1
        { pg8::Gemm g{WSP(bf16, WS_XN), WSP(bf16, WS_WIN_T), M, NPROJ, DM}; pg8::StaticOrder S; S.init(M, NPROJ, F.G, bx);
          pg8::EpiBf16<PROBE_P1> E{WSP(bf16, WS_PROJ), 512, nullptr, 512, SLAB, C2};
          pg8::gemm_phase<pg8::EpiBf16<PROBE_P1>, pg8::StaticOrder, PG8_ALIGN, PG8_SP2>(F.lds + RING_OFF, g, S, E); }
#endif
        if (BOTH(1)) GRID_BAR();
    }

    if (IN(2)) {
#define P2_ATTN() do { if (F.G == 256) { const int bh = F.vcu >> 3, s = F.vcu & 7; \
            for (int i = 0; i < 4; ++i) { const int qb = (i == 0) ? s : (i == 1) ? 15 - s : (i == 2) ? 16 + s : 31 - s; attn_unit(F, bh, qb); } } \
        else { for (int u = F.vcu; u < 1024; u += F.G) attn_unit(F, u >> 5, u & 31); } } while (0)
#define P2_MLA() do { for (int u = F.vcu; u < N_MLU; u += F.G) mla_unit(F, u); } while (0)
        P2_ATTN();
#ifdef PROBE_P2A
        P2_ATTN();
#endif
        P2_MLA();
#ifdef PROBE_P2B
        P2_MLA();
#endif
        if (BOTH(2)) GRID_BAR();
    }

    if (IN(3)) { for (int it = F.vcu; it < 256; it += F.G) ml_scan_item(F, it);
#ifdef PROBE_P3
        for (int it = F.vcu; it < 256; it += F.G) ml_scan_item(F, it, WS_Y);
#endif
        if (BOTH(3)) GRID_BAR(); }

    if (IN(4)) { REPS(4) for (int u = F.vcu; u < N_MLU; u += F.G) mlc_unit(F, u); if (BOTH(4)) GRID_BAR(); }

    if (IN(5)) {
        pg8::Gemm g{WSP(bf16, WS_OCAT), WSP(bf16, WS_WSB_T), M, DM, DM}; pg8::StaticOrder S; S.init(M, DM, F.G, bx);
        pg8::EpiGate2 E{WSP(bf16, WS_Y), WSP(bf16, WS_PROJ) + 7 * SLAB, WSP(bf16, WS_PROJ) + 9 * SLAB};
        pg8::gemm_phase<pg8::EpiGate2, pg8::StaticOrder, PG8_ALIGN, PG8_SP2>(F.lds + RING_OFF, g, S, E);
        if (BOTH(5)) GRID_BAR();
    }

    if (IN(6)) {
#define P6_OUTPROJ() do { pg8::Gemm g{WSP(bf16, WS_Y), WSP(bf16, WS_WOUT_T), M, DM, DM}; pg8::StaticOrder S; S.init(M, DM, F.G, bx); \
          pg8::EpiBf16<0> E{WSP(bf16, WS_PRE1), DM, nullptr, 0, 0, 1.f}; \
          pg8::gemm_phase<pg8::EpiBf16<0>, pg8::StaticOrder, PG8_ALIGN, PG8_SP2>(F.lds + RING_OFF, g, S, E); } while (0)
#define P6_PLE() do { pg8::Gemm g{WSP(bf16, WS_PB), WSP(bf16, WS_WPLE_T), M, DM, 256}; pg8::StaticOrder S; S.init(M, DM, F.G, bx); \
          pg8::EpiBf16<0> E{WSP(bf16, WS_PLE), DM, nullptr, 0, 0, 1.f}; \
          pg8::gemm_phase<pg8::EpiBf16<0>, pg8::StaticOrder, PG8_ALIGN, PG8_SP2>(F.lds + RING_OFF, g, S, E); } while (0)
        P6_OUTPROJ(); P6_PLE();
#ifdef PROBE_P6A
        P6_OUTPROJ();
#endif
#ifdef PROBE_P6B
        P6_PLE();
#endif
        if (BOTH(6)) GRID_BAR();
    }

    if (IN(7)) { REPS(7) p7_ln1_tables(F); if (BOTH(7)) GRID_BAR(); }

    if (IN(8)) {
        pg8::Gemm g{WSP(bf16, WS_H1B), WSP(bf16, WS_WQG_T), M, 3072, DM}; pg8::StaticOrder S; S.init(M, 3072, F.G, bx);
        pg8::EpiQG E{WSP(bf16, WS_Q), WSP(bf16, WS_PLE)};
        pg8::gemm_phase<pg8::EpiQG, pg8::StaticOrder, PG8_ALIGN, PG8_SP2>(F.lds + RING_OFF, g, S, E);
        if (BOTH(8)) GRID_BAR();
    }

    if (IN(9)) { REPS(9) p9_route(F); if (BOTH(9)) GRID_BAR(); }

    if (IN(10)) { p10_experts<0>(F, F.out);
#ifdef PROBE_P10
        p10_experts<PROBE_P10>(F, WSP(float, WS_PRE1));
#endif
    }
#undef IN
#undef BOTH
#undef GRID_BAR
}

extern "C" void kernel_launch(void* const* d_in, const int* in_sizes, int n_in, void* d_out, int out_size, void* d_ws, size_t ws_size, hipStream_t stream) {
    static int grid = 0;
    if (grid == 0) {
        if (n_in != 23 || in_sizes[0] != M * DM || out_size != M * DM || ws_size < WS_END) {
            fprintf(stderr, "kernel_launch: built for 23 inputs, x/out of %d floats, >= %zu bytes of workspace; got n_in %d, in0 %d, out %d, ws %zu; nothing launched\n", M * DM, (size_t)WS_END, n_in, n_in > 0 ? in_sizes[0] : -1, out_size, ws_size);
            grid = -1; return; }
        int dev = 0, cus = 0;
        if (hipGetDevice(&dev) != hipSuccess || hipDeviceGetAttribute(&cus, hipDeviceAttributeMultiprocessorCount, dev) != hipSuccess) { fprintf(stderr, "kernel_launch: device query failed\n"); grid = -1; return; }
        if (hipFuncSetAttribute((const void*)fwd_kernel, hipFuncAttributeMaxDynamicSharedMemorySize, LDS_BYTES) != hipSuccess) { fprintf(stderr, "kernel_launch: hipFuncSetAttribute failed\n"); grid = -1; return; }
        int per_cu = 0;
        if (hipOccupancyMaxActiveBlocksPerMultiprocessor(&per_cu, (const void*)fwd_kernel, NWAVES * 64, LDS_BYTES) != hipSuccess || per_cu < 1)
            fprintf(stderr, "kernel_launch: note: occupancy query reports %d workgroups per CU\n", per_cu);
        (void)hipGetLastError();
        grid = cus;
    }
    if (grid < 0) return;
    if (hipMemsetAsync((char*)d_ws + WS_CTL, 0, CTL_ZERO_BYTES, stream) != hipSuccess) { fprintf(stderr, "kernel_launch: hipMemsetAsync failed\n"); return; }
    Args a{};
    for (int i = 0; i < 23; ++i) a.in[i] = (const float*)d_in[i];
    a.out = (float*)d_out; a.ws = (unsigned char*)d_ws;
    for (int li = 0; li < N_LAUNCHES; ++li) {
        if (N_LAUNCHES == 1) { a.ph_lo = 0; a.ph_hi = N_PHASES; } else { a.ph_lo = li; a.ph_hi = li + 1; }
        a.li = li;
        hipLaunchKernelGGL(fwd_kernel, dim3(grid), dim3(NWAVES * 64), LDS_BYTES, stream, a);
        const hipError_t le = hipPeekAtLastError();
        if (le != hipSuccess) { fprintf(stderr, "kernel_launch: launch %d failed: %s\n", li, hipGetErrorName(le)); break; }
    }
}
```

```cpp
#include <hip/hip_runtime.h>
#include <cstdio>
#include <cstdint>
#include <cmath>
namespace pg8 {
#define PG8_LAS __attribute__((address_space(3)))
typedef unsigned short bf16_t;
typedef short bf16x8 __attribute__((ext_vector_type(8)));
typedef float f32x4 __attribute__((ext_vector_type(4)));
typedef unsigned u32x4 __attribute__((ext_vector_type(4)));
constexpr int BM = 256, BK = 64, HALF = 128, HTB = HALF * BK * 2  , STAGE_BYTES = 8 * HTB, NXCD = 8, WGM = 8;

__host__ __device__ __forceinline__ int lds_byte(int r, int c) { const int st = (r >> 4) * 2 + (c >> 5), rr = r & 15, cc = c & 31, ob = rr * 64 + cc * 2; return st * 1024 + (ob ^ (((ob >> 9) & 1) << 5)); }
__host__ __device__ __forceinline__ void stage_rc(int b, int& R, int& C) { const int st = b / 1024, sb = b % 1024, swz = sb ^ (((sb >> 9) & 1) << 5); R = (st >> 1) * 16 + swz / 64; C = (st & 1) * 32 + (swz % 64) / 2; }
__host__ __device__ __forceinline__ int perm32(int rho) { const int n = rho >> 4, i = rho & 15; return 8 * (i >> 2) + 4 * n + (i & 3); }

struct Unit { int pm, pn; };
struct Gemm { const bf16_t* A; const bf16_t* Bt; int M, N, K; };

struct StaticOrder {
    int nM, nN, nwg, G, c;
    __host__ __device__ void init(int M, int N, int G_, int c_) { nM = M / BM; nN = N / BM; nwg = nM * nN; G = G_; c = c_; }
    __host__ __device__ bool next(int i, Unit& u) const {
        const long L = (long)i * G + c; if (L >= nwg) return false;
        int wgid = (int)L; { const int q = nwg / NXCD, r = nwg % NXCD, xcd = wgid % NXCD, off = wgid / NXCD; wgid = (xcd < r ? xcd * (q + 1) : r * (q + 1) + (xcd - r) * q) + off; }
        const int nig = WGM * nN, gid = wgid / nig, fm = gid * WGM, gsz = (nM - fm) < WGM ? (nM - fm) : WGM;
        u.pm = fm + ((wgid % nig) % gsz); u.pn = (wgid % nig) / gsz; return true;
    }
    __device__ __forceinline__ void a_ready(const Unit&) const {}
    __device__ __forceinline__ void done(const Unit&) const {}
};

__device__ __forceinline__ unsigned cvt_pk_bf16(float lo, float hi) { unsigned r; asm volatile("v_cvt_pk_bf16_f32 %0, %1, %2" : "=v"(r) : "v"(lo), "v"(hi)); return r; }
typedef float f32x2 __attribute__((ext_vector_type(2)));
__device__ __forceinline__ f32x2 gelu_pk(f32x2 v) {
    const f32x2 av = __builtin_elementwise_abs(v), d = av * 0.2316418882f + 1.0f;
    f32x2 t; t.x = __builtin_amdgcn_rcpf(d.x); t.y = __builtin_amdgcn_rcpf(d.y);
    f32x2 q = t * 0.5307027145f + (-0.7265760135f); q = q * t + 0.7107068705f; q = q * t + (-0.142248368f); q = q * t + 0.127414796f; q = q * t;
    const f32x2 s = (v * v) * (-0.72134752044f);
    f32x2 e; e.x = __builtin_amdgcn_exp2f(s.x); e.y = __builtin_amdgcn_exp2f(s.y);
    const f32x2 m = v * (q * e), r = v - m;
    f32x2 o; o.x = v.x < 0.f ? m.x : r.x; o.y = v.y < 0.f ? m.y : r.y; return o;
}

template <int ACT  > struct EpiBf16 {
    static constexpr bool PERM = true, AFTER_DRAIN = false; static constexpr int MID_T = -1; static_assert(ACT == 0 || ACT == 1 || ACT == 7, "EpiBf16: ACT is 0 (none) or 1 (gelu_pk); 7 = timing probe without stores");
    bf16_t* O; int ldc; const float* bias; int split_cols; size_t split_stride; float scale0;
    __device__ __forceinline__ void operator()(const f32x4 (&acc)[2][2][4][2], const Unit& u, int wr, int wc, int fr, int fq) const {
        const int row0 = u.pm * BM + wr * 64 + fr; int colt = u.pn * BM; bf16_t* base = O;
        float sc = 1.f; if (split_cols) { const int t = colt / split_cols; base += (size_t)t * split_stride; colt -= t * split_cols; if (t == 0) sc = scale0; }
        const int col0 = colt + wc * 32 + 8 * fq, bcol0 = u.pn * BM + wc * 32 + 8 * fq;
        f32x4 bv[2][2];
#pragma unroll
        for (int bj = 0; bj < 2; ++bj)
#pragma unroll
            for (int n = 0; n < 2; ++n) bv[bj][n] = bias ? *(const f32x4*)(bias + bcol0 + bj * HALF + 4 * n) : (f32x4){0.f, 0.f, 0.f, 0.f};
#pragma unroll
        for (int ai = 0; ai < 2; ++ai)
#pragma unroll
            for (int m = 0; m < 4; ++m) { bf16_t* rowp = base + (size_t)(row0 + ai * HALF + m * 16) * ldc + col0;
#pragma unroll
                for (int bj = 0; bj < 2; ++bj) { f32x4 v0 = acc[ai][bj][m][0] + bv[bj][0], v1 = acc[ai][bj][m][1] + bv[bj][1];
                    if (ACT == 1) { f32x2 a = gelu_pk((f32x2){v0[0], v0[1]}), b = gelu_pk((f32x2){v0[2], v0[3]}), c = gelu_pk((f32x2){v1[0], v1[1]}), d = gelu_pk((f32x2){v1[2], v1[3]});
                        v0 = (f32x4){a.x, a.y, b.x, b.y}; v1 = (f32x4){c.x, c.y, d.x, d.y}; }
                    v0 = v0 * sc; v1 = v1 * sc; u32x4 w; w.x = cvt_pk_bf16(v0[0], v0[1]); w.y = cvt_pk_bf16(v0[2], v0[3]); w.z = cvt_pk_bf16(v1[0], v1[1]); w.w = cvt_pk_bf16(v1[2], v1[3]);
                    if (ACT != 7 || u.pm < 0) *(u32x4*)(rowp + bj * HALF) = w; } }
    }
};

struct PanelStats {
    unsigned* xbuf;
    unsigned* cnt;
    unsigned* tmo;
    int ntn; float eps;
    unsigned code;
    __device__ __forceinline__ bool run(const f32x4 (&v)[2][2][4][2], const Unit& u, int wr, int wc, int fr, int fq, PG8_LAS unsigned char* lds, int wid, int lane) const {
        typedef float f32x2v __attribute__((ext_vector_type(2)));
        PG8_LAS f32x2v* P = (PG8_LAS f32x2v*)lds;
        PG8_LAS f32x2v* S = (PG8_LAS f32x2v*)(lds + 8192);
        PG8_LAS unsigned* flag = (PG8_LAS unsigned*)(lds + 8192 + 2048);
#pragma unroll
        for (int ai = 0; ai < 2; ++ai)
#pragma unroll
            for (int m = 0; m < 4; ++m) {
                float s = 0.f;
#pragma unroll
                for (int bj = 0; bj < 2; ++bj)
#pragma unroll
                    for (int n = 0; n < 2; ++n) { const f32x4 x = v[ai][bj][m][n]; s += (x[0] + x[1]) + (x[2] + x[3]); }
                s += __shfl_xor(s, 16); s += __shfl_xor(s, 32);
                const float mw = s * (1.0f / 64.0f); float q = 0.f;
#pragma unroll
                for (int bj = 0; bj < 2; ++bj)
#pragma unroll
                    for (int n = 0; n < 2; ++n) { const f32x4 d = v[ai][bj][m][n] - mw; q += (d[0] * d[0] + d[1] * d[1]) + (d[2] * d[2] + d[3] * d[3]); }
                q += __shfl_xor(q, 16); q += __shfl_xor(q, 32);
                if (fq == 0) P[(ai * HALF + wr * 64 + m * 16 + fr) * 4 + wc] = (f32x2v){mw, q};
            }
        asm volatile("s_waitcnt lgkmcnt(0)" ::: "memory"); __builtin_amdgcn_s_barrier(); asm volatile("" ::: "memory");
#if defined(BROKEN_EXCHANGE_NO_WAIT)
#warning BROKEN CONTROL BUILD: the row-statistics exchange does not wait; results are wrong by design
        if (blockIdx.x >= 64) { const long long t0_ = clock64(); while (clock64() - t0_ < 60000) __builtin_amdgcn_s_sleep(8); }
#endif
        const int row = wid * 32 + (lane & 31);
        if (lane < 32) {
            const f32x2v a = P[row * 4 + 0], b = P[row * 4 + 1], c = P[row * 4 + 2], d = P[row * 4 + 3];
            const float mt = (a.x + b.x + c.x + d.x) * 0.25f;
            const float da = a.x - mt, db = b.x - mt, dc = c.x - mt, dd = d.x - mt;
            const float m2 = (a.y + b.y) + (c.y + d.y) + 64.0f * ((da * da + db * db) + (dc * dc + dd * dd));
            unsigned long long* slot = (unsigned long long*)xbuf + ((size_t)(u.pm * BM + row) * 4 + u.pn);
            __hip_atomic_store(slot, ((unsigned long long)__float_as_uint(m2) << 32) | __float_as_uint(mt), __ATOMIC_RELAXED, __HIP_MEMORY_SCOPE_AGENT);
        }
        asm volatile("s_waitcnt vmcnt(0)" ::: "memory");
        if (lane == 0) __hip_atomic_fetch_add(cnt + 64 * u.pm, 1u, __ATOMIC_RELAXED, __HIP_MEMORY_SCOPE_AGENT);
        if (wid == 0) {
            bool dead = false; const unsigned long long t0 = __builtin_amdgcn_s_memrealtime(); const unsigned want = 8u * (unsigned)ntn;
            for (;;) {
#if defined(BROKEN_EXCHANGE_NO_WAIT)
                break;
#endif
                if ((unsigned)__builtin_amdgcn_readfirstlane(__hip_atomic_load(cnt + 64 * u.pm, __ATOMIC_RELAXED, __HIP_MEMORY_SCOPE_AGENT)) >= want) break;
                if (__builtin_amdgcn_s_memrealtime() - t0 > 2000000ull) {
                    if (lane == 0) { unsigned expect = 0u; __hip_atomic_compare_exchange_strong(tmo + 1, &expect, code | (unsigned)(u.pm & 0xff), __ATOMIC_RELAXED, __ATOMIC_RELAXED, __HIP_MEMORY_SCOPE_AGENT);
                                     __hip_atomic_store(tmo, 1u, __ATOMIC_RELAXED, __HIP_MEMORY_SCOPE_AGENT); }
                    dead = true; break; }
                __builtin_amdgcn_s_sleep(2);
            }
            __builtin_amdgcn_fence(__ATOMIC_ACQUIRE, "agent");
            if (lane == 0) flag[0] = dead ? 1u : 0u;
        }
        asm volatile("s_waitcnt vmcnt(0) lgkmcnt(0)" ::: "memory"); __builtin_amdgcn_s_barrier(); asm volatile("" ::: "memory");
        const bool bad = flag[0] != 0u;
        if (lane < 32) {
            const unsigned long long* slot = (const unsigned long long*)xbuf + (size_t)(u.pm * BM + row) * 4; float mt[4], m2[4]; float ms = 0.f;
#pragma unroll
            for (int t = 0; t < 4; ++t) { if (t < ntn) { const unsigned long long w = __hip_atomic_load(slot + t, __ATOMIC_RELAXED, __HIP_MEMORY_SCOPE_AGENT); mt[t] = __uint_as_float((unsigned)w); m2[t] = __uint_as_float((unsigned)(w >> 32)); } else { mt[t] = 0.f; m2[t] = 0.f; } ms += mt[t]; }
            const float mean = ms / (float)ntn; float q = 0.f;
#pragma unroll
            for (int t = 0; t < 4; ++t) if (t < ntn) { const float dm = mt[t] - mean; q += m2[t] + 256.0f * dm * dm; }
            S[row] = (f32x2v){mean, 1.0f / sqrtf(q / (256.0f * (float)ntn) + eps)};
        }
        asm volatile("s_waitcnt lgkmcnt(0)" ::: "memory"); __builtin_amdgcn_s_barrier(); asm volatile("" ::: "memory");
        return bad;
    }
};
struct EpiLnRes {
    static constexpr bool PERM = false, AFTER_DRAIN = true; static constexpr int MID_T = -1;
    const float* base; float* out; int ldc; const float* bias; PanelStats st; unsigned poison;
    __device__ __forceinline__ void fused(f32x4 (&acc)[2][2][4][2], const Unit& u, int wr, int wc, int fr, int fq, PG8_LAS unsigned char* lds, int wid, int lane) const {
        typedef float f32x2v __attribute__((ext_vector_type(2)));
        const PG8_LAS f32x2v* S = (const PG8_LAS f32x2v*)(lds + 8192);
        const int col0 = u.pn * BM + wc * 32 + 4 * fq;
#pragma unroll
        for (int bj = 0; bj < 2; ++bj)
#pragma unroll
            for (int n = 0; n < 2; ++n) { const f32x4 bv = bias ? *(const f32x4*)(bias + col0 + bj * HALF + n * 16) : (f32x4){0.f, 0.f, 0.f, 0.f};
#pragma unroll
                for (int ai = 0; ai < 2; ++ai)
#pragma unroll
                    for (int m = 0; m < 4; ++m) acc[ai][bj][m][n] += bv; }
        f32x4 pre[4][2][2];
#pragma unroll
        for (int m = 0; m < 4; ++m) { const size_t off = (size_t)(u.pm * BM + wr * 64 + m * 16 + fr) * ldc + col0;
#pragma unroll
            for (int bj = 0; bj < 2; ++bj)
#pragma unroll
                for (int n = 0; n < 2; ++n) pre[m][bj][n] = *(const f32x4*)(base + off + bj * HALF + n * 16); }
        const bool bad = st.run(acc, u, wr, wc, fr, fq, lds, wid, lane) || poison != 0u;
        const float qnan = __builtin_nanf("");
#pragma unroll
        for (int ai = 0; ai < 2; ++ai)
#pragma unroll
            for (int m = 0; m < 4; ++m) { const int r = ai * HALF + wr * 64 + m * 16 + fr; const f32x2v sr = S[r]; const size_t off = (size_t)(u.pm * BM + r) * ldc + col0;
#pragma unroll
                for (int bj = 0; bj < 2; ++bj)
#pragma unroll
                    for (int n = 0; n < 2; ++n) { const f32x4 bs = ai == 0 ? pre[m][bj][n] : *(const f32x4*)(base + off + bj * HALF + n * 16); f32x4 o = bs + (acc[ai][bj][m][n] - sr.x) * sr.y;
                        if (bad) o = (f32x4){qnan, qnan, qnan, qnan}; *(f32x4*)(out + off + bj * HALF + n * 16) = o; }
                if (m & 1) asm volatile("" ::: "memory"); }
    }
};
struct EpiLnResLn {
    static constexpr bool PERM = false, AFTER_DRAIN = true; static constexpr int MID_T = -1;
    const float* base; float* out; bf16_t* xn; int ldc; const float* bias; PanelStats st1, st2; unsigned poison;
    __device__ __forceinline__ void fused(f32x4 (&acc)[2][2][4][2], const Unit& u, int wr, int wc, int fr, int fq, PG8_LAS unsigned char* lds, int wid, int lane) const {
        typedef float f32x2v __attribute__((ext_vector_type(2))); typedef unsigned u32x2v __attribute__((ext_vector_type(2)));
        const PG8_LAS f32x2v* S = (const PG8_LAS f32x2v*)(lds + 8192);
        const int col0 = u.pn * BM + wc * 32 + 4 * fq;
#pragma unroll
        for (int bj = 0; bj < 2; ++bj)
#pragma unroll
            for (int n = 0; n < 2; ++n) { const f32x4 bv = bias ? *(const f32x4*)(bias + col0 + bj * HALF + n * 16) : (f32x4){0.f, 0.f, 0.f, 0.f};
#pragma unroll
                for (int ai = 0; ai < 2; ++ai)
#pragma unroll
                    for (int m = 0; m < 4; ++m) acc[ai][bj][m][n] += bv; }
        bool bad = st1.run(acc, u, wr, wc, fr, fq, lds, wid, lane) || poison != 0u;
        const float qnan = __builtin_nanf("");
#pragma unroll
        for (int ai = 0; ai < 2; ++ai)
#pragma unroll
            for (int m = 0; m < 4; ++m) { const int r = ai * HALF + wr * 64 + m * 16 + fr; const f32x2v sr = S[r]; const size_t off = (size_t)(u.pm * BM + r) * ldc + col0;
#pragma unroll
                for (int bj = 0; bj < 2; ++bj)
#pragma unroll
                    for (int n = 0; n < 2; ++n) { const f32x4 bs = *(const f32x4*)(base + off + bj * HALF + n * 16); acc[ai][bj][m][n] = bs + (acc[ai][bj][m][n] - sr.x) * sr.y; }
                asm volatile("" : "+v"(acc[ai][0][m][0]), "+v"(acc[ai][0][m][1]), "+v"(acc[ai][1][m][0]), "+v"(acc[ai][1][m][1]));
                if (m & 1) asm volatile("" ::: "memory"); }
        const bool bad1 = bad;
        bad = st2.run(acc, u, wr, wc, fr, fq, lds, wid, lane) || bad;
#pragma unroll
        for (int ai = 0; ai < 2; ++ai)
#pragma unroll
            for (int m = 0; m < 4; ++m) { const int r = ai * HALF + wr * 64 + m * 16 + fr; const f32x2v sr = S[r]; const size_t off = (size_t)(u.pm * BM + r) * ldc + col0;
#pragma unroll
                for (int bj = 0; bj < 2; ++bj)
#pragma unroll
                    for (int n = 0; n < 2; ++n) { const f32x4 x1 = acc[ai][bj][m][n]; *(f32x4*)(out + off + bj * HALF + n * 16) = bad1 ? (f32x4){qnan, qnan, qnan, qnan} : x1;
                        const f32x4 o = (x1 - sr.x) * sr.y; u32x2v w; w.x = cvt_pk_bf16(o[0], o[1]); w.y = cvt_pk_bf16(o[2], o[3]);
                        if (bad) { w.x = 0x7fc07fc0u; w.y = 0x7fc07fc0u; } *(u32x2v*)(xn + off + bj * HALF + n * 16) = w; }
                asm volatile("" ::: "memory"); }
    }
};

template <class Epi, class Sched, bool ALIGN_EPI = false, bool SP2 = false>
__device__ __forceinline__ void gemm_phase(PG8_LAS unsigned char* lds, const Gemm g, const Sched& S, const Epi& E) {
    const int tid = threadIdx.x, wid = __builtin_amdgcn_readfirstlane(tid >> 6), lane = tid & 63, wr = wid >> 2, wc = wid & 3, fr = lane & 15, fq = lane >> 4;
    const int K = g.K, nt = K / BK;
    unsigned voffA[2], voffB[2];
#pragma unroll
    for (int i = 0; i < 2; ++i) { int R, C; stage_rc(tid * 16 + i * 8192, R, C); const int Rb = Epi::PERM ? ((R & ~31) + perm32(R & 31)) : R;
        voffA[i] = (unsigned)(R * K + C) * 2u; voffB[i] = (unsigned)(Rb * K + C) * 2u; }
    const size_t kstep = (size_t)(BK * 2);
    const size_t hstep = (size_t)HALF * K * 2;
    const size_t tstep = 2 * hstep;
    const unsigned ldsw = (unsigned)wid * 1024u;
    const int aoff = lds_byte(wr * 64 + fr, fq * 8), boff = lds_byte(wc * 32 + fr, fq * 8);
#define PG8_SA(b, h) (((b) * 2 + (h)) * HTB)
#define PG8_SB(b, h) ((4 + (b) * 2 + (h)) * HTB)
#define PG8_STAGE(bufoff, gbase, voff) do { _Pragma("unroll") for (int _i = 0; _i < 2; ++_i) \
        __builtin_amdgcn_global_load_lds((const unsigned*)((const char*)(gbase) + (voff)[_i]), (PG8_LAS unsigned*)(lds + (bufoff) + ldsw + _i * 8192), 16, 0, 0); } while (0)
#define PG8_LDA(dst, b, h) do { _Pragma("unroll") for (int m = 0; m < 4; ++m) _Pragma("unroll") for (int k = 0; k < 2; ++k) dst[m][k] = *(const PG8_LAS bf16x8*)(lds + PG8_SA(b, h) + aoff + m * 2048 + k * 1024); } while (0)
#define PG8_LDB(dst, b, h) do { _Pragma("unroll") for (int n = 0; n < 2; ++n) _Pragma("unroll") for (int k = 0; k < 2; ++k) dst[n][k] = *(const PG8_LAS bf16x8*)(lds + PG8_SB(b, h) + boff + n * 2048 + k * 1024); } while (0)
#define PG8_MMA(ai, bj, At, Bt) do { __builtin_amdgcn_s_setprio(1); _Pragma("unroll") for (int m = 0; m < 4; ++m) _Pragma("unroll") for (int n = 0; n < 2; ++n) _Pragma("unroll") for (int k = 0; k < 2; ++k) \
        acc[ai][bj][m][n] = __builtin_amdgcn_mfma_f32_16x16x32_bf16(Bt[n][k], At[m][k], acc[ai][bj][m][n], 0, 0, 0); __builtin_amdgcn_s_setprio(0); } while (0)
#define PG8_WAIT_V(n) asm volatile("s_waitcnt vmcnt(" #n ")" ::: "memory")
#define PG8_WAIT_L(n) asm volatile("s_waitcnt lgkmcnt(" #n ")" ::: "memory")
#define PG8_BAR __builtin_amdgcn_s_barrier()
#define PG8_SCHED __builtin_amdgcn_sched_barrier(0)
    Unit cur, nxt; int ui = 0;
    if (!S.next(0, cur)) return;
    f32x4 acc[2][2][4][2];
#pragma unroll
    for (int a = 0; a < 2; ++a)
#pragma unroll
        for (int b = 0; b < 2; ++b)
#pragma unroll
            for (int m = 0; m < 4; ++m)
#pragma unroll
                for (int n = 0; n < 2; ++n) acc[a][b][m][n] = (f32x4){0.f, 0.f, 0.f, 0.f};
    bf16x8 At[4][2], B0[2][2], B1[2][2];
    const char* cA = (const char*)g.A + (size_t)cur.pm * tstep; const char* cB = (const char*)g.Bt + (size_t)cur.pn * tstep;
    S.a_ready(cur);
    if constexpr (SP2) {
        PG8_STAGE(PG8_SB(0, 0), cB, voffB); PG8_STAGE(PG8_SB(0, 1), cB + hstep, voffB); PG8_STAGE(PG8_SA(0, 0), cA, voffA); PG8_STAGE(PG8_SA(0, 1), cA + hstep, voffA);
        if (wr == 1) PG8_BAR;
        PG8_WAIT_V(2); PG8_BAR;
        PG8_STAGE(PG8_SB(1, 0), cB + kstep, voffB); PG8_STAGE(PG8_SA(1, 0), cA + kstep, voffA); PG8_STAGE(PG8_SB(1, 1), cB + hstep + kstep, voffB);
        PG8_WAIT_V(6); PG8_BAR;
    } else {
        PG8_STAGE(PG8_SB(0, 0), cB, voffB); PG8_STAGE(PG8_SA(0, 0), cA, voffA); PG8_STAGE(PG8_SB(0, 1), cB + hstep, voffB); PG8_STAGE(PG8_SA(0, 1), cA + hstep, voffA);
        if (wr == 1) PG8_BAR;
        PG8_WAIT_V(4); PG8_BAR;
        PG8_STAGE(PG8_SB(1, 0), cB + kstep, voffB); PG8_STAGE(PG8_SA(1, 0), cA + kstep, voffA); PG8_STAGE(PG8_SB(1, 1), cB + hstep + kstep, voffB);
        PG8_WAIT_V(6); PG8_BAR;
    }
    for (;;) {
        const bool has_next = S.next(ui + 1, nxt);
        const char* nA = has_next ? (const char*)g.A + (size_t)nxt.pm * tstep : cA; const char* nB = has_next ? (const char*)g.Bt + (size_t)nxt.pn * tstep : cB;
        if constexpr (Epi::MID_T >= 0) {
        for (int t = 0; t < Epi::MID_T; t += 2) {
            const bool last = (t == nt - 2);
            const char* a1 = cA + (size_t)(t + 1) * kstep;
            const char* a2 = last ? nA : cA + (size_t)(t + 2) * kstep; const char* b2 = last ? nB : cB + (size_t)(t + 2) * kstep;
            const char* a3 = a2 + kstep; const char* b3 = b2 + kstep;
            if (last && has_next) S.a_ready(nxt);
            if constexpr (SP2) {
            PG8_LDB(B0, 0, 0); PG8_LDB(B1, 0, 1); PG8_SCHED; PG8_LDA(At, 0, 0); PG8_STAGE(PG8_SA(1, 1), a1 + hstep, voffA);
            PG8_WAIT_V(8); PG8_WAIT_L(0); PG8_BAR; PG8_MMA(0, 0, At, B0); PG8_MMA(0, 1, At, B1); PG8_BAR; PG8_SCHED;
            PG8_LDA(At, 0, 1); PG8_STAGE(PG8_SB(0, 0), b2, voffB); PG8_STAGE(PG8_SB(0, 1), b2 + hstep, voffB); PG8_STAGE(PG8_SA(0, 0), a2, voffA);
            PG8_WAIT_V(8); PG8_WAIT_L(0); PG8_BAR; PG8_MMA(1, 0, At, B0); PG8_MMA(1, 1, At, B1); PG8_BAR; PG8_SCHED;
            PG8_LDB(B0, 1, 0); PG8_LDB(B1, 1, 1); PG8_SCHED; PG8_LDA(At, 1, 0); PG8_STAGE(PG8_SA(0, 1), a2 + hstep, voffA);
            PG8_WAIT_V(8); PG8_WAIT_L(0); PG8_BAR; PG8_MMA(0, 0, At, B0); PG8_MMA(0, 1, At, B1); PG8_BAR; PG8_SCHED;
            PG8_LDA(At, 1, 1); PG8_STAGE(PG8_SB(1, 0), b3, voffB); PG8_STAGE(PG8_SB(1, 1), b3 + hstep, voffB); PG8_STAGE(PG8_SA(1, 0), a3, voffA);
            PG8_WAIT_V(8); PG8_WAIT_L(0); PG8_BAR; PG8_MMA(1, 0, At, B0); PG8_MMA(1, 1, At, B1); PG8_BAR; PG8_SCHED;
            } else {
            PG8_LDB(B0, 0, 0); PG8_SCHED; PG8_LDA(At, 0, 0); PG8_STAGE(PG8_SA(1, 1), a1 + hstep, voffA);
            PG8_WAIT_L(8); PG8_BAR; PG8_WAIT_L(0); PG8_MMA(0, 0, At, B0); PG8_BAR; PG8_SCHED;
            PG8_LDB(B1, 0, 1); PG8_STAGE(PG8_SB(0, 0), b2, voffB);
            PG8_BAR; PG8_WAIT_L(0); PG8_MMA(0, 1, At, B1); PG8_BAR;
            PG8_LDA(At, 0, 1); PG8_STAGE(PG8_SA(0, 0), a2, voffA);
            PG8_BAR; PG8_WAIT_L(0); PG8_MMA(1, 0, At, B0); PG8_BAR; PG8_SCHED;
            PG8_STAGE(PG8_SB(0, 1), b2 + hstep, voffB);
            PG8_WAIT_V(6); PG8_BAR; PG8_MMA(1, 1, At, B1); PG8_BAR;
            PG8_LDB(B0, 1, 0); PG8_SCHED; PG8_LDA(At, 1, 0); PG8_STAGE(PG8_SA(0, 1), a2 + hstep, voffA);
            PG8_WAIT_L(8); PG8_BAR; PG8_WAIT_L(0); PG8_MMA(0, 0, At, B0); PG8_BAR; PG8_SCHED;
            PG8_LDB(B1, 1, 1); PG8_STAGE(PG8_SB(1, 0), b3, voffB);
            PG8_BAR; PG8_WAIT_L(0); PG8_MMA(0, 1, At, B1); PG8_BAR;
            PG8_LDA(At, 1, 1); PG8_STAGE(PG8_SA(1, 0), a3, voffA);
            PG8_BAR; PG8_WAIT_L(0); PG8_MMA(1, 0, At, B0); PG8_BAR; PG8_SCHED;
            PG8_STAGE(PG8_SB(1, 1), b3 + hstep, voffB);
            PG8_WAIT_V(6); PG8_BAR; PG8_MMA(1, 1, At, B1); PG8_BAR;
            }
        }
        E.mid(acc, cur, wr, wc, fr, fq);
        for (int t = Epi::MID_T; t < nt; t += 2) {
            const bool last = (t == nt - 2);
            const char* a1 = cA + (size_t)(t + 1) * kstep;
            const char* a2 = last ? nA : cA + (size_t)(t + 2) * kstep; const char* b2 = last ? nB : cB + (size_t)(t + 2) * kstep;
            const char* a3 = a2 + kstep; const char* b3 = b2 + kstep;
            if (last && has_next) S.a_ready(nxt);
            if constexpr (SP2) {
            PG8_LDB(B0, 0, 0); PG8_LDB(B1, 0, 1); PG8_SCHED; PG8_LDA(At, 0, 0); PG8_STAGE(PG8_SA(1, 1), a1 + hstep, voffA);
            PG8_WAIT_V(8); PG8_WAIT_L(0); PG8_BAR; PG8_MMA(0, 0, At, B0); PG8_MMA(0, 1, At, B1); PG8_BAR; PG8_SCHED;
            PG8_LDA(At, 0, 1); PG8_STAGE(PG8_SB(0, 0), b2, voffB); PG8_STAGE(PG8_SB(0, 1), b2 + hstep, voffB); PG8_STAGE(PG8_SA(0, 0), a2, voffA);
            PG8_WAIT_V(8); PG8_WAIT_L(0); PG8_BAR; PG8_MMA(1, 0, At, B0); PG8_MMA(1, 1, At, B1); PG8_BAR; PG8_SCHED;
            PG8_LDB(B0, 1, 0); PG8_LDB(B1, 1, 1); PG8_SCHED; PG8_LDA(At, 1, 0); PG8_STAGE(PG8_SA(0, 1), a2 + hstep, voffA);
            PG8_WAIT_V(8); PG8_WAIT_L(0); PG8_BAR; PG8_MMA(0, 0, At, B0); PG8_MMA(0, 1, At, B1); PG8_BAR; PG8_SCHED;
            PG8_LDA(At, 1, 1); PG8_STAGE(PG8_SB(1, 0), b3, voffB); PG8_STAGE(PG8_SB(1, 1), b3 + hstep, voffB); PG8_STAGE(PG8_SA(1, 0), a3, voffA);
            PG8_WAIT_V(8); PG8_WAIT_L(0); PG8_BAR; PG8_MMA(1, 0, At, B0); PG8_MMA(1, 1, At, B1); PG8_BAR; PG8_SCHED;
            } else {
            PG8_LDB(B0, 0, 0); PG8_SCHED; PG8_LDA(At, 0, 0); PG8_STAGE(PG8_SA(1, 1), a1 + hstep, voffA);
            PG8_WAIT_L(8); PG8_BAR; PG8_WAIT_L(0); PG8_MMA(0, 0, At, B0); PG8_BAR; PG8_SCHED;
            PG8_LDB(B1, 0, 1); PG8_STAGE(PG8_SB(0, 0), b2, voffB);
            PG8_BAR; PG8_WAIT_L(0); PG8_MMA(0, 1, At, B1); PG8_BAR;
            PG8_LDA(At, 0, 1); PG8_STAGE(PG8_SA(0, 0), a2, voffA);
            PG8_BAR; PG8_WAIT_L(0); PG8_MMA(1, 0, At, B0); PG8_BAR; PG8_SCHED;
            PG8_STAGE(PG8_SB(0, 1), b2 + hstep, voffB);
            PG8_WAIT_V(6); PG8_BAR; PG8_MMA(1, 1, At, B1); PG8_BAR;
            PG8_LDB(B0, 1, 0); PG8_SCHED; PG8_LDA(At, 1, 0); PG8_STAGE(PG8_SA(0, 1), a2 + hstep, voffA);
            PG8_WAIT_L(8); PG8_BAR; PG8_WAIT_L(0); PG8_MMA(0, 0, At, B0); PG8_BAR; PG8_SCHED;
            PG8_LDB(B1, 1, 1); PG8_STAGE(PG8_SB(1, 0), b3, voffB);
            PG8_BAR; PG8_WAIT_L(0); PG8_MMA(0, 1, At, B1); PG8_BAR;
            PG8_LDA(At, 1, 1); PG8_STAGE(PG8_SA(1, 0), a3, voffA);
            PG8_BAR; PG8_WAIT_L(0); PG8_MMA(1, 0, At, B0); PG8_BAR; PG8_SCHED;
            PG8_STAGE(PG8_SB(1, 1), b3 + hstep, voffB);
            PG8_WAIT_V(6); PG8_BAR; PG8_MMA(1, 1, At, B1); PG8_BAR;
            }
        }
        } else {
        for (int t = 0; t < nt; t += 2) {
            const bool last = (t == nt - 2);
            const char* a1 = cA + (size_t)(t + 1) * kstep;
            const char* a2 = last ? nA : cA + (size_t)(t + 2) * kstep; const char* b2 = last ? nB : cB + (size_t)(t + 2) * kstep;
            const char* a3 = a2 + kstep; const char* b3 = b2 + kstep;
            if (last && has_next) S.a_ready(nxt);
            if constexpr (SP2) {
            PG8_LDB(B0, 0, 0); PG8_LDB(B1, 0, 1); PG8_SCHED; PG8_LDA(At, 0, 0); PG8_STAGE(PG8_SA(1, 1), a1 + hstep, voffA);
            PG8_WAIT_V(8); PG8_WAIT_L(0); PG8_BAR; PG8_MMA(0, 0, At, B0); PG8_MMA(0, 1, At, B1); PG8_BAR; PG8_SCHED;
            PG8_LDA(At, 0, 1); PG8_STAGE(PG8_SB(0, 0), b2, voffB); PG8_STAGE(PG8_SB(0, 1), b2 + hstep, voffB); PG8_STAGE(PG8_SA(0, 0), a2, voffA);
            PG8_WAIT_V(8); PG8_WAIT_L(0); PG8_BAR; PG8_MMA(1, 0, At, B0); PG8_MMA(1, 1, At, B1); PG8_BAR; PG8_SCHED;
            PG8_LDB(B0, 1, 0); PG8_LDB(B1, 1, 1); PG8_SCHED; PG8_LDA(At, 1, 0); PG8_STAGE(PG8_SA(0, 1), a2 + hstep, voffA);
            PG8_WAIT_V(8); PG8_WAIT_L(0); PG8_BAR; PG8_MMA(0, 0, At, B0); PG8_MMA(0, 1, At, B1); PG8_BAR; PG8_SCHED;
            PG8_LDA(At, 1, 1); PG8_STAGE(PG8_SB(1, 0), b3, voffB); PG8_STAGE(PG8_SB(1, 1), b3 + hstep, voffB); PG8_STAGE(PG8_SA(1, 0), a3, voffA);
            PG8_WAIT_V(8); PG8_WAIT_L(0); PG8_BAR; PG8_MMA(1, 0, At, B0); PG8_MMA(1, 1, At, B1); PG8_BAR; PG8_SCHED;
            } else {
            PG8_LDB(B0, 0, 0); PG8_SCHED; PG8_LDA(At, 0, 0); PG8_STAGE(PG8_SA(1, 1), a1 + hstep, voffA);
            PG8_WAIT_L(8); PG8_BAR; PG8_WAIT_L(0); PG8_MMA(0, 0, At, B0); PG8_BAR; PG8_SCHED;
            PG8_LDB(B1, 0, 1); PG8_STAGE(PG8_SB(0, 0), b2, voffB);
            PG8_BAR; PG8_WAIT_L(0); PG8_MMA(0, 1, At, B1); PG8_BAR;
            PG8_LDA(At, 0, 1); PG8_STAGE(PG8_SA(0, 0), a2, voffA);
            PG8_BAR; PG8_WAIT_L(0); PG8_MMA(1, 0, At, B0); PG8_BAR; PG8_SCHED;
            PG8_STAGE(PG8_SB(0, 1), b2 + hstep, voffB);
            PG8_WAIT_V(6); PG8_BAR; PG8_MMA(1, 1, At, B1); PG8_BAR;
            PG8_LDB(B0, 1, 0); PG8_SCHED; PG8_LDA(At, 1, 0); PG8_STAGE(PG8_SA(0, 1), a2 + hstep, voffA);
            PG8_WAIT_L(8); PG8_BAR; PG8_WAIT_L(0); PG8_MMA(0, 0, At, B0); PG8_BAR; PG8_SCHED;
            PG8_LDB(B1, 1, 1); PG8_STAGE(PG8_SB(1, 0), b3, voffB);
            PG8_BAR; PG8_WAIT_L(0); PG8_MMA(0, 1, At, B1); PG8_BAR;
            PG8_LDA(At, 1, 1); PG8_STAGE(PG8_SA(1, 0), a3, voffA);
            PG8_BAR; PG8_WAIT_L(0); PG8_MMA(1, 0, At, B0); PG8_BAR; PG8_SCHED;
            PG8_STAGE(PG8_SB(1, 1), b3 + hstep, voffB);
            PG8_WAIT_V(6); PG8_BAR; PG8_MMA(1, 1, At, B1); PG8_BAR;
            }
        }
        }
        if constexpr (ALIGN_EPI) { if (wr == 0) PG8_BAR; }
        if constexpr (!Epi::AFTER_DRAIN) { E(acc, cur, wr, wc, fr, fq); S.done(cur); }
        if (!has_next) break;
#pragma unroll
        for (int a = 0; a < 2; ++a)
#pragma unroll
            for (int b = 0; b < 2; ++b)
#pragma unroll
                for (int m = 0; m < 4; ++m)
#pragma unroll
                    for (int n = 0; n < 2; ++n) acc[a][b][m][n] = (f32x4){0.f, 0.f, 0.f, 0.f};
        cur = nxt; cA = nA; cB = nB; ++ui;
        if constexpr (ALIGN_EPI) { if (wr == 1) PG8_BAR; }
    }
    PG8_WAIT_V(0);
    if constexpr (!ALIGN_EPI) { if (wr == 0) PG8_BAR; }
    PG8_BAR;
    if constexpr (Epi::AFTER_DRAIN) { E.fused(acc, cur, wr, wc, fr, fq, lds, wid, lane); S.done(cur); }
#undef PG8_SA
#undef PG8_SB
#undef PG8_STAGE
#undef PG8_LDA
#undef PG8_LDB
#undef PG8_MMA
#undef PG8_WAIT_V
#undef PG8_WAIT_L
#undef PG8_BAR
#undef PG8_SCHED
}
}
#ifndef PG8_SP2
#define PG8_SP2 true
#endif
#ifndef PG8_ALIGN
#define PG8_ALIGN true
#endif
constexpr int NWAVES = 8;
#ifndef MK_N_LAUNCHES
#define MK_N_LAUNCHES 1
#endif
#ifndef SB_EARLY_EXIT
#define SB_EARLY_EXIT 1
#endif
constexpr int N_PHASES = 11;
constexpr int N_LAUNCHES = MK_N_LAUNCHES;

constexpr int BATCH = 4, SEQ = 8192, DM = 1024, M = BATCH * SEQ;
constexpr int INW = 5640, NPROJ = 5632, GATE_COL = 3584;
constexpr int NCHUNK = SEQ / 128;
constexpr int N_MLU = BATCH * 4 * NCHUNK;
constexpr float ALPHA = 1.18920711500272107f;
constexpr float LN_EPS = 1e-5f;
constexpr float LOG2E = 1.4426950408889634f;
constexpr float C2 = 0.125f * LOG2E;

constexpr size_t MiB = 1u << 20;
constexpr size_t WS_CTL = 0, CTL_ZERO_BYTES = 1 * MiB;
constexpr size_t WS_WIN_T = 1 * MiB;
constexpr size_t WS_WSB_T = 12 * MiB;
constexpr size_t WS_WOUT_T = 14 * MiB;
constexpr size_t WS_WQG_T = 16 * MiB;
constexpr size_t WS_WPLE_T = 22 * MiB;
constexpr size_t WS_STATS = 23 * MiB;
constexpr size_t WS_GI = 24 * MiB;
constexpr size_t WS_GF = 25 * MiB;
constexpr size_t WS_MLN = 26 * MiB;
constexpr size_t WS_MLS = 27 * MiB;
constexpr size_t WS_XN = 32 * MiB;
constexpr size_t WS_OCAT = 32 * MiB;
constexpr size_t WS_C = 448 * MiB;
constexpr size_t WS_UT = 32 * MiB;
constexpr size_t WS_VT = 48 * MiB;
constexpr float U_SCALE = 64.f, V_SCALE = 8.f;
constexpr size_t WS_PROJ = 96 * MiB;
constexpr size_t SLAB = (size_t)M * 512;
constexpr size_t WS_Y = 96 * MiB;
constexpr size_t WS_PLE = 160 * MiB;
constexpr size_t WS_H1B = 224 * MiB;
constexpr size_t WS_PRE1 = 320 * MiB;
constexpr size_t WS_Q = 320 * MiB;
constexpr size_t WS_IDX = 96 * MiB;
constexpr size_t WS_GATE = 112 * MiB;
constexpr size_t WS_PB = 480 * MiB;
constexpr size_t WS_END = 496 * MiB;
constexpr int CW_TMO = 0, CW_CODE = 1;
constexpr int CW_BAR = 4096;

constexpr int RING_OFF = 0, RING_BYTES = 131072;
constexpr int LDSCTL_OFF = RING_BYTES, MISC_OFF = LDSCTL_OFF + 320;
constexpr int LDS_BYTES = 147456;
#define GAS __attribute__((address_space(1)))
#define LAS __attribute__((address_space(3)))
typedef unsigned short bf16;
typedef unsigned v4u __attribute__((ext_vector_type(4)));
typedef float f32x4 __attribute__((ext_vector_type(4)));
typedef short bf16x8 __attribute__((ext_vector_type(8)));
typedef GAS unsigned gu32;
typedef GAS unsigned long long gu64;
#define RLX_AGENT __ATOMIC_RELAXED, __HIP_MEMORY_SCOPE_AGENT
#define LDS_WAIT() asm volatile("s_waitcnt lgkmcnt(0)" ::: "memory")
#define VM_WAIT() asm volatile("s_waitcnt vmcnt(0)" ::: "memory")
__device__ __forceinline__ unsigned long long rt() { return __builtin_amdgcn_s_memrealtime(); }
__device__ __forceinline__ unsigned f2bf(float f) { unsigned u = __builtin_bit_cast(unsigned, f); return (u + 0x7fffu + ((u >> 16) & 1u)) >> 16; }
__device__ __forceinline__ unsigned pk2(float lo, float hi) { return f2bf(lo) | (f2bf(hi) << 16); }

#define XB_TMO      128
#define XB_XCNT(j)  (256  + 64 * (j))
#define XB_XSUB(j)  (1280 + 64 * (j))
#define XB_XGEN(j)  (2304 + 64 * (j))
#define XB_TOP      3328
#define XB_TOPGEN   3392
#define XCD_BAR_WORDS 3456
#define XB_SPIN_CAP (1u << 18)

__device__ __forceinline__ unsigned xb_ld(unsigned* p)              { return __hip_atomic_load(p, __ATOMIC_RELAXED, __HIP_MEMORY_SCOPE_AGENT); }
__device__ __forceinline__ unsigned xb_add(unsigned* p, unsigned v) { return __hip_atomic_fetch_add(p, v, __ATOMIC_RELAXED, __HIP_MEMORY_SCOPE_AGENT); }
__device__ __forceinline__ unsigned xb_xcc_id() { return (unsigned)__builtin_amdgcn_s_getreg((3 << 11) | 20) & 0xFu; }
#define XB_SPIN(cond, bar) do { unsigned _sp = 0; while (cond) { __builtin_amdgcn_s_sleep(1); \
    if ((++_sp & 255u) == 0u) { if (xb_ld(&(bar)[XB_TMO])) break; if (_sp > XB_SPIN_CAP) { atomicAdd(&(bar)[XB_TMO], 1u); break; } } } } while (0)

struct XcdBarrier {
    unsigned* bar; unsigned x;
    volatile LAS unsigned* st;
};

__device__ __forceinline__ XcdBarrier xcd_barrier_post(unsigned* bar, volatile LAS unsigned* st) {
    XcdBarrier b; b.bar = bar; b.x = xb_xcc_id(); b.st = st;
    if (threadIdx.x == 0) (void)xb_add(&bar[XB_XCNT(b.x)], 1u);
    return b;
}
__device__ __forceinline__ void xcd_barrier_complete(unsigned* bar, unsigned x, unsigned& nloc, unsigned& nx) {
    const unsigned G = gridDim.x * gridDim.y * gridDim.z;
    unsigned sum, cnt, mine, sp = 0u;
    for (;;) {
        sum = 0u; cnt = 0u; mine = 0u;
#pragma unroll
        for (unsigned j = 0; j < 16; ++j) { const unsigned c = xb_ld(&bar[XB_XCNT(j)]); sum += c; cnt += (c > 0u) ? 1u : 0u; mine = (j == x) ? c : mine; }
        if (sum == G) break;
        __builtin_amdgcn_s_sleep(1);
        if ((++sp & 255u) == 0u) { if (xb_ld(&bar[XB_TMO])) break; if (sp > XB_SPIN_CAP) { atomicAdd(&bar[XB_TMO], 1u); break; } }
    }
    nloc = mine > 0u ? mine : 1u; nx = cnt > 0u ? cnt : 1u;
}

__device__ __forceinline__ void xcd_barrier(const XcdBarrier& b) {
    asm volatile("s_waitcnt vmcnt(0)" ::: "memory");
    __syncthreads();
    if (threadIdx.x == 0) {
        unsigned* bar = b.bar;
        __builtin_amdgcn_s_waitcnt(0);
        unsigned nloc = b.st[0], nx = b.st[1];
        if (nloc == 0u) { xcd_barrier_complete(bar, b.x, nloc, nx); b.st[0] = nloc; b.st[1] = nx; }
        const unsigned old = xb_add(&bar[XB_XSUB(b.x)], 1u);
        const unsigned gen = old / nloc;
        if (old + 1u == (gen + 1u) * nloc) {
            __builtin_amdgcn_fence(__ATOMIC_RELEASE, "agent");
            asm volatile("s_waitcnt vmcnt(0)" ::: "memory");
            const unsigned og = xb_add(&bar[XB_TOP], 1u);
            const unsigned tg = og / nx;
            if (og + 1u == (tg + 1u) * nx) xb_add(&bar[XB_TOPGEN], 1u);
            else XB_SPIN(xb_ld(&bar[XB_TOPGEN]) == tg, bar);
            __builtin_amdgcn_fence(__ATOMIC_ACQUIRE, "agent");
            xb_add(&bar[XB_XGEN(b.x)], 1u);
            asm volatile("s_waitcnt vmcnt(0)" ::: "memory");
        } else {
            XB_SPIN(xb_ld(&bar[XB_XGEN(b.x)]) == gen, bar);
            __builtin_amdgcn_fence(__ATOMIC_ACQUIRE, "agent");
            asm volatile("s_waitcnt vmcnt(0)" ::: "memory");
        }
    }
    __syncthreads();
}
typedef float f32x16 __attribute__((ext_vector_type(16)));
typedef float f32x2 __attribute__((ext_vector_type(2)));
typedef unsigned u32x2 __attribute__((ext_vector_type(2)));
typedef __bf16 bf16x2_t __attribute__((ext_vector_type(2)));

struct Frame {
    LAS unsigned char* lds;
    volatile LAS unsigned* MISC;
    gu32* ctl;
    int tid, lane, wave;
    int vcu, G;
    const float* const* in;
    float* out;
    unsigned char* ws;
};
#define WSP(T, off) ((T*)(F.ws + (off)))
__device__ __forceinline__ int lane_id() { int l; asm volatile("v_mbcnt_lo_u32_b32 %0, -1, 0\n\tv_mbcnt_hi_u32_b32 %0, -1, %0" : "=v"(l)); return l; }

#define DPP_F(v, CTRL) __uint_as_float((unsigned)__builtin_amdgcn_mov_dpp((int)__float_as_uint(v), (CTRL), 0xF, 0xF, true))
__device__ __forceinline__ float wave_sum(float v) {
    v += DPP_F(v, 0xB1); v += DPP_F(v, 0x4E); v += DPP_F(v, 0x141); v += DPP_F(v, 0x140);
    v += __uint_as_float((unsigned)__builtin_amdgcn_ds_swizzle((int)__float_as_uint(v), 0x401F));
    auto rr = __builtin_amdgcn_permlane32_swap(__float_as_uint(v), __float_as_uint(v), false, false);
    return __uint_as_float(rr[0]) + __uint_as_float(rr[1]);
}
__device__ __forceinline__ float wave_max(float v) {
    v = fmaxf(v, DPP_F(v, 0xB1)); v = fmaxf(v, DPP_F(v, 0x4E)); v = fmaxf(v, DPP_F(v, 0x141)); v = fmaxf(v, DPP_F(v, 0x140));
    v = fmaxf(v, __uint_as_float((unsigned)__builtin_amdgcn_ds_swizzle((int)__float_as_uint(v), 0x401F)));
    auto rr = __builtin_amdgcn_permlane32_swap(__float_as_uint(v), __float_as_uint(v), false, false);
    return fmaxf(__uint_as_float(rr[0]), __uint_as_float(rr[1]));
}
__device__ __forceinline__ float reduce8_transposed(const float (&d)[8], bool up16, bool up8) {
    float a_[4];
#pragma unroll
    for (int i = 0; i < 4; ++i) { auto rr = __builtin_amdgcn_permlane32_swap(__float_as_uint(d[i]), __float_as_uint(d[4 + i]), false, false); a_[i] = __uint_as_float(rr[0]) + __uint_as_float(rr[1]); }
    float b_[2];
#pragma unroll
    for (int i = 0; i < 2; ++i) { const float keep = up16 ? a_[2 + i] : a_[i], send = up16 ? a_[i] : a_[2 + i];
        b_[i] = keep + __uint_as_float((unsigned)__builtin_amdgcn_ds_swizzle((int)__float_as_uint(send), 0x401F)); }
    const float keep = up8 ? b_[1] : b_[0], send = up8 ? b_[0] : b_[1];
    float c0 = keep + DPP_F(send, 0x128);
    c0 += DPP_F(c0, 0x141); c0 += DPP_F(c0, 0x4E); c0 += DPP_F(c0, 0xB1);
    return c0;
}
__device__ __forceinline__ float bf_lo(unsigned u) { return __uint_as_float(u << 16); }
__device__ __forceinline__ float bf_hi(unsigned u) { return __uint_as_float(u & 0xffff0000u); }
__device__ __forceinline__ unsigned cvtpk(float lo, float hi) { f32x2 v = {lo, hi}; bf16x2_t b = __builtin_convertvector(v, bf16x2_t); return __builtin_bit_cast(unsigned, b); }
__device__ __forceinline__ float sigmoidf_fast(float x) { return __builtin_amdgcn_rcpf(1.0f + __builtin_amdgcn_exp2f(-x * LOG2E)); }
__device__ __forceinline__ float siluf_fast(float x) { return x * sigmoidf_fast(x); }
__device__ __forceinline__ int crow(int r, int hi) { return (r & 3) + 8 * (r >> 2) + 4 * hi; }
__device__ __forceinline__ float dot2_bf16(unsigned w, unsigned x, float acc) { return __builtin_amdgcn_fdot2_f32_bf16(__builtin_bit_cast(bf16x2_t, w), __builtin_bit_cast(bf16x2_t, x), acc, false); }
#define MFMA32(a, b, c) __builtin_amdgcn_mfma_f32_32x32x16_bf16((a), (b), (c), 0, 0, 0)

namespace pg8 {
template <bool ADD> struct EpiGate {
    static constexpr bool PERM = true, AFTER_DRAIN = false; static constexpr int MID_T = -1;
    bf16_t* Y; const bf16_t* G;
    __device__ __forceinline__ void operator()(const f32x4 (&acc)[2][2][4][2], const Unit& u, int wr, int wc, int fr, int fq) const {
        const int row0 = u.pm * BM + wr * 64 + fr, col0 = u.pn * BM + wc * 32 + 8 * fq;
#pragma unroll
        for (int ai = 0; ai < 2; ++ai)
#pragma unroll
            for (int m = 0; m < 4; ++m) { const size_t row = (size_t)(row0 + ai * HALF + m * 16);
#pragma unroll
                for (int bj = 0; bj < 2; ++bj) { const int col = col0 + bj * HALF;
                    const u32x4 g = *(const u32x4*)(G + (size_t)(col >> 9) * SLAB + row * 512 + (col & 511));
                    const f32x4 v0 = acc[ai][bj][m][0], v1 = acc[ai][bj][m][1];
                    float y[8];
                    y[0] = sigmoidf_fast(bf_lo(g.x)) * v0[0]; y[1] = sigmoidf_fast(bf_hi(g.x)) * v0[1]; y[2] = sigmoidf_fast(bf_lo(g.y)) * v0[2]; y[3] = sigmoidf_fast(bf_hi(g.y)) * v0[3];
                    y[4] = sigmoidf_fast(bf_lo(g.z)) * v1[0]; y[5] = sigmoidf_fast(bf_hi(g.z)) * v1[1]; y[6] = sigmoidf_fast(bf_lo(g.w)) * v1[2]; y[7] = sigmoidf_fast(bf_hi(g.w)) * v1[3];
                    u32x4* yp = (u32x4*)(Y + row * 1024 + col);
                    if (ADD) { const u32x4 o = *yp; y[0] += bf_lo(o.x); y[1] += bf_hi(o.x); y[2] += bf_lo(o.y); y[3] += bf_hi(o.y); y[4] += bf_lo(o.z); y[5] += bf_hi(o.z); y[6] += bf_lo(o.w); y[7] += bf_hi(o.w); }
                    u32x4 w; w.x = cvtpk(y[0], y[1]); w.y = cvtpk(y[2], y[3]); w.z = cvtpk(y[4], y[5]); w.w = cvtpk(y[6], y[7]);
                    *yp = w; } }
    }
};
__device__ __forceinline__ float sig_den(float x) { return 1.0f + __builtin_amdgcn_exp2f(fminf(-x * LOG2E, 60.0f)); }
struct EpiGate2 {
    static constexpr bool PERM = true, AFTER_DRAIN = false; static constexpr int MID_T = 8;
    bf16_t* Y; const bf16_t* Gsb; const bf16_t* Gml;
    __device__ __forceinline__ void mid(f32x4 (&acc)[2][2][4][2], const Unit& u, int wr, int wc, int fr, int fq) const {
        const int row0 = u.pm * BM + wr * 64 + fr, col0 = u.pn * BM + wc * 32 + 8 * fq;
#pragma unroll
        for (int ai = 0; ai < 2; ++ai)
#pragma unroll
            for (int m = 0; m < 4; ++m) { const size_t row = (size_t)(row0 + ai * HALF + m * 16);
#pragma unroll
                for (int bj = 0; bj < 2; ++bj) { const int col = col0 + bj * HALF; const size_t go = (size_t)(col >> 9) * SLAB + row * 512 + (col & 511);
                    const u32x4 a = *(const u32x4*)(Gsb + go), b = *(const u32x4*)(Gml + go);
                    f32x4& v0 = acc[ai][bj][m][0]; f32x4& v1 = acc[ai][bj][m][1];
                    v0[0] *= sig_den(bf_lo(b.x)) * __builtin_amdgcn_rcpf(sig_den(bf_lo(a.x))); v0[1] *= sig_den(bf_hi(b.x)) * __builtin_amdgcn_rcpf(sig_den(bf_hi(a.x)));
                    v0[2] *= sig_den(bf_lo(b.y)) * __builtin_amdgcn_rcpf(sig_den(bf_lo(a.y))); v0[3] *= sig_den(bf_hi(b.y)) * __builtin_amdgcn_rcpf(sig_den(bf_hi(a.y)));
                    v1[0] *= sig_den(bf_lo(b.z)) * __builtin_amdgcn_rcpf(sig_den(bf_lo(a.z))); v1[1] *= sig_den(bf_hi(b.z)) * __builtin_amdgcn_rcpf(sig_den(bf_hi(a.z)));
                    v1[2] *= sig_den(bf_lo(b.w)) * __builtin_amdgcn_rcpf(sig_den(bf_lo(a.w))); v1[3] *= sig_den(bf_hi(b.w)) * __builtin_amdgcn_rcpf(sig_den(bf_hi(a.w)));
                    asm volatile("" ::: "memory"); __builtin_amdgcn_sched_barrier(0); } }
    }
    __device__ __forceinline__ void operator()(const f32x4 (&acc)[2][2][4][2], const Unit& u, int wr, int wc, int fr, int fq) const {
        const int row0 = u.pm * BM + wr * 64 + fr, col0 = u.pn * BM + wc * 32 + 8 * fq;
#pragma unroll
        for (int ai = 0; ai < 2; ++ai)
#pragma unroll
            for (int m = 0; m < 4; ++m) { const size_t row = (size_t)(row0 + ai * HALF + m * 16);
#pragma unroll
                for (int bj = 0; bj < 2; ++bj) { const int col = col0 + bj * HALF;
                    const u32x4 b = *(const u32x4*)(Gml + (size_t)(col >> 9) * SLAB + row * 512 + (col & 511));
                    const f32x4 v0 = acc[ai][bj][m][0], v1 = acc[ai][bj][m][1];
                    u32x4 w;
                    w.x = cvtpk(v0[0] * __builtin_amdgcn_rcpf(sig_den(bf_lo(b.x))), v0[1] * __builtin_amdgcn_rcpf(sig_den(bf_hi(b.x)))); w.y = cvtpk(v0[2] * __builtin_amdgcn_rcpf(sig_den(bf_lo(b.y))), v0[3] * __builtin_amdgcn_rcpf(sig_den(bf_hi(b.y))));
                    w.z = cvtpk(v1[0] * __builtin_amdgcn_rcpf(sig_den(bf_lo(b.z))), v1[1] * __builtin_amdgcn_rcpf(sig_den(bf_hi(b.z)))); w.w = cvtpk(v1[2] * __builtin_amdgcn_rcpf(sig_den(bf_lo(b.w))), v1[3] * __builtin_amdgcn_rcpf(sig_den(bf_hi(b.w))));
                    *(u32x4*)(Y + row * 1024 + col) = w; } }
    }
};
struct EpiPre1 {
    static constexpr bool PERM = false, AFTER_DRAIN = false; static constexpr int MID_T = -1;
    float* P; const float* x; const float* stats; const float* g0; const float* b0;
    __device__ __forceinline__ void operator()(const f32x4 (&acc)[2][2][4][2], const Unit& u, int wr, int wc, int fr, int fq) const {
        const int row0 = u.pm * BM + wr * 64 + fr, col0 = u.pn * BM + wc * 32 + 4 * fq;
        f32x4 gv[2][2], bv[2][2];
#pragma unroll
        for (int bj = 0; bj < 2; ++bj)
#pragma unroll
            for (int n = 0; n < 2; ++n) { gv[bj][n] = *(const f32x4*)(g0 + col0 + bj * HALF + n * 16); bv[bj][n] = *(const f32x4*)(b0 + col0 + bj * HALF + n * 16); }
#pragma unroll
        for (int ai = 0; ai < 2; ++ai)
#pragma unroll
            for (int m = 0; m < 4; ++m) { const size_t row = (size_t)(row0 + ai * HALF + m * 16); const f32x2 st = *(const f32x2*)(stats + row * 2);
#pragma unroll
                for (int bj = 0; bj < 2; ++bj)
#pragma unroll
                    for (int n = 0; n < 2; ++n) { const size_t off = row * 1024 + col0 + bj * HALF + n * 16; const f32x4 xv = *(const f32x4*)(x + off);
                        const f32x4 h0 = (xv - st.x) * st.y * gv[bj][n] + bv[bj][n];
                        *(f32x4*)(P + off) = h0 * ALPHA + acc[ai][bj][m][n]; } }
    }
};
struct EpiQG {
    static constexpr bool PERM = true, AFTER_DRAIN = false; static constexpr int MID_T = -1;
    bf16_t* Q; bf16_t* PLE;
    __device__ __forceinline__ void operator()(const f32x4 (&acc)[2][2][4][2], const Unit& u, int wr, int wc, int fr, int fq) const {
        const int row0 = u.pm * BM + wr * 64 + fr, colt = u.pn * BM, col0 = colt + wc * 32 + 8 * fq;
        const bool isq = colt < 2048;
#pragma unroll
        for (int ai = 0; ai < 2; ++ai)
#pragma unroll
            for (int m = 0; m < 4; ++m) { const size_t row = (size_t)(row0 + ai * HALF + m * 16);
#pragma unroll
                for (int bj = 0; bj < 2; ++bj) { const int col = col0 + bj * HALF; const f32x4 v0 = acc[ai][bj][m][0], v1 = acc[ai][bj][m][1];
                    if (isq) { u32x4 w; w.x = cvtpk(v0[0], v0[1]); w.y = cvtpk(v0[2], v0[3]); w.z = cvtpk(v1[0], v1[1]); w.w = cvtpk(v1[2], v1[3]);
                        *(u32x4*)(Q + row * 2048 + col) = w; }
                    else { u32x4* pp = (u32x4*)(PLE + row * 1024 + (col - 2048)); const u32x4 o = *pp; u32x4 w;
                        w.x = cvtpk(sigmoidf_fast(v0[0]) * bf_lo(o.x), sigmoidf_fast(v0[1]) * bf_hi(o.x)); w.y = cvtpk(sigmoidf_fast(v0[2]) * bf_lo(o.y), sigmoidf_fast(v0[3]) * bf_hi(o.y));
                        w.z = cvtpk(sigmoidf_fast(v1[0]) * bf_lo(o.z), sigmoidf_fast(v1[1]) * bf_hi(o.z)); w.w = cvtpk(sigmoidf_fast(v1[2]) * bf_lo(o.w), sigmoidf_fast(v1[3]) * bf_hi(o.w));
                        *pp = w; } } }
    }
};
}

__device__ __forceinline__ void p0_transpose_item(const float* W, int ldw, int K, int nblk, int shift_from, int shift, bf16* WT, int row_off, LAS float* scr, int item, int lane, int ldt = 0, int kofs = 0) {
    const int kb = item / nblk, nb = item % nblk, k0 = 64 * kb, n0 = 32 * nb, sn0 = n0 + (n0 >= shift_from ? shift : 0);
#pragma unroll 8
    for (int i = 0; i < 32; ++i) { const int kk = 2 * i + (lane >> 5); scr[kk * 33 + (lane & 31)] = W[(size_t)(k0 + kk) * ldw + sn0 + (lane & 31)]; }
    LDS_WAIT(); asm volatile("" ::: "memory");
    const int c = lane & 7;
#pragma unroll
    for (int j = 0; j < 4; ++j) { const int n = (lane >> 3) + 8 * j; const LAS float* s = scr + (8 * c) * 33 + n;
        v4u o; o.x = pk2(s[0 * 33], s[1 * 33]); o.y = pk2(s[2 * 33], s[3 * 33]); o.z = pk2(s[4 * 33], s[5 * 33]); o.w = pk2(s[6 * 33], s[7 * 33]);
        *(GAS v4u*)(WT + (size_t)(row_off + n0 + n) * (ldt ? ldt : K) + kofs + k0 + 8 * c) = o; }
    LDS_WAIT(); asm volatile("" ::: "memory");
}
__device__ __forceinline__ float log_sigmoidf(float x) { return -(fmaxf(-x, 0.f) + log1pf(expf(-fabsf(x)))); }

__device__ __forceinline__ void p0_prologue(Frame& F) {
    const int gw = F.vcu * NWAVES + F.wave, NGW = F.G * NWAVES, lane = lane_id();
    {
        LAS float* scr = (LAS float*)(F.lds + RING_OFF + F.wave * 16384);
        constexpr int I_IN = 16 * (NPROJ / 32), I_SB = 8 * 32, I_ML = 8 * 32, I_OUT = 16 * 32, I_WQ = 16 * 64, I_WG = 16 * 32, I_PLE = 4 * 32;
        constexpr int NITEMS = I_IN + I_SB + I_ML + I_OUT + I_WQ + I_WG + I_PLE;
        for (int it = gw; it < NITEMS; it += NGW) {
            int r = it;
            if (r < I_IN) { p0_transpose_item(F.in[4], INW, 1024, NPROJ / 32, GATE_COL, 8, WSP(bf16, WS_WIN_T), 0, scr, r, lane); continue; } r -= I_IN;
            if (r < I_SB) { p0_transpose_item(F.in[9], 1024, 512, 32, 1 << 30, 0, WSP(bf16, WS_WSB_T), 0, scr, r, lane, 1024, 0); continue; } r -= I_SB;
            if (r < I_ML) { p0_transpose_item(F.in[10], 1024, 512, 32, 1 << 30, 0, WSP(bf16, WS_WSB_T), 0, scr, r, lane, 1024, 512); continue; } r -= I_ML;
            if (r < I_OUT) { p0_transpose_item(F.in[11], 1024, 1024, 32, 1 << 30, 0, WSP(bf16, WS_WOUT_T), 0, scr, r, lane); continue; } r -= I_OUT;
            if (r < I_WQ) { p0_transpose_item(F.in[14], 2048, 1024, 64, 1 << 30, 0, WSP(bf16, WS_WQG_T), 0, scr, r, lane); continue; } r -= I_WQ;
            if (r < I_WG) { p0_transpose_item(F.in[19], 1024, 1024, 32, 1 << 30, 0, WSP(bf16, WS_WQG_T), 2048, scr, r, lane); continue; } r -= I_WG;
            p0_transpose_item(F.in[20], 1024, 256, 32, 1 << 30, 0, WSP(bf16, WS_WPLE_T), 0, scr, r, lane);
        }
    }
    {
        const float* p = F.in[1]; bf16* PB = WSP(bf16, WS_PB);
        const size_t nchunk = (size_t)M * 256 / 8, stride = (size_t)F.G * NWAVES * 64;
        for (size_t i = (size_t)F.vcu * NWAVES * 64 + F.tid; i < nchunk; i += stride) {
            const f32x4 a = *(const GAS f32x4*)(p + i * 8), b = *(const GAS f32x4*)(p + i * 8 + 4);
            v4u o; o.x = pk2(a.x, a.y); o.y = pk2(a.z, a.w); o.z = pk2(b.x, b.y); o.w = pk2(b.z, b.w);
            *(GAS v4u*)(PB + i * 8) = o; }
    }
    __syncthreads();
    LAS float* WGt = (LAS float*)(F.lds + RING_OFF);
    for (int i = F.tid; i < 8192; i += NWAVES * 64) { const int k = i >> 3, c = i & 7; WGt[c * 1024 + k] = F.in[4][(size_t)k * INW + GATE_COL + c]; }
    __syncthreads();
    const float* x = F.in[0]; const float* g0 = F.in[2]; const float* b0 = F.in[3];
    f32x4 gv[4], bv[4];
#pragma unroll
    for (int j = 0; j < 4; ++j) { gv[j] = *(const f32x4*)(g0 + 256 * j + 4 * lane); bv[j] = *(const f32x4*)(b0 + 256 * j + 4 * lane); }
    bf16* XN = WSP(bf16, WS_XN); float* stats = WSP(float, WS_STATS); float* GI = WSP(float, WS_GI); float* GF = WSP(float, WS_GF);
    const float big = F.in[5][(lane >> 3) & 3], bfg = F.in[6][(lane >> 3) & 3];
    const bool up16 = (lane & 16) != 0, up8 = (lane & 8) != 0;
    f32x4 vn[4];
    if (gw < M) {
#pragma unroll
        for (int j = 0; j < 4; ++j) vn[j] = ((const GAS f32x4*)(x + (size_t)gw * DM) + lane)[64 * j]; }
    for (int m = gw; m < M; m += NGW) {
        f32x4 v[4]; float s = 0.f;
#pragma unroll
        for (int j = 0; j < 4; ++j) v[j] = vn[j];
        { const int mn = (m + NGW < M) ? m + NGW : m;
#pragma unroll
            for (int j = 0; j < 4; ++j) vn[j] = ((const GAS f32x4*)(x + (size_t)mn * DM) + lane)[64 * j]; }
        __builtin_amdgcn_sched_barrier(0);
#pragma unroll
        for (int j = 0; j < 4; ++j) s += (v[j].x + v[j].y) + (v[j].z + v[j].w);
        const float mean = wave_sum(s) * (1.f / DM); float s2 = 0.f;
#pragma unroll
        for (int j = 0; j < 4; ++j) { v[j] = v[j] - mean; s2 += (v[j].x * v[j].x + v[j].y * v[j].y) + (v[j].z * v[j].z + v[j].w * v[j].w); }
        const float rstd = 1.f / sqrtf(wave_sum(s2) * (1.f / DM) + LN_EPS);
        GAS unsigned long long* o8 = (GAS unsigned long long*)(XN + (size_t)m * DM) + lane;
        float part[8];
#pragma unroll
        for (int c = 0; c < 8; ++c) part[c] = 0.f;
#pragma unroll
        for (int j = 0; j < 4; ++j) { const f32x4 y = v[j] * rstd * gv[j] + bv[j];
            o8[64 * j] = (unsigned long long)pk2(y.x, y.y) | ((unsigned long long)pk2(y.z, y.w) << 32);
#pragma unroll
            for (int c = 0; c < 8; ++c) { const f32x4 w = *(const LAS f32x4*)(WGt + c * 1024 + 256 * j + 4 * lane); part[c] += (y.x * w.x + y.y * w.y) + (y.z * w.z + y.w * w.w); } }
        const float sel = reduce8_transposed(part, up16, up8);
        if (lane == 0) { stats[(size_t)m * 2] = mean; stats[(size_t)m * 2 + 1] = rstd; }
        if ((lane & 7) == 0) { const int c = lane >> 3; if (c < 4) GI[(size_t)m * 4 + c] = sel + big; else GF[(size_t)m * 4 + (c - 4)] = log_sigmoidf(sel + bfg); }
    }
}
template <bool MASK>
__device__ __forceinline__ void sb_block(const f32x16& x, float& R, int kbase, int qg, int hi, unsigned (&pw)[8]) {
    float bt[16], om[16];
#pragma unroll
    for (int r = 0; r < 16; ++r) {
        const float xv = fminf(fmaxf(x[r], -60.f), 60.f);
        const float e = __builtin_amdgcn_exp2f(-xv);
        const float be = __builtin_amdgcn_rcpf(1.0f + e);
        bt[r] = be; om[r] = e * be;
        if (MASK) { const bool c = (kbase + crow(r, hi)) < qg; om[r] = c ? om[r] : 1.f; bt[r] = c ? bt[r] : 0.f; }
    }
    float ex[16], T[4];
#pragma unroll
    for (int g = 0; g < 4; ++g) { ex[4 * g + 3] = 1.f; ex[4 * g + 2] = om[4 * g + 3]; ex[4 * g + 1] = ex[4 * g + 2] * om[4 * g + 2]; ex[4 * g] = ex[4 * g + 1] * om[4 * g + 1]; T[g] = ex[4 * g] * om[4 * g]; }
    float S[4], up[4];
#pragma unroll
    for (int g = 0; g < 4; ++g) { auto rr = __builtin_amdgcn_permlane32_swap(__float_as_uint(T[g]), __float_as_uint(T[g]), false, false);
        const float lo_v = __uint_as_float(rr[0]), up_v = __uint_as_float(rr[1]); S[g] = lo_v * up_v; up[g] = up_v; }
    float base[4];
    base[3] = R; base[2] = base[3] * S[3]; base[1] = base[2] * S[2]; base[0] = base[1] * S[1];
    R = base[0] * S[0];
    float w[16];
#pragma unroll
    for (int g = 0; g < 4; ++g) { const float off = base[g] * (hi == 0 ? up[g] : 1.f);
#pragma unroll
        for (int i = 0; i < 4; ++i) w[4 * g + i] = bt[4 * g + i] * (off * ex[4 * g + i]); }
#pragma unroll
    for (int i = 0; i < 8; ++i) pw[i] = cvtpk(w[2 * i], w[2 * i + 1]);
}

constexpr int AT_TK = 128;
constexpr int AT_KS = 0, AT_KSB = AT_TK * 144, AT_VT = 2 * AT_KSB, AT_VTB = 64 * 264, AT_FL = AT_VT + 2 * AT_VTB;
__device__ __forceinline__ void attn_unit(Frame& F, int bh, int qb) {
    const int tid = F.tid, lane = lane_id(), wave = F.wave, r32 = lane & 31, hi = lane >> 5;
    const int b = bh >> 3, h = bh & 7;
    const size_t rowbase = (size_t)b * SEQ;
    const int q0 = qb * 256, qw = q0 + wave * 32;
    const bf16* PROJ = WSP(bf16, WS_PROJ);
    const bf16* Qs = PROJ + (rowbase + qw) * 512 + h * 64;
    const bf16* Ks = PROJ + SLAB + rowbase * 512 + h * 64;
    const bf16* Vs = PROJ + 2 * SLAB + rowbase * 512 + h * 64;
    bf16x8 qr[4];
#pragma unroll
    for (int ks = 0; ks < 4; ++ks) qr[ks] = *(const bf16x8*)(Qs + (size_t)r32 * 512 + ks * 16 + hi * 8);
    LAS unsigned char* L = F.lds + RING_OFF;
    LAS unsigned* FL = (LAS unsigned*)(L + AT_FL);
    const int skey = tid >> 3, sch = tid & 7;
    f32x16 o0, o1;
#pragma unroll
    for (int r = 0; r < 16; ++r) { o0[r] = 0.f; o1[r] = 0.f; }
    float R = 1.f; bool wdone = false;
    const int NT = (q0 + 256) / AT_TK;
    v4u kreg[2], vreg[2];
#define AT_LOAD(kt) do { _Pragma("unroll") for (int hh_ = 0; hh_ < 2; ++hh_) { const size_t ro_ = (size_t)((kt) * AT_TK + 64 * hh_ + skey) * 512 + sch * 8; kreg[hh_] = *(const v4u*)(Ks + ro_); vreg[hh_] = *(const v4u*)(Vs + ro_); } } while (0)
#define AT_WRITE(buf) do { _Pragma("unroll") for (int hh_ = 0; hh_ < 2; ++hh_) { const int key_ = 64 * hh_ + skey; *(LAS v4u*)(L + AT_KS + (buf) * AT_KSB + key_ * 144 + sch * 16) = kreg[hh_]; \
        LAS unsigned short* vt_ = (LAS unsigned short*)(L + AT_VT + (buf) * AT_VTB) + (sch * 8) * 132 + key_; const v4u w_ = vreg[hh_]; \
        vt_[0 * 132] = (unsigned short)(w_.x & 0xffffu); vt_[1 * 132] = (unsigned short)(w_.x >> 16); vt_[2 * 132] = (unsigned short)(w_.y & 0xffffu); vt_[3 * 132] = (unsigned short)(w_.y >> 16); \
        vt_[4 * 132] = (unsigned short)(w_.z & 0xffffu); vt_[5 * 132] = (unsigned short)(w_.z >> 16); vt_[6 * 132] = (unsigned short)(w_.w & 0xffffu); vt_[7 * 132] = (unsigned short)(w_.w >> 16); } } while (0)
    AT_LOAD(NT - 1); AT_WRITE(0);
    __syncthreads();
    int cur = 0, par = 0;
    for (int kt = NT - 1; kt >= 0; --kt) {
        if (kt > 0) AT_LOAD(kt - 1);
        if (!wdone && AT_TK * kt < qw + 31) {
#pragma unroll
            for (int kbi = 0; kbi < 4; ++kbi) { const int kb = 3 - kbi; const int kbase = AT_TK * kt + 32 * kb;
                if (!wdone && kbase < qw + 31) {
                    f32x16 x;
#pragma unroll
                    for (int r = 0; r < 16; ++r) x[r] = 0.f;
#pragma unroll
                    for (int ks = 0; ks < 4; ++ks) { const bf16x8 a = *(const LAS bf16x8*)(L + AT_KS + cur * AT_KSB + (32 * kb + r32) * 144 + (16 * ks + 8 * hi) * 2); x = MFMA32(a, qr[ks], x); }
                    unsigned pw[8];
                    if (kbase + 31 < qw) sb_block<false>(x, R, kbase, qw + r32, hi, pw); else sb_block<true>(x, R, kbase, qw + r32, hi, pw);
#pragma unroll
                    for (int s2 = 0; s2 < 2; ++s2) { v4u av; av.x = pw[4 * s2]; av.y = pw[4 * s2 + 1]; av.z = pw[4 * s2 + 2]; av.w = pw[4 * s2 + 3]; const bf16x8 a = __builtin_bit_cast(bf16x8, av);
#pragma unroll
                        for (int dt = 0; dt < 2; ++dt) { const LAS unsigned char* vp = L + AT_VT + cur * AT_VTB + (32 * dt + r32) * 264 + (32 * kb + 16 * s2 + 4 * hi) * 2;
                            const u32x2 b0 = *(const LAS u32x2*)vp, b1 = *(const LAS u32x2*)(vp + 16);
                            v4u bv; bv.x = b0.x; bv.y = b0.y; bv.z = b1.x; bv.w = b1.y; const bf16x8 bb = __builtin_bit_cast(bf16x8, bv);
                            if (dt == 0) o0 = MFMA32(a, bb, o0); else o1 = MFMA32(a, bb, o1); } }
#if SB_EARLY_EXIT
                    wdone = __all(R == 0.f);
#endif
                }
            }
        }
        if (lane == 0) FL[par * 8 + wave] = wdone ? 1u : 0u;
        if (kt > 0) AT_WRITE(cur ^ 1);
        __syncthreads();
        unsigned alld = 1u;
#pragma unroll
        for (int w = 0; w < 8; ++w) alld &= FL[par * 8 + w];
        cur ^= 1; par ^= 1;
        if (alld) break;
    }
#undef AT_LOAD
#undef AT_WRITE
    bf16* Ow = WSP(bf16, WS_OCAT) + (rowbase + qw) * 1024 + h * 64 + r32;
#pragma unroll
    for (int r = 0; r < 16; ++r) { const int q = crow(r, hi); Ow[(size_t)q * 1024] = (bf16)f2bf(o0[r]); Ow[(size_t)q * 1024 + 32] = (bf16)f2bf(o1[r]); }
    __syncthreads();
}

template <bool TRANS>
__device__ __forceinline__ void ml_stage_conv(Frame& F, const bf16* raw, int t0, const float* cw, const float* cb, float scale, LAS bf16* dst) {
    const int cg = F.tid & 15, rr = F.tid >> 4;
    float w[4][8], bb[8];
#pragma unroll
    for (int j = 0; j < 4; ++j) { const f32x4 a = *(const f32x4*)(cw + j * 1024 + cg * 8), c = *(const f32x4*)(cw + j * 1024 + cg * 8 + 4);
        w[j][0] = a.x; w[j][1] = a.y; w[j][2] = a.z; w[j][3] = a.w; w[j][4] = c.x; w[j][5] = c.y; w[j][6] = c.z; w[j][7] = c.w; }
    { const f32x4 a = *(const f32x4*)(cb + cg * 8), c = *(const f32x4*)(cb + cg * 8 + 4); bb[0] = a.x; bb[1] = a.y; bb[2] = a.z; bb[3] = a.w; bb[4] = c.x; bb[5] = c.y; bb[6] = c.z; bb[7] = c.w; }
#pragma unroll
    for (int p = 0; p < 4; ++p) { const int s = p * 32 + rr;
        float y[8];
#pragma unroll
        for (int i = 0; i < 8; ++i) y[i] = bb[i];
#pragma unroll
        for (int j = 0; j < 4; ++j) { const int t = t0 + s - j;
            v4u rv = {0u, 0u, 0u, 0u};
            if (t >= 0) rv = *(const v4u*)(raw + (size_t)t * 512 + cg * 8);
            y[0] += w[j][0] * bf_lo(rv.x); y[1] += w[j][1] * bf_hi(rv.x); y[2] += w[j][2] * bf_lo(rv.y); y[3] += w[j][3] * bf_hi(rv.y);
            y[4] += w[j][4] * bf_lo(rv.z); y[5] += w[j][5] * bf_hi(rv.z); y[6] += w[j][6] * bf_lo(rv.w); y[7] += w[j][7] * bf_hi(rv.w); }
#pragma unroll
        for (int i = 0; i < 8; ++i) y[i] = siluf_fast(y[i]) * scale;
        if (!TRANS) { v4u o; o.x = cvtpk(y[0], y[1]); o.y = cvtpk(y[2], y[3]); o.z = cvtpk(y[4], y[5]); o.w = cvtpk(y[6], y[7]); *(LAS v4u*)(dst + s * 136 + cg * 8) = o; }
        else {
#pragma unroll
            for (int i = 0; i < 8; ++i) dst[(cg * 8 + i) * 136 + s] = (bf16)f2bf(y[i]); }
    }
}
__device__ __forceinline__ void scan_add128(float a0, float a1, int lane, float& o0, float& o1) {
    float v = a0 + a1;
#pragma unroll
    for (int d = 1; d < 64; d <<= 1) { const float t = __shfl_up(v, d); if (lane >= d) v += t; }
    const float exv = v - (a0 + a1); o0 = exv + a0; o1 = exv + a0 + a1;
}
__device__ __forceinline__ void scan_max128(float a0, float a1, int lane, float& o0, float& o1) {
    float v = fmaxf(a0, a1);
#pragma unroll
    for (int d = 1; d < 64; d <<= 1) { const float t = __shfl_up(v, d); if (lane >= d) v = fmaxf(v, t); }
    float pv = __shfl_up(v, 1); if (lane == 0) pv = -INFINITY;
    o0 = fmaxf(pv, a0); o1 = fmaxf(o0, a1);
}

constexpr int ML_T0 = 0, ML_T1 = 34816, ML_T2 = 69632, ML_SM = 104448;
__device__ __forceinline__ void mla_unit(Frame& F, int u) {
    const int tid = F.tid, lane = lane_id(), wave = F.wave, r32 = lane & 31, hi = lane >> 5;
    const int bhd = u >> 6, ch = u & 63, b = bhd >> 2, hd = bhd & 3;
    const size_t rowbase = (size_t)b * SEQ; const int t0 = ch * 128;
    LAS unsigned char* L = F.lds + RING_OFF;
    LAS bf16* KT = (LAS bf16*)(L + ML_T0); LAS bf16* VT = (LAS bf16*)(L + ML_T1);
    LAS float* BC = (LAS float*)(L + ML_SM); LAS float* EE = BC + 128; LAS float* SC = BC + 256;
    const bf16* PROJ = WSP(bf16, WS_PROJ);
    const float* GI = WSP(float, WS_GI); const float* GF = WSP(float, WS_GF);
    if (wave == 0) {
        const size_t r0 = rowbase + t0 + 2 * lane;
        const float f0 = GF[r0 * 4 + hd], f1 = GF[(r0 + 1) * 4 + hd], i0 = GI[r0 * 4 + hd], i1 = GI[(r0 + 1) * 4 + hd];
        float c0, c1; scan_add128(f0, f1, lane, c0, c1);
        const float blast = __shfl(c1, 63);
        const float w0 = blast - c0 + i0, w1 = blast - c1 + i1;
        const float mloc = wave_max(fmaxf(w0, w1));
        EE[2 * lane] = __expf(w0 - mloc); EE[2 * lane + 1] = __expf(w1 - mloc);
        if (lane == 0) { float* S = WSP(float, WS_MLS); S[u] = mloc; S[1024 + u] = blast; }
    }
    ml_stage_conv<true>(F, PROJ + 4 * SLAB + rowbase * 512 + hd * 128, t0, F.in[7] + 512 + hd * 128, F.in[8] + 512 + hd * 128, 0.08838834764831845f, KT);
    __syncthreads();
    {
        const bf16* Vs = PROJ + 5 * SLAB + (rowbase + t0) * 512 + hd * 128;
        const int cg = tid & 15, rr = tid >> 4;
#pragma unroll
        for (int p = 0; p < 4; ++p) { const int s = p * 32 + rr; const float e = EE[s]; const v4u rv = *(const v4u*)(Vs + (size_t)s * 512 + cg * 8);
            LAS bf16* d = VT + (cg * 8) * 136 + s;
            d[0 * 136] = (bf16)f2bf(e * bf_lo(rv.x)); d[1 * 136] = (bf16)f2bf(e * bf_hi(rv.x)); d[2 * 136] = (bf16)f2bf(e * bf_lo(rv.y)); d[3 * 136] = (bf16)f2bf(e * bf_hi(rv.y));
            d[4 * 136] = (bf16)f2bf(e * bf_lo(rv.z)); d[5 * 136] = (bf16)f2bf(e * bf_hi(rv.z)); d[6 * 136] = (bf16)f2bf(e * bf_lo(rv.w)); d[7 * 136] = (bf16)f2bf(e * bf_hi(rv.w)); }
    }
    if (tid < 128) {
        float n = 0.f; const LAS bf16* kr = KT + tid * 136;
#pragma unroll 4
        for (int s8 = 0; s8 < 16; ++s8) { const v4u kv = *(const LAS v4u*)(kr + s8 * 8); const LAS float* ep = EE + s8 * 8;
            n += ep[0] * bf_lo(kv.x) + ep[1] * bf_hi(kv.x) + ep[2] * bf_lo(kv.y) + ep[3] * bf_hi(kv.y) + ep[4] * bf_lo(kv.z) + ep[5] * bf_hi(kv.z) + ep[6] * bf_lo(kv.w) + ep[7] * bf_hi(kv.w); }
        WSP(float, WS_MLN)[(size_t)u * 128 + tid] = n;
    }
    __syncthreads();
    {
        const int dvt = wave >> 1, eh = wave & 1;
        f32x16 c0, c1;
#pragma unroll
        for (int r = 0; r < 16; ++r) { c0[r] = 0.f; c1[r] = 0.f; }
#pragma unroll
        for (int ks = 0; ks < 8; ++ks) { const bf16x8 a = *(const LAS bf16x8*)(VT + (32 * dvt + r32) * 136 + 16 * ks + 8 * hi);
            const bf16x8 b0 = *(const LAS bf16x8*)(KT + (64 * eh + r32) * 136 + 16 * ks + 8 * hi), b1 = *(const LAS bf16x8*)(KT + (64 * eh + 32 + r32) * 136 + 16 * ks + 8 * hi);
            c0 = MFMA32(a, b0, c0); c1 = MFMA32(a, b1, c1); }
        bf16* Cg = WSP(bf16, WS_C) + (size_t)u * 16384 + 64 * eh + r32;
#pragma unroll
        for (int r = 0; r < 16; ++r) { const int dv = 32 * dvt + crow(r, hi); Cg[(size_t)dv * 128] = (bf16)f2bf(c0[r]); Cg[(size_t)dv * 128 + 32] = (bf16)f2bf(c1[r]); }
    }
    __syncthreads();
}

__device__ __forceinline__ void ml_scan_item(Frame& F, int item, const size_t dummy = 0) {
    const int tid = F.tid; const int bhd = item >> 4, part = item & 15;
    LAS float* SM = (LAS float*)(F.lds + RING_OFF);
    float* S = WSP(float, WS_MLS);
    if (tid < 64) SM[tid] = S[bhd * 64 + tid]; else if (tid < 128) SM[tid] = S[1024 + bhd * 64 + (tid - 64)];
    unsigned* Cw = WSP(unsigned, WS_C) + (size_t)bhd * 64 * 8192 + (size_t)(part * 8 + (tid >> 6)) * 64 + (tid & 63);
    unsigned cl[64];
#pragma unroll
    for (int j = 0; j < 64; ++j) cl[j] = Cw[(size_t)j * 8192];
    const bool do_n = (part == 0 && tid < 128);
    float* Nw = WSP(float, WS_MLN) + (size_t)bhd * 64 * 128 + (tid & 127);
    float nlv[64];
#pragma unroll
    for (int j = 0; j < 64; ++j) nlv[j] = do_n ? Nw[(size_t)j * 128] : 0.f;
    __syncthreads();
    float c0 = 0.f, c1 = 0.f, m = 0.f, n = 0.f;
#pragma unroll
    for (int j = 0; j < 64; ++j) {
        const float ml = SM[j], bl = SM[64 + j];
        (dummy ? (unsigned*)(F.ws + dummy) + (Cw - WSP(unsigned, WS_C)) : Cw)[(size_t)j * 8192] = cvtpk(c0, c1);
        const float nl = nlv[j]; if (do_n) (dummy ? (float*)(F.ws + dummy + 40 * MiB) + (Nw - WSP(float, WS_MLN)) : Nw)[(size_t)j * 128] = n;
        if (part == 0 && tid == 0) (dummy ? (float*)(F.ws + dummy + 48 * MiB) : S)[2048 + bhd * 64 + j] = m;
        const float mn = fmaxf(bl + m, ml), a = __expf(bl + m - mn), g = __expf(ml - mn);
        c0 = a * c0 + g * bf_lo(cl[j]); c1 = a * c1 + g * bf_hi(cl[j]); n = a * n + g * nl; m = mn;
    }
    __syncthreads();
}

__device__ __forceinline__ void mlc_unit(Frame& F, int u) {
    const int tid = F.tid, lane = lane_id(), wave = F.wave, r32 = lane & 31, hi = lane >> 5;
    const int bhd = u >> 6, ch = u & 63, b = bhd >> 2, hd = bhd & 3;
    const size_t rowbase = (size_t)b * SEQ; const int t0 = ch * 128;
    LAS unsigned char* L = F.lds + RING_OFF;
    LAS bf16* QS = (LAS bf16*)(L + ML_T0); LAS bf16* KS = (LAS bf16*)(L + ML_T1); LAS bf16* VT = (LAS bf16*)(L + ML_T2);
    LAS float* AA = (LAS float*)(L + ML_SM); LAS float* MM = AA + 128; LAS float* AT = AA + 256; LAS float* EM = AA + 384; LAS float* NP = AA + 512; LAS float* NQ = AA + 640; LAS float* INV = AA + 768;
    const bf16* PROJ = WSP(bf16, WS_PROJ);
    const float* GI = WSP(float, WS_GI); const float* GF = WSP(float, WS_GF);
    const float mprev = WSP(float, WS_MLS)[2048 + u];
    if (wave == 0) {
        const size_t r0 = rowbase + t0 + 2 * lane;
        const float f0 = GF[r0 * 4 + hd], f1 = GF[(r0 + 1) * 4 + hd], i0 = GI[r0 * 4 + hd], i1 = GI[(r0 + 1) * 4 + hd];
        float c0, c1; scan_add128(f0, f1, lane, c0, c1);
        const float a0 = i0 - c0, a1 = i1 - c1;
        float p0, p1; scan_max128(a0, a1, lane, p0, p1);
        const float m0 = fmaxf(mprev, p0), m1 = fmaxf(mprev, p1);
        AA[2 * lane] = a0; AA[2 * lane + 1] = a1; MM[2 * lane] = m0; MM[2 * lane + 1] = m1;
        AT[2 * lane] = __expf(mprev - m0); AT[2 * lane + 1] = __expf(mprev - m1);
        EM[2 * lane] = __expf(-(c0 + m0)); EM[2 * lane + 1] = __expf(-(c1 + m1));
    } else if (wave == 1) {
        const float* Np = WSP(float, WS_MLN) + (size_t)u * 128; NP[2 * lane] = Np[2 * lane]; NP[2 * lane + 1] = Np[2 * lane + 1];
    }
    ml_stage_conv<false>(F, PROJ + 3 * SLAB + rowbase * 512 + hd * 128, t0, F.in[7] + hd * 128, F.in[8] + hd * 128, 1.0f, QS);
    ml_stage_conv<false>(F, PROJ + 4 * SLAB + rowbase * 512 + hd * 128, t0, F.in[7] + 512 + hd * 128, F.in[8] + 512 + hd * 128, 0.08838834764831845f, KS);
    {
        const bf16* Vs = PROJ + 5 * SLAB + (rowbase + t0) * 512 + hd * 128;
        const int cg = tid & 15, rr = tid >> 4;
#pragma unroll
        for (int p = 0; p < 4; ++p) { const int s = p * 32 + rr; const v4u rv = *(const v4u*)(Vs + (size_t)s * 512 + cg * 8);
            LAS bf16* d = VT + (cg * 8) * 136 + s;
            d[0 * 136] = (bf16)(rv.x & 0xffffu); d[1 * 136] = (bf16)(rv.x >> 16); d[2 * 136] = (bf16)(rv.y & 0xffffu); d[3 * 136] = (bf16)(rv.y >> 16);
            d[4 * 136] = (bf16)(rv.z & 0xffffu); d[5 * 136] = (bf16)(rv.z >> 16); d[6 * 136] = (bf16)(rv.w & 0xffffu); d[7 * 136] = (bf16)(rv.w >> 16); }
    }
    __syncthreads();
    if (tid < 128) {
        float n = 0.f; const LAS bf16* qrow = QS + tid * 136;
#pragma unroll 4
        for (int e8 = 0; e8 < 16; ++e8) { const v4u qv = *(const LAS v4u*)(qrow + e8 * 8); const LAS float* np = NP + e8 * 8;
            n += np[0] * bf_lo(qv.x) + np[1] * bf_hi(qv.x) + np[2] * bf_lo(qv.y) + np[3] * bf_hi(qv.y) + np[4] * bf_lo(qv.z) + np[5] * bf_hi(qv.z) + np[6] * bf_lo(qv.w) + np[7] * bf_hi(qv.w); }
        NQ[tid] = n;
    }
    const int tt = wave >> 1, dh = wave & 1;
    f32x16 acc0, acc1;
#pragma unroll
    for (int r = 0; r < 16; ++r) { acc0[r] = 0.f; acc1[r] = 0.f; }
    {
        const bf16* Cg = WSP(bf16, WS_C) + (size_t)u * 16384;
#pragma unroll
        for (int ks = 0; ks < 8; ++ks) { const bf16x8 a = *(const LAS bf16x8*)(QS + (32 * tt + r32) * 136 + 16 * ks + 8 * hi);
            const bf16x8 b0 = *(const bf16x8*)(Cg + (size_t)(64 * dh + r32) * 128 + 16 * ks + 8 * hi), b1 = *(const bf16x8*)(Cg + (size_t)(64 * dh + 32 + r32) * 128 + 16 * ks + 8 * hi);
            acc0 = MFMA32(a, b0, acc0); acc1 = MFMA32(a, b1, acc1); }
#pragma unroll
        for (int r = 0; r < 16; ++r) { const float at = AT[32 * tt + crow(r, hi)]; acc0[r] *= at; acc1[r] *= at; }
    }
    float den = 0.f;
    const int tg = 32 * tt + r32; const float mmt = MM[tg];
    for (int st = 0; st <= tt; ++st) {
        f32x16 sT;
#pragma unroll
        for (int r = 0; r < 16; ++r) sT[r] = 0.f;
#pragma unroll
        for (int ks = 0; ks < 8; ++ks) { const bf16x8 a = *(const LAS bf16x8*)(KS + (32 * st + r32) * 136 + 16 * ks + 8 * hi); const bf16x8 bq = *(const LAS bf16x8*)(QS + (32 * tt + r32) * 136 + 16 * ks + 8 * hi);
            sT = MFMA32(a, bq, sT); }
        float p[16];
#pragma unroll
        for (int r = 0; r < 16; ++r) { const int s = 32 * st + crow(r, hi); const float wgt = (s <= tg) ? __expf(AA[s] - mmt) : 0.f; p[r] = sT[r] * wgt; den += p[r]; }
#pragma unroll
        for (int s2 = 0; s2 < 2; ++s2) { v4u av; av.x = cvtpk(p[8 * s2], p[8 * s2 + 1]); av.y = cvtpk(p[8 * s2 + 2], p[8 * s2 + 3]); av.z = cvtpk(p[8 * s2 + 4], p[8 * s2 + 5]); av.w = cvtpk(p[8 * s2 + 6], p[8 * s2 + 7]);
            const bf16x8 a = __builtin_bit_cast(bf16x8, av);
#pragma unroll
            for (int d = 0; d < 2; ++d) { const LAS bf16* vp = VT + (64 * dh + 32 * d + r32) * 136 + 32 * st + 16 * s2 + 4 * hi;
                const u32x2 b0 = *(const LAS u32x2*)vp, b1 = *(const LAS u32x2*)(vp + 8);
                v4u bv; bv.x = b0.x; bv.y = b0.y; bv.z = b1.x; bv.w = b1.y; const bf16x8 bb = __builtin_bit_cast(bf16x8, bv);
                if (d == 0) acc0 = MFMA32(a, bb, acc0); else acc1 = MFMA32(a, bb, acc1); } }
    }
    { auto rr = __builtin_amdgcn_permlane32_swap(__float_as_uint(den), __float_as_uint(den), false, false); den = __uint_as_float(rr[0]) + __uint_as_float(rr[1]); }
    __syncthreads();
    if (dh == 0 && hi == 0) { const float dn = AT[tg] * NQ[tg] + den; INV[tg] = 1.0f / fmaxf(fabsf(dn), EM[tg]); }
    __syncthreads();
    {
        const bf16* Og = PROJ + 6 * SLAB + (rowbase + t0) * 512 + hd * 128 + 64 * dh + r32;
        bf16* Out = WSP(bf16, WS_OCAT) + (rowbase + t0) * 1024 + 512 + hd * 128 + 64 * dh + r32;
#pragma unroll
        for (int r = 0; r < 16; ++r) { const int t = 32 * tt + crow(r, hi); const float iv = INV[t];
            const float g0 = sigmoidf_fast(bf_lo((unsigned)Og[(size_t)t * 512])), g1 = sigmoidf_fast(bf_lo((unsigned)Og[(size_t)t * 512 + 32]));
            Out[(size_t)t * 1024] = (bf16)f2bf(acc0[r] * iv * g0); Out[(size_t)t * 1024 + 32] = (bf16)f2bf(acc1[r] * iv * g1); }
    }
    __syncthreads();
}
__device__ __forceinline__ void p7_ln1_tables(Frame& F) {
    const int gw = F.vcu * NWAVES + F.wave, NGW = F.G * NWAVES, lane = lane_id();
    const float* g1 = F.in[12]; const float* b1 = F.in[13];
    f32x4 gv[4], bv[4];
#pragma unroll
    for (int j = 0; j < 4; ++j) { gv[j] = *(const f32x4*)(g1 + 256 * j + 4 * lane); bv[j] = *(const f32x4*)(b1 + 256 * j + 4 * lane); }
    const bf16* MIX = WSP(bf16, WS_PRE1); bf16* H1B = WSP(bf16, WS_H1B); const float* x = F.in[0]; const float* stats = WSP(float, WS_STATS);
    f32x4 g0v[4], b0v[4];
#pragma unroll
    for (int j = 0; j < 4; ++j) { g0v[j] = *(const f32x4*)(F.in[2] + 256 * j + 4 * lane); b0v[j] = *(const f32x4*)(F.in[3] + 256 * j + 4 * lane); }
    f32x4 xn[4]; u32x2 mn4[4]; f32x2 stn = {0.f, 1.f};
    if (gw < M) { stn = *(const f32x2*)(stats + (size_t)gw * 2);
#pragma unroll
        for (int j = 0; j < 4; ++j) { xn[j] = ((const GAS f32x4*)(x + (size_t)gw * DM) + lane)[64 * j]; mn4[j] = ((const GAS u32x2*)(MIX + (size_t)gw * DM) + lane)[64 * j]; } }
    for (int m = gw; m < M; m += NGW) {
        f32x4 xc[4]; u32x2 mc[4]; const f32x2 stc = stn;
#pragma unroll
        for (int j = 0; j < 4; ++j) { xc[j] = xn[j]; mc[j] = mn4[j]; }
        { const int mnx = (m + NGW < M) ? m + NGW : m; stn = *(const f32x2*)(stats + (size_t)mnx * 2);
#pragma unroll
            for (int j = 0; j < 4; ++j) { xn[j] = ((const GAS f32x4*)(x + (size_t)mnx * DM) + lane)[64 * j]; mn4[j] = ((const GAS u32x2*)(MIX + (size_t)mnx * DM) + lane)[64 * j]; } }
        __builtin_amdgcn_sched_barrier(0);
        const float mean0 = stc.x, rstd0 = stc.y;
        f32x4 v[4]; float s = 0.f;
#pragma unroll
        for (int j = 0; j < 4; ++j) { const f32x4 xv = xc[j]; const u32x2 mv = mc[j];
            const f32x4 h0 = (xv - mean0) * rstd0 * g0v[j] + b0v[j];
            v[j].x = ALPHA * h0.x + bf_lo(mv.x); v[j].y = ALPHA * h0.y + bf_hi(mv.x); v[j].z = ALPHA * h0.z + bf_lo(mv.y); v[j].w = ALPHA * h0.w + bf_hi(mv.y);
            s += (v[j].x + v[j].y) + (v[j].z + v[j].w); }
        const float mean = wave_sum(s) * (1.f / DM); float s2 = 0.f;
#pragma unroll
        for (int j = 0; j < 4; ++j) { v[j] = v[j] - mean; s2 += (v[j].x * v[j].x + v[j].y * v[j].y) + (v[j].z * v[j].z + v[j].w * v[j].w); }
        const float rstd = 1.f / sqrtf(wave_sum(s2) * (1.f / DM) + LN_EPS);
        GAS unsigned long long* o8 = (GAS unsigned long long*)(H1B + (size_t)m * DM) + lane;
#pragma unroll
        for (int j = 0; j < 4; ++j) { const f32x4 y = v[j] * rstd * gv[j] + bv[j]; o8[64 * j] = (unsigned long long)pk2(y.x, y.y) | ((unsigned long long)pk2(y.z, y.w) << 32); }
    }
    if (F.G != 256) {
    const size_t nchunk = (size_t)16384 * 1024 / 16, stride = (size_t)F.G * NWAVES * 64;
#pragma unroll 1
    for (int tb = 0; tb < 2; ++tb) { const float* src = F.in[17 + tb]; unsigned char* dst = WSP(unsigned char, tb == 0 ? WS_UT : WS_VT); const float sc = tb == 0 ? U_SCALE : V_SCALE;
        for (size_t i = (size_t)F.vcu * NWAVES * 64 + F.tid; i < nchunk; i += stride) {
            v4u o;
#pragma unroll
            for (int w = 0; w < 4; ++w) { const f32x4 a = *(const GAS f32x4*)(src + i * 16 + w * 4); int pk = 0;
                pk = __builtin_amdgcn_cvt_pk_fp8_f32(a.x * sc, a.y * sc, pk, false); pk = __builtin_amdgcn_cvt_pk_fp8_f32(a.z * sc, a.w * sc, pk, true); o[w] = (unsigned)pk; }
            *(GAS v4u*)(dst + i * 16) = o; } }
    }
}

constexpr int RT_K1 = 0, RT_K2 = 34816, RT_VL = 69632, RT_FL = 102400;
#define CE_DESC(a, b) do { const float hi_ = fmaxf(a, b), lo_ = fminf(a, b); a = hi_; b = lo_; } while (0)
__device__ __forceinline__ void sort16_desc(f32x16& v) {
#pragma unroll
    for (int k = 2; k <= 16; k <<= 1)
#pragma unroll
        for (int j = k >> 1; j > 0; j >>= 1)
#pragma unroll
            for (int i = 0; i < 16; ++i) { const int l = i ^ j; if (l > i) { float a = v[i], b = v[l]; if ((i & k) == 0) { CE_DESC(a, b); } else { CE_DESC(b, a); } v[i] = a; v[l] = b; } }
}
__device__ __forceinline__ void merge16_desc(f32x16& a, const f32x16& b) {
#pragma unroll
    for (int i = 0; i < 16; ++i) a[i] = fmaxf(a[i], b[15 - i]);
#pragma unroll
    for (int j = 8; j > 0; j >>= 1)
#pragma unroll
        for (int i = 0; i < 16; ++i) { const int l = i ^ j; if (l > i) { float x = a[i], y = a[l]; CE_DESC(x, y); a[i] = x; a[l] = y; } }
}
__host__ __device__ constexpr int cand_ij(int n) { int c = 0; for (int i = 0; i < 16; ++i) for (int j = 0; j < 16; ++j) if ((i + 1) * (j + 1) <= 16) { if (c == n) return i * 16 + j; ++c; } return 0; }
__device__ __forceinline__ void p9_route(Frame& F) {
    const int tid = F.tid, lane = lane_id(), wave = F.wave, r32 = lane & 31, hi = lane >> 5;
    LAS unsigned char* L = F.lds + RING_OFF;
    for (int i = tid; i < 2 * 128 * 32; i += NWAVES * 64) { const int which = i >> 12, row = (i >> 5) & 127, c4 = (i & 31) * 4;
        const f32x4 a = *(const f32x4*)(F.in[15 + which] + row * 128 + c4);
        u32x2 o; o.x = pk2(a.x, a.y); o.y = pk2(a.z, a.w);
        *(LAS u32x2*)(L + (which ? RT_K2 : RT_K1) + row * 272 + c4 * 2) = o; }
    __syncthreads();
    const bf16* Q = WSP(bf16, WS_Q); int* IDX = WSP(int, WS_IDX); float* GATE = WSP(float, WS_GATE);
    LAS float* VL = (LAS float*)(L + RT_VL) + (wave * 32 + r32) * 32;
    const int gw = F.vcu * NWAVES + wave, NGW = F.G * NWAVES;
    const bool conv = (F.G == 256);
    int it = 0;
    for (int unit = gw; unit < (M / 32) * 8; unit += NGW, ++it) {
        const int tg = unit >> 3, hd = unit & 7; const size_t tok = (size_t)tg * 32 + r32;
        const bf16* qp = Q + tok * 2048 + hd * 256;
        f32x16 top[2];
#pragma unroll
        for (int half = 0; half < 2; ++half) {
            f32x4 cva[2][4]; const size_t cbase = ((size_t)(gw * 4 + it) * 2) * 64 + lane;
            if (conv) {
#pragma unroll
                for (int j = 0; j < 2; ++j)
#pragma unroll
                    for (int w = 0; w < 4; ++w) cva[j][w] = *(const GAS f32x4*)(F.in[17 + half] + (cbase + (size_t)j * 64) * 16 + w * 4); }
            f32x16 s0, s1, s2, s3;
#pragma unroll
            for (int r = 0; r < 16; ++r) { s0[r] = 0.f; s1[r] = 0.f; s2[r] = 0.f; s3[r] = 0.f; }
            const LAS unsigned char* KB = L + (half ? RT_K2 : RT_K1);
#pragma unroll
            for (int ks = 0; ks < 8; ++ks) { const bf16x8 bq = *(const bf16x8*)(qp + half * 128 + ks * 16 + hi * 8);
                const LAS unsigned char* ka = KB + r32 * 272 + (16 * ks + 8 * hi) * 2;
                s0 = MFMA32(*(const LAS bf16x8*)(ka), bq, s0); s1 = MFMA32(*(const LAS bf16x8*)(ka + 32 * 272), bq, s1);
                s2 = MFMA32(*(const LAS bf16x8*)(ka + 64 * 272), bq, s2); s3 = MFMA32(*(const LAS bf16x8*)(ka + 96 * 272), bq, s3); }
#pragma unroll
            for (int r = 0; r < 16; ++r) { const unsigned key = (unsigned)crow(r, hi);
                s0[r] = __uint_as_float((__float_as_uint(s0[r]) & ~127u) | key); s1[r] = __uint_as_float((__float_as_uint(s1[r]) & ~127u) | (key + 32u));
                s2[r] = __uint_as_float((__float_as_uint(s2[r]) & ~127u) | (key + 64u)); s3[r] = __uint_as_float((__float_as_uint(s3[r]) & ~127u) | (key + 96u)); }
            sort16_desc(s0); sort16_desc(s1); sort16_desc(s2); sort16_desc(s3);
            merge16_desc(s0, s1); merge16_desc(s2, s3); merge16_desc(s0, s2);
            f32x16 pa, pb;
#pragma unroll
            for (int i = 0; i < 16; ++i) { auto rr = __builtin_amdgcn_permlane32_swap(__float_as_uint(s0[i]), __float_as_uint(s0[i]), false, false); pa[i] = __uint_as_float(rr[0]); pb[i] = __uint_as_float(rr[1]); }
            merge16_desc(pa, pb);
            top[half] = pa;
            if (conv) { const float sc = half == 0 ? U_SCALE : V_SCALE; unsigned char* dst = WSP(unsigned char, half == 0 ? WS_UT : WS_VT);
#pragma unroll
                for (int j = 0; j < 2; ++j) { v4u o;
#pragma unroll
                    for (int w = 0; w < 4; ++w) { const f32x4 a = cva[j][w]; int pk = 0;
                        pk = __builtin_amdgcn_cvt_pk_fp8_f32(a.x * sc, a.y * sc, pk, false); pk = __builtin_amdgcn_cvt_pk_fp8_f32(a.z * sc, a.w * sc, pk, true); o[w] = (unsigned)pk; }
                    *(GAS v4u*)(dst + (cbase + (size_t)j * 64) * 16) = o; } }
        }
        if (hi == 0) {
#pragma unroll
            for (int i = 0; i < 16; ++i) { VL[i] = top[0][i]; VL[16 + i] = top[1][i]; } }
        float l1[16], l2[16];
#pragma unroll
        for (int i = 0; i < 16; ++i) { l1[i] = __uint_as_float(__float_as_uint(top[0][i]) & ~127u); l2[i] = __uint_as_float(__float_as_uint(top[1][i]) & ~127u); }
        f32x16 c0, c1, c2, c3;
        {
            int n = 0;
#pragma unroll
            for (int i = 0; i < 16; ++i)
#pragma unroll
                for (int j = 0; j < 16; ++j) if ((i + 1) * (j + 1) <= 16) { const float cv = __uint_as_float((__float_as_uint(l1[i] + l2[j]) & ~255u) | (unsigned)(i * 16 + j));
                    if (n < 16) c0[n & 15] = cv; else if (n < 32) c1[n & 15] = cv; else if (n < 48) c2[n & 15] = cv; else c3[n & 15] = cv; ++n; }
        }
#pragma unroll
        for (int m = 2; m < 16; ++m) c3[m] = -INFINITY;
        sort16_desc(c0); sort16_desc(c1); sort16_desc(c2); sort16_desc(c3);
        merge16_desc(c0, c1); merge16_desc(c2, c3); merge16_desc(c0, c2);
        const f32x16 fa = c0;
        const float topv = __uint_as_float(__float_as_uint(fa[0]) & ~255u);
        float esum = 0.f, ev[8]; int ex[8];
#pragma unroll
        for (int k = 0; k < 16; ++k) { const unsigned bits = __float_as_uint(fa[k]); const float e = __expf(__uint_as_float(bits & ~255u) - topv); esum += e;
            if ((k >> 3) == hi) { ev[k & 7] = e; const int ci = (bits >> 4) & 15, cj = bits & 15;
                ex[k & 7] = (int)((__float_as_uint(VL[ci]) & 127u) * 128u + (__float_as_uint(VL[16 + cj]) & 127u)); } }
        const float inv = 1.0f / esum;
        int* ip = IDX + tok * 128 + hd * 16 + hi * 8; float* gp = GATE + tok * 128 + hd * 16 + hi * 8;
        *(int4*)ip = make_int4(ex[0], ex[1], ex[2], ex[3]); *(int4*)(ip + 4) = make_int4(ex[4], ex[5], ex[6], ex[7]);
        *(f32x4*)gp = (f32x4){ev[0] * inv, ev[1] * inv, ev[2] * inv, ev[3] * inv}; *(f32x4*)(gp + 4) = (f32x4){ev[4] * inv, ev[5] * inv, ev[6] * inv, ev[7] * inv};
    }
    __syncthreads();
}

__device__ __forceinline__ float gelu_erf(float x) { return 0.5f * x * (1.0f + erff(x * 0.70710678118654752f)); }
__device__ __forceinline__ float dot16_fp8(const v4u& u, const float (&h)[16], float acc) {
    f32x2 a2 = {acc, 0.f};
#pragma unroll
    for (int w = 0; w < 4; ++w) { const f32x2 a = __builtin_amdgcn_cvt_pk_f32_fp8((int)u[w], false), b = __builtin_amdgcn_cvt_pk_f32_fp8((int)u[w], true);
        a2 = __builtin_elementwise_fma(a, (f32x2){h[4 * w], h[4 * w + 1]}, a2); a2 = __builtin_elementwise_fma(b, (f32x2){h[4 * w + 2], h[4 * w + 3]}, a2); }
    return a2.x + a2.y;
}
__device__ __forceinline__ void axpy16_fp8(float (&acc)[16], const v4u& v, float c) {
#pragma unroll
    for (int w = 0; w < 4; ++w) { const f32x2 a = __builtin_amdgcn_cvt_pk_f32_fp8((int)v[w], false), b = __builtin_amdgcn_cvt_pk_f32_fp8((int)v[w], true);
        acc[4 * w] = fmaf(c, a.x, acc[4 * w]); acc[4 * w + 1] = fmaf(c, a.y, acc[4 * w + 1]); acc[4 * w + 2] = fmaf(c, b.x, acc[4 * w + 2]); acc[4 * w + 3] = fmaf(c, b.y, acc[4 * w + 3]); }
}
__device__ __forceinline__ void unpack16(const v4u& a, const v4u& b, float (&h)[16]) {
    h[0] = bf_lo(a.x); h[1] = bf_hi(a.x); h[2] = bf_lo(a.y); h[3] = bf_hi(a.y); h[4] = bf_lo(a.z); h[5] = bf_hi(a.z); h[6] = bf_lo(a.w); h[7] = bf_hi(a.w);
    h[8] = bf_lo(b.x); h[9] = bf_hi(b.x); h[10] = bf_lo(b.y); h[11] = bf_hi(b.y); h[12] = bf_lo(b.z); h[13] = bf_hi(b.z); h[14] = bf_lo(b.w); h[15] = bf_hi(b.w);
}
__device__ __forceinline__ float gelu_as(float v) {
    const float av = fabsf(v), t = __builtin_amdgcn_rcpf(fmaf(av, 0.2316418882f, 1.0f));
    float q = fmaf(t, 0.5307027145f, -0.7265760135f); q = fmaf(q, t, 0.7107068705f); q = fmaf(q, t, -0.142248368f); q = fmaf(q, t, 0.127414796f); q = q * t;
    const float e = __builtin_amdgcn_exp2f(v * v * -0.72134752044f), m = v * (q * e);
    return v < 0.f ? m : v - m;
}
#ifndef P10_TPW_DEF
#define P10_TPW_DEF 4
#endif
constexpr int P10_TPW = P10_TPW_DEF, P10_NS = 16, P10_SH = 10;
constexpr int P10_WB = 13056, P10_SIDX = 0, P10_SCF = 2048, P10_HB = 4096, P10_DESC = 12288;
#define P10_DECODE(D, T_, J_, N_) const int T_ = (D) & 3, J_ = ((D) >> 2) & 127, N_ = (D) >> 9
#define P10_ROWS(RS, BUF, DD, I) const int DD##n_ = __builtin_amdgcn_readfirstlane(DESC[(I)]); DD = DD##n_; P10_DECODE(DD##n_, t_, j_, n_); \
        const int ev_ = SIDX[t_ * 128 + j_ + min(lane & 7, max(n_ - 1, 0))]; \
        _Pragma("unroll") for (int k = 0; k < 8; ++k) { const int e_ = __builtin_amdgcn_readlane(ev_, k); BUF[k] = __builtin_bit_cast(v4u, __builtin_amdgcn_raw_buffer_load_b128(RS, voff, e_ * 1024, 0)); }
#define P10_ISSUE_U(BUF, DD, H0, H1, GG, I) do { P10_ROWS(rsU, BUF, DD, I) \
        { const LAS v4u* hp = (const LAS v4u*)(HB + t_ * 1024) + 2 * lane; H0 = hp[0]; H1 = hp[1]; } \
        GG = SCF[t_ * 128 + j_ + min(lane >> 3, max(n_ - 1, 0))]; } while (0)
#define P10_COMP_U(BUF, DD, H0, H1, GG) do { P10_DECODE(DD, t_, j_, n_); \
        float h[16]; unpack16(H0, H1, h); \
        float d[8]; _Pragma("unroll") for (int k = 0; k < 8; ++k) d[k] = dot16_fp8(BUF[k], h, 0.f); \
        const float c0 = reduce8_transposed(d, up16, up8); \
        const float act = gelu_as(c0 * (1.0f / U_SCALE)) * (1.0f / V_SCALE);       \
        if ((lane & 7) == 0 && (lane >> 3) < n_) SCF[t_ * 128 + j_ + (lane >> 3)] = GG * act; } while (0)
#define P10_ISSUE_V(BUF, DD, CV, I) do { P10_ROWS(rsV, BUF, DD, I) \
        CV = SCF[t_ * 128 + j_ + min(lane & 7, max(n_ - 1, 0))]; } while (0)
#define P10_AXPY8(ACC, BUF, CV) do { _Pragma("unroll") for (int k = 0; k < 8; ++k) { const float ck = (k < n_) ? __uint_as_float(__builtin_amdgcn_readlane(__float_as_uint(CV), k)) : 0.f; axpy16_fp8(ACC, BUF[k], ck); } } while (0)
#define P10_COMP_V(BUF, DD, CV) do { P10_DECODE(DD, t_, j_, n_); (void)j_; \
        if (t_ == 0) P10_AXPY8(acc[0], BUF, CV); else if (t_ == 1) P10_AXPY8(acc[1], BUF, CV); else if (t_ == 2) P10_AXPY8(acc[2], BUF, CV); else P10_AXPY8(acc[3], BUF, CV); } while (0)
#define P10_SB __builtin_amdgcn_sched_barrier(0)
template <int MODE> __device__ __forceinline__ void p10_experts(Frame& F, float* outp) {
    const int lane = lane_id();
    const bf16* H1B = WSP(bf16, WS_H1B); const bf16* PLE = WSP(bf16, WS_PLE); const int* IDX = WSP(int, WS_IDX); const float* GATE = WSP(float, WS_GATE);
    const auto rsU = __builtin_amdgcn_make_buffer_rsrc((void*)WSP(unsigned char, WS_UT), 0, 16384 * 1024, 0x00020000);
    const auto rsV = __builtin_amdgcn_make_buffer_rsrc((void*)WSP(unsigned char, WS_VT), 0, 16384 * 1024, 0x00020000);
    const int voff = lane * 16;
    const float* g2 = F.in[21]; const float* b2 = F.in[22];
    const bool up16 = (lane & 16) != 0, up8 = (lane & 8) != 0;
    LAS unsigned char* LW = F.lds + RING_OFF + F.wave * P10_WB;
    LAS int* SIDX = (LAS int*)(LW + P10_SIDX); LAS float* SCF = (LAS float*)(LW + P10_SCF); LAS bf16* HB = (LAS bf16*)(LW + P10_HB); LAS int* DESC = (LAS int*)(LW + P10_DESC);
    constexpr int TPB = NWAVES * P10_TPW;
    for (int blk = F.vcu; blk < M / TPB; blk += F.G) {
        const int tok0 = blk * TPB + F.wave * P10_TPW;
        int seg[P10_TPW][P10_NS + 1];
#pragma unroll
        for (int t = 0; t < P10_TPW; ++t) { const size_t tk = (size_t)(tok0 + t);
            const int i0 = IDX[tk * 128 + lane], i1 = IDX[tk * 128 + 64 + lane]; const float g0 = GATE[tk * 128 + lane], g1 = GATE[tk * 128 + 64 + lane];
            { const v4u* hp = (const v4u*)(H1B + tk * 1024) + 2 * lane; LAS v4u* hd = (LAS v4u*)(HB + t * 1024) + 2 * lane; hd[0] = hp[0]; hd[1] = hp[1]; }
            const int k0 = i0 >> P10_SH, k1 = i1 >> P10_SH; int r0 = 0, r1 = 0, base = 0;
#pragma unroll
            for (int k = 0; k < P10_NS; ++k) { const unsigned long long b0 = __ballot(k0 == k), b1 = __ballot(k1 == k);
                const int below0 = (int)__builtin_amdgcn_mbcnt_hi((unsigned)(b0 >> 32), __builtin_amdgcn_mbcnt_lo((unsigned)b0, 0u)), below1 = (int)__builtin_amdgcn_mbcnt_hi((unsigned)(b1 >> 32), __builtin_amdgcn_mbcnt_lo((unsigned)b1, 0u));
                const int n0 = __builtin_popcountll(b0), n1 = __builtin_popcountll(b1);
                r0 = (k0 == k) ? base + below0 : r0; r1 = (k1 == k) ? base + n0 + below1 : r1; seg[t][k] = base; base += n0 + n1; }
            seg[t][P10_NS] = base;
            SIDX[t * 128 + r0] = i0; SCF[t * 128 + r0] = g0; SIDX[t * 128 + r1] = i1; SCF[t * 128 + r1] = g1; }
        int nd = 0;
#pragma unroll
        for (int s = 0; s < P10_NS; ++s)
#pragma unroll
            for (int t = 0; t < P10_TPW; ++t) { for (int c = (seg[t][s] + 7) >> 3; c < (seg[t][s + 1] + 7) >> 3; ++c) { if (lane == 0) DESC[nd] = t | ((8 * c) << 2) | (8 << 9); ++nd; } }
        if (lane < 3) DESC[nd + lane] = 0;
        const int ndp = (nd + 1) & ~1;
        v4u BA[8], BB[8];
        {
            int dA, dB; v4u hA0, hA1, hB0, hB1; float gA, gB;
            P10_ISSUE_U(BA, dA, hA0, hA1, gA, 0); P10_SB;
#pragma unroll 1
            for (int i = 0; i < ndp; i += 2) {
                P10_ISSUE_U(BB, dB, hB0, hB1, gB, i + 1); P10_SB;
                P10_COMP_U(BA, dA, hA0, hA1, gA); P10_SB;
                P10_ISSUE_U(BA, dA, hA0, hA1, gA, i + 2); P10_SB;
                P10_COMP_U(BB, dB, hB0, hB1, gB); P10_SB;
            }
        }
        float acc[4][16];
#pragma unroll
        for (int t = 0; t < 4; ++t)
#pragma unroll
            for (int i = 0; i < 16; ++i) acc[t][i] = 0.f;
        {
            int dA, dB; float cA, cB;
            P10_ISSUE_V(BA, dA, cA, 0); P10_SB;
#pragma unroll 1
            for (int i = 0; i < ndp; i += 2) {
                P10_ISSUE_V(BB, dB, cB, i + 1); P10_SB;
                P10_COMP_V(BA, dA, cA); P10_SB;
                P10_ISSUE_V(BA, dA, cA, i + 2); P10_SB;
                P10_COMP_V(BB, dB, cB); P10_SB;
            }
        }
#pragma unroll
        for (int t = 0; t < P10_TPW; ++t) { const int tok = tok0 + t;
            float h[16], pl[16];
            { const LAS v4u* hp = (const LAS v4u*)(HB + t * 1024) + 2 * lane; const v4u x0_ = hp[0], x1_ = hp[1]; unpack16(x0_, x1_, h); }
            { const v4u* pp = (const v4u*)(PLE + (size_t)tok * 1024) + 2 * lane; unpack16(pp[0], pp[1], pl); }
            float y[16]; float sm = 0.f;
#pragma unroll
            for (int i = 0; i < 16; ++i) { y[i] = ALPHA * h[i] + acc[t][i] + pl[i]; sm += y[i]; }
            const float mean = wave_sum(sm) * (1.f / DM); float s2 = 0.f;
#pragma unroll
            for (int i = 0; i < 16; ++i) { y[i] -= mean; s2 += y[i] * y[i]; }
            const float rstd = 1.f / sqrtf(wave_sum(s2) * (1.f / DM) + LN_EPS);
            float* op = outp + (size_t)tok * 1024 + 16 * lane; const float* gp = g2 + 16 * lane; const float* bp = b2 + 16 * lane;
#pragma unroll
            for (int q = 0; q < 4; ++q) { const f32x4 ga = *(const f32x4*)(gp + 4 * q), ba = *(const f32x4*)(bp + 4 * q); f32x4 o;
                o.x = y[4 * q] * rstd * ga.x + ba.x; o.y = y[4 * q + 1] * rstd * ga.y + ba.y; o.z = y[4 * q + 2] * rstd * ga.z + ba.z; o.w = y[4 * q + 3] * rstd * ga.w + ba.w;
                *(f32x4*)(op + 4 * q) = o; }
        }
    }
}
struct Args { const float* in[23]; float* out; unsigned char* ws; int ph_lo, ph_hi, li, pad; };
__global__ void __launch_bounds__(NWAVES * 64, 2) fwd_kernel(Args args) {
    extern __shared__ __attribute__((aligned(16))) unsigned char lds[];
    Frame F;
    F.lds = (LAS unsigned char*)lds;
    F.MISC = (volatile LAS unsigned*)(F.lds + MISC_OFF);
    F.tid = threadIdx.x; F.lane = F.tid & 63; F.wave = __builtin_amdgcn_readfirstlane(F.tid >> 6);
    F.G = gridDim.x; { const int bx = blockIdx.x; F.vcu = (F.G % 8 == 0) ? (bx % 8) * (F.G / 8) + bx / 8 : bx; }
    F.ws = args.ws; F.out = args.out; F.in = args.in;
    F.ctl = (gu32*)(F.ws + WS_CTL);
    for (int u = F.tid; u < (LDS_BYTES - LDSCTL_OFF) / 4; u += NWAVES * 64) ((LAS unsigned*)(F.lds + LDSCTL_OFF))[u] = 0u;
    __syncthreads();
    XcdBarrier bar; bar.bar = (unsigned*)(F.ctl + CW_BAR); bar.x = 0; bar.st = nullptr;
    if (N_LAUNCHES == 1) bar = xcd_barrier_post((unsigned*)(F.ctl + CW_BAR), F.MISC + 8);
#ifdef PROBE_BAR2
#define GRID_BAR() do { if (N_LAUNCHES == 1) { xcd_barrier(bar); xcd_barrier(bar); } } while (0)
#else
#define GRID_BAR() do { if (N_LAUNCHES == 1) xcd_barrier(bar); } while (0)
#endif
    const int lo = args.ph_lo, hi = args.ph_hi;
#ifndef PH_MASK
#define PH_MASK 0x7ff
#endif
#define IN(k) (((PH_MASK >> (k)) & 1) && lo <= (k) && (k) < hi)
#define BOTH(k) (IN(k) && IN((k) + 1))
#ifndef REP_MASK
#define REP_MASK 0
#endif
#define REPS(k) for (int rep_ = 0; rep_ < 1 + ((REP_MASK >> (k)) & 1); ++rep_)
    const int bx = (int)blockIdx.x;

    if (IN(0)) { p0_prologue(F);
#ifdef PROBE_P0
        __syncthreads(); p0_prologue(F);
#endif
        if (BOTH(0)) GRID_BAR(); }

    if (IN(1)) {
        { pg8::Gemm g{WSP(bf16, WS_XN), WSP(bf16, WS_WIN_T), M, NPROJ, DM}; pg8::StaticOrder S; S.init(M, NPROJ, F.G, bx);
          pg8::EpiBf16<0> E{WSP(bf16, WS_PROJ), 512, nullptr, 512, SLAB, C2};
          pg8::gemm_phase<pg8::EpiBf16<0>, pg8::StaticOrder, PG8_ALIGN, PG8_SP2>(F.lds + RING_OFF, g, S, E); }
#ifdef PROBE_P1
        { pg8::Gemm g{WSP(bf16, WS_XN), WSP(bf16, WS_WIN_T), M, NPROJ, DM}; pg8::StaticOrder S; S.init(M, NPROJ, F.G, bx);
          pg8::EpiBf16<PROBE_P1> E{WSP(bf16, WS_PROJ), 512, nullptr, 512, SLAB, C2};
          pg8::gemm_phase<pg8::EpiBf16<PROBE_P1>, pg8::StaticOrder, PG8_ALIGN, PG8_SP2>(F.lds + RING_OFF, g, S, E); }
#endif
        if (BOTH(1)) GRID_BAR();
    }

    if (IN(2)) {
#define P2_ATTN() do { if (F.G == 256) { const int bh = F.vcu >> 3, s = F.vcu & 7; \
            for (int i = 0; i < 4; ++i) { const int qb = (i == 0) ? s : (i == 1) ? 15 - s : (i == 2) ? 16 + s : 31 - s; attn_unit(F, bh, qb); } } \
        else { for (int u = F.vcu; u < 1024; u += F.G) attn_unit(F, u >> 5, u & 31); } } while (0)
#define P2_MLA() do { for (int u = F.vcu; u < N_MLU; u += F.G) mla_unit(F, u); } while (0)
        P2_ATTN();
#ifdef PROBE_P2A
        P2_ATTN();
#endif
        P2_MLA();
#ifdef PROBE_P2B
        P2_MLA();
#endif
        if (BOTH(2)) GRID_BAR();
    }

    if (IN(3)) { for (int it = F.vcu; it < 256; it += F.G) ml_scan_item(F, it);
#ifdef PROBE_P3
        for (int it = F.vcu; it < 256; it += F.G) ml_scan_item(F, it, WS_Y);
#endif
        if (BOTH(3)) GRID_BAR(); }

    if (IN(4)) { REPS(4) for (int u = F.vcu; u < N_MLU; u += F.G) mlc_unit(F, u); if (BOTH(4)) GRID_BAR(); }

    if (IN(5)) {
        pg8::Gemm g{WSP(bf16, WS_OCAT), WSP(bf16, WS_WSB_T), M, DM, DM}; pg8::StaticOrder S; S.init(M, DM, F.G, bx);
        pg8::EpiGate2 E{WSP(bf16, WS_Y), WSP(bf16, WS_PROJ) + 7 * SLAB, WSP(bf16, WS_PROJ) + 9 * SLAB};
        pg8::gemm_phase<pg8::EpiGate2, pg8::StaticOrder, PG8_ALIGN, PG8_SP2>(F.lds + RING_OFF, g, S, E);
        if (BOTH(5)) GRID_BAR();
    }

    if (IN(6)) {
#define P6_OUTPROJ() do { pg8::Gemm g{WSP(bf16, WS_Y), WSP(bf16, WS_WOUT_T), M, DM, DM}; pg8::StaticOrder S; S.init(M, DM, F.G, bx); \
          pg8::EpiBf16<0> E{WSP(bf16, WS_PRE1), DM, nullptr, 0, 0, 1.f}; \
          pg8::gemm_phase<pg8::EpiBf16<0>, pg8::StaticOrder, PG8_ALIGN, PG8_SP2>(F.lds + RING_OFF, g, S, E); } while (0)
#define P6_PLE() do { pg8::Gemm g{WSP(bf16, WS_PB), WSP(bf16, WS_WPLE_T), M, DM, 256}; pg8::StaticOrder S; S.init(M, DM, F.G, bx); \
          pg8::EpiBf16<0> E{WSP(bf16, WS_PLE), DM, nullptr, 0, 0, 1.f}; \
          pg8::gemm_phase<pg8::EpiBf16<0>, pg8::StaticOrder, PG8_ALIGN, PG8_SP2>(F.lds + RING_OFF, g, S, E); } while (0)
        P6_OUTPROJ(); P6_PLE();
#ifdef PROBE_P6A
        P6_OUTPROJ();
#endif
#ifdef PROBE_P6B
        P6_PLE();
#endif
        if (BOTH(6)) GRID_BAR();
    }

    if (IN(7)) { REPS(7) p7_ln1_tables(F); if (BOTH(7)) GRID_BAR(); }

    if (IN(8)) {
        pg8::Gemm g{WSP(bf16, WS_H1B), WSP(bf16, WS_WQG_T), M, 3072, DM}; pg8::StaticOrder S; S.init(M, 3072, F.G, bx);
        pg8::EpiQG E{WSP(bf16, WS_Q), WSP(bf16, WS_PLE)};
        pg8::gemm_phase<pg8::EpiQG, pg8::StaticOrder, PG8_ALIGN, PG8_SP2>(F.lds + RING_OFF, g, S, E);
        if (BOTH(8)) GRID_BAR();
    }

    if (IN(9)) { REPS(9) p9_route(F); if (BOTH(9)) GRID_BAR(); }

    if (IN(10)) { p10_experts<0>(F, F.out);
#ifdef PROBE_P10
        p10_experts<PROBE_P10>(F, WSP(float, WS_PRE1));
#endif
    }
#undef IN
#undef BOTH
#undef GRID_BAR
}

extern "C" void kernel_launch(void* const* d_in, const int* in_sizes, int n_in, void* d_out, int out_size, void* d_ws, size_t ws_size, hipStream_t stream) {
    static int grid = 0;
    if (grid == 0) {
        if (n_in != 23 || in_sizes[0] != M * DM || out_size != M * DM || ws_size < WS_END) {
            fprintf(stderr, "kernel_launch: built for 23 inputs, x/out of %d floats, >= %zu bytes of workspace; got n_in %d, in0 %d, out %d, ws %zu; nothing launched\n", M * DM, (size_t)WS_END, n_in, n_in > 0 ? in_sizes[0] : -1, out_size, ws_size);
            grid = -1; return; }
        int dev = 0, cus = 0;
        if (hipGetDevice(&dev) != hipSuccess || hipDeviceGetAttribute(&cus, hipDeviceAttributeMultiprocessorCount, dev) != hipSuccess) { fprintf(stderr, "kernel_launch: device query failed\n"); grid = -1; return; }
        if (hipFuncSetAttribute((const void*)fwd_kernel, hipFuncAttributeMaxDynamicSharedMemorySize, LDS_BYTES) != hipSuccess) { fprintf(stderr, "kernel_launch: hipFuncSetAttribute failed\n"); grid = -1; return; }
        int per_cu = 0;
        if (hipOccupancyMaxActiveBlocksPerMultiprocessor(&per_cu, (const void*)fwd_kernel, NWAVES * 64, LDS_BYTES) != hipSuccess || per_cu < 1)
            fprintf(stderr, "kernel_launch: note: occupancy query reports %d workgroups per CU\n", per_cu);
        (void)hipGetLastError();
        grid = cus;
    }
    if (grid < 0) return;
    if (hipMemsetAsync((char*)d_ws + WS_CTL, 0, CTL_ZERO_BYTES, stream) != hipSuccess) { fprintf(stderr, "kernel_launch: hipMemsetAsync failed\n"); return; }
    Args a{};
    for (int i = 0; i < 23; ++i) a.in[i] = (const float*)d_in[i];
    a.out = (float*)d_out; a.ws = (unsigned char*)d_ws;
    for (int li = 0; li < N_LAUNCHES; ++li) {
        if (N_LAUNCHES == 1) { a.ph_lo = 0; a.ph_hi = N_PHASES; } else { a.ph_lo = li; a.ph_hi = li + 1; }
        a.li = li;
        hipLaunchKernelGGL(fwd_kernel, dim3(grid), dim3(NWAVES * 64), LDS_BYTES, stream, a);
        const hipError_t le = hipPeekAtLastError();
        if (le != hipSuccess) { fprintf(stderr, "kernel_launch: launch %d failed: %s\n", li, hipGetErrorName(le)); break; }
    }
}
```
